# Optimizing an MI355X kernel written in HIP

```python
import jax
import jax.numpy as jnp
from jax import lax
import numpy as np

D_MODEL = 1024
BATCH = 2
SEQ = 16384
DEPTH = 2

GRID_W = 64
CTX_LEN = 256
HEAD_DIM = 64
ROPE_BASE = 10000.0
NEG_INF = -1e30
EPS = 1e-6

POOL_WINDOWS = (2, 4, 8, 16)
POOL_GROUPS = 4
POOL_GROUP_DIM = 64
POOL_W = POOL_GROUPS * POOL_GROUP_DIM
NA_HEADS = 4
NA_ROWS = 8
NA_COLS = 16
NA_W = NA_HEADS * HEAD_DIM
SWA_HEADS = 4
SWA_KV_HEADS = 2
SWA_WINDOW = 128
SWA_BLOCK = 128
MLA_HEADS = 4
MLA_Q_RANK = 256
MLA_KV_RANK = 128
MLA_NOPE = 64
MLA_ROPE = 32
MLA_V = 64
MLA_Q_BLOCK = 128
MLA_SCALE = (MLA_NOPE + MLA_ROPE) ** -0.5
N_BRANCH = 4
BRANCH_W = 256
FFN_HIDDEN = -(-8 * D_MODEL // (3 * 256)) * 256

OFF_NA_K = 0
OFF_NA_V = OFF_NA_K + NA_W
OFF_SWA_K = OFF_NA_V + NA_W
OFF_SWA_V = OFF_SWA_K + SWA_KV_HEADS * HEAD_DIM
OFF_MLA_CKV = OFF_SWA_V + SWA_KV_HEADS * HEAD_DIM
OFF_MLA_KR = OFF_MLA_CKV + MLA_KV_RANK
KV_COLS = OFF_MLA_KR + MLA_ROPE
OFF_NA_Q = KV_COLS
OFF_SWA_Q = OFF_NA_Q + NA_W
OFF_MLA_CQ = OFF_SWA_Q + SWA_HEADS * HEAD_DIM
OFF_POOL = OFF_MLA_CQ + MLA_Q_RANK
OFF_GATE = OFF_POOL + POOL_W
IN_COLS = OFF_GATE + N_BRANCH * D_MODEL

kernel_name = "hybrid_pool_natten_swa_mla_prefix_dit"

F32 = jnp.float32


def rms_norm(x, g):
    xf = x.astype(F32)
    y = xf * lax.rsqrt(jnp.mean(xf * xf, axis=-1, keepdims=True) + EPS)
    return (y * g.astype(F32)).astype(x.dtype)


def modulation(cond, w, b, k):
    m = jax.nn.silu(cond) @ w[:, :k * D_MODEL] + b[:k * D_MODEL]
    return jnp.split(m, k, axis=-1)


def modulate(x, g, shift, scale):
    return rms_norm(x, g) * (1 + scale[..., None, :]) + shift[..., None, :]


def axial_rope(n, dim):
    t = jnp.arange(n, dtype=jnp.int32)
    row = (t // GRID_W).astype(F32)
    col = (t % GRID_W).astype(F32)
    n_freq = dim // 4
    inv = jnp.power(ROPE_BASE, -jnp.arange(n_freq, dtype=F32) / n_freq)
    ang = jnp.concatenate([row[:, None] * inv, col[:, None] * inv], axis=-1)
    return jnp.cos(ang), jnp.sin(ang)


def apply_rope(x, cos, sin):
    half = x.shape[-1] // 2
    xf = x.astype(F32)
    x1, x2 = xf[..., :half], xf[..., half:]
    return jnp.concatenate([x1 * cos - x2 * sin, x2 * cos + x1 * sin], axis=-1).astype(x.dtype)


def kv_heads(u, kv_norm_g, rope):
    B, n, _ = u.shape
    na_k = u[..., OFF_NA_K:OFF_NA_V].reshape(B, n, NA_HEADS, HEAD_DIM)
    na_v = u[..., OFF_NA_V:OFF_SWA_K].reshape(B, n, NA_HEADS, HEAD_DIM)
    swa_k = u[..., OFF_SWA_K:OFF_SWA_V].reshape(B, n, SWA_KV_HEADS, HEAD_DIM)
    swa_v = u[..., OFF_SWA_V:OFF_MLA_CKV].reshape(B, n, SWA_KV_HEADS, HEAD_DIM)
    ckv = rms_norm(u[..., OFF_MLA_CKV:OFF_MLA_KR], kv_norm_g)
    kr = u[..., OFF_MLA_KR:KV_COLS]
    if rope is not None:
        cos_h, sin_h, cos_r, sin_r = rope
        swa_k = apply_rope(swa_k, cos_h[:, None], sin_h[:, None])
        kr = apply_rope(kr, cos_r, sin_r)
    return (na_k, na_v, swa_k, swa_v, ckv, kr)


def query_heads(u, q_norm_g, w_uq, w_uk, rope):
    B, n, _ = u.shape
    na_q = u[..., OFF_NA_Q:OFF_SWA_Q].reshape(B, n, NA_HEADS, HEAD_DIM)
    swa_q = u[..., OFF_SWA_Q:OFF_MLA_CQ].reshape(B, n, SWA_HEADS, HEAD_DIM)
    cq = rms_norm(u[..., OFF_MLA_CQ:OFF_POOL], q_norm_g)
    q = (cq @ w_uq).reshape(B, n, MLA_HEADS, MLA_NOPE + MLA_ROPE)
    q_nope, q_rope = q[..., :MLA_NOPE], q[..., MLA_NOPE:]
    if rope is not None:
        cos_h, sin_h, cos_r, sin_r = rope
        swa_q = apply_rope(swa_q, cos_h[:, None], sin_h[:, None])
        q_rope = apply_rope(q_rope, cos_r[:, None], sin_r[:, None])
    q_lat = jnp.einsum('bnhd,chd->bnhc', q_nope, w_uk)
    pool_in = u[..., OFF_POOL:OFF_GATE]
    gate_logits = u[..., OFF_GATE:]
    return (na_q, swa_q, q_lat, q_rope, pool_in, gate_logits)


def multiscale_pool(u, w_grp, scale):
    B, n, _ = u.shape
    ug = u.reshape(B, n, POOL_GROUPS, POOL_GROUP_DIM).astype(F32)
    cs = jnp.concatenate([jnp.zeros_like(ug[:, :1]), jnp.cumsum(ug, axis=1)], axis=1)
    t = jnp.arange(n)
    means = []
    for g, w in enumerate(POOL_WINDOWS):
        lo = jnp.clip(t - w // 2, 0, n)
        hi = jnp.clip(t - w // 2 + w, 0, n)
        cnt = (hi - lo).astype(F32)[None, :, None]
        means.append((cs[:, hi, g] - cs[:, lo, g]) / cnt)
    y = (jnp.stack(means, axis=2) - ug).astype(u.dtype)
    y = jnp.einsum('bngc,gcd->bngd', y, w_grp).reshape(B, n, POOL_W)
    return y * scale


def neighbourhood_attention(q, k, v, kc, vc, rpb):
    B, n, H, dh = q.shape
    rows = n // GRID_W
    kr_ = min(NA_ROWS, rows)
    m = kr_ * NA_COLS
    qg = q.reshape(B, rows, GRID_W, H, dh)
    kg = k.reshape(B, rows, GRID_W, H, dh)
    vg = v.reshape(B, rows, GRID_W, H, dh)
    col = jnp.arange(GRID_W)
    col_idx = jnp.clip(col - NA_COLS // 2, 0, GRID_W - NA_COLS)[:, None] + jnp.arange(NA_COLS)[None, :]
    col_off = col_idx - col[:, None] + (NA_COLS - 1)
    scale = dh ** -0.5

    def one_row(r):
        r0 = jnp.clip(r - kr_ // 2, 0, rows - kr_)
        qr = lax.dynamic_index_in_dim(qg, r, axis=1, keepdims=False)
        kb = lax.dynamic_slice_in_dim(kg, r0, kr_, axis=1)[:, :, col_idx]
        vb = lax.dynamic_slice_in_dim(vg, r0, kr_, axis=1)[:, :, col_idx]
        row_off = r0 + jnp.arange(kr_) - r + (NA_ROWS - 1)
        bias = rpb[:, row_off[None, :, None], col_off[:, None, :]]
        s_loc = jnp.einsum('bqhd,bjqkhd->bhqjk', qr, kb).astype(F32) * scale + bias.astype(F32)
        s_ctx = jnp.einsum('bqhd,blhd->bhql', qr, kc).astype(F32) * scale
        p = jax.nn.softmax(jnp.concatenate([s_loc.reshape(B, H, GRID_W, m), s_ctx], axis=-1), axis=-1)
        p = p.astype(v.dtype)
        return (jnp.einsum('bhqjk,bjqkhd->bqhd', p[..., :m].reshape(B, H, GRID_W, kr_, NA_COLS), vb)
                + jnp.einsum('bhql,blhd->bqhd', p[..., m:], vc))

    o = lax.map(one_row, jnp.arange(rows))
    return jnp.moveaxis(o, 0, 1).reshape(B, n, H * dh)


def banded(t, nb):
    B, _, KVH, dh = t.shape
    tb = t.reshape(B, nb, SWA_BLOCK, KVH, dh)
    z = jnp.zeros_like(tb[:, :1])
    prev = jnp.concatenate([z, tb[:, :-1]], axis=1)
    nxt = jnp.concatenate([tb[:, 1:], z], axis=1)
    return jnp.concatenate([prev, tb, nxt], axis=2)


def windowed_attention(q, k, v, kc, vc, sink):
    B, n, H, dh = q.shape
    KVH = k.shape[2]
    G = H // KVH
    L = kc.shape[1]
    nb = n // SWA_BLOCK
    m = 3 * SWA_BLOCK
    scale = dh ** -0.5
    qb = q.reshape(B, nb, SWA_BLOCK, KVH, G, dh)
    kb = banded(k, nb)
    vb = banded(v, nb)
    qpos = jnp.arange(SWA_BLOCK)
    kpos = jnp.arange(m) - SWA_BLOCK
    kabs = jnp.arange(nb)[:, None] * SWA_BLOCK + kpos[None, :]
    rel = kpos[None, :] - qpos[:, None]
    mask = (jnp.abs(rel) <= SWA_WINDOW)[None] & ((kabs >= 0) & (kabs < n))[:, None, :]
    s_loc = jnp.einsum('bnqkgd,bnjkd->bnkgqj', qb, kb).astype(F32) * scale
    s_loc = jnp.where(mask[None, :, None, None], s_loc, NEG_INF)
    s_ctx = jnp.einsum('bnqkgd,blkd->bnkgql', qb, kc).astype(F32) * scale
    s_sink = jnp.broadcast_to(sink.astype(F32).reshape(1, 1, KVH, G, 1, 1), s_ctx.shape[:-1] + (1,))
    p = jax.nn.softmax(jnp.concatenate([s_loc, s_ctx, s_sink], axis=-1), axis=-1).astype(v.dtype)
    o = (jnp.einsum('bnkgqj,bnjkd->bnqkgd', p[..., :m], vb)
         + jnp.einsum('bnkgql,blkd->bnqkgd', p[..., m:m + L], vc))
    return o.reshape(B, n, H * dh)


def dense_attention(q, k, v, sink):
    B, n, H, dh = q.shape
    KVH = k.shape[2]
    G = H // KVH
    qg = q.reshape(B, n, KVH, G, dh)
    s = jnp.einsum('bqkgd,bjkd->bkgqj', qg, k).astype(F32) * (dh ** -0.5)
    m = s.shape[-1]
    if sink is not None:
        s = jnp.concatenate([s, jnp.broadcast_to(sink.astype(F32).reshape(1, KVH, G, 1, 1), s.shape[:-1] + (1,))], axis=-1)
    p = jax.nn.softmax(s, axis=-1).astype(v.dtype)[..., :m]
    return jnp.einsum('bkgqj,bjkd->bqkgd', p, v).reshape(B, n, H * dh)


def mla_attend(q_lat, q_rope, ckv, kr, w_uv):
    B, n, H, _ = q_lat.shape
    s = (jnp.einsum('bqhc,bjc->bhqj', q_lat, ckv) + jnp.einsum('bqhr,bjr->bhqj', q_rope, kr)).astype(F32) * MLA_SCALE
    p = jax.nn.softmax(s, axis=-1).astype(ckv.dtype)
    o_lat = jnp.einsum('bhqj,bjc->bqhc', p, ckv)
    return jnp.einsum('bqhc,chd->bqhd', o_lat, w_uv).reshape(B, n, H * MLA_V)


def mla_blocks(q_lat, q_rope, ckv, kr, w_uv):
    B, n, H, C = q_lat.shape
    nb = n // MLA_Q_BLOCK
    qb = jnp.moveaxis(q_lat.reshape(B, nb, MLA_Q_BLOCK, H, C), 1, 0)
    rb = jnp.moveaxis(q_rope.reshape(B, nb, MLA_Q_BLOCK, H, MLA_ROPE), 1, 0)
    o = lax.map(lambda a: mla_attend(a[0], a[1], ckv, kr, w_uv), (qb, rb))
    return jnp.moveaxis(o, 0, 1).reshape(B, n, H * MLA_V)


def latent_branches(q, kv, kv_c, pool_w, pool_scale, rpb, sink, w_uv):
    na_q, swa_q, q_lat, q_rope, pool_in, _ = q
    na_k, na_v, swa_k, swa_v, ckv, kr = kv
    na_kc, na_vc, swa_kc, swa_vc, ckv_c, kr_c = kv_c
    return (multiscale_pool(pool_in, pool_w, pool_scale),
            neighbourhood_attention(na_q, na_k, na_v, na_kc, na_vc, rpb),
            windowed_attention(swa_q, swa_k, swa_v, swa_kc, swa_vc, sink),
            mla_blocks(q_lat, q_rope, jnp.concatenate([ckv_c, ckv], axis=1),
                       jnp.concatenate([kr_c, kr], axis=1), w_uv))


def context_branches(q, kv_c, pool_w, pool_scale, sink, w_uv):
    na_q, swa_q, q_lat, q_rope, pool_in, _ = q
    na_kc, na_vc, swa_kc, swa_vc, ckv_c, kr_c = kv_c
    return (multiscale_pool(pool_in, pool_w, pool_scale),
            dense_attention(na_q, na_kc, na_vc, None),
            dense_attention(swa_q, swa_kc, swa_vc, sink),
            mla_attend(q_lat, q_rope, ckv_c, kr_c, w_uv))


def merge_branches(branches, gate_logits, w_branch, w_out):
    merged = None
    for i, y in enumerate(branches):
        term = jax.nn.sigmoid(gate_logits[..., i * D_MODEL:(i + 1) * D_MODEL]) * (y @ w_branch[i])
        merged = term if merged is None else merged + term
    return merged @ w_out


def swiglu(h, w1, w3, w2):
    return (jax.nn.silu(h @ w1) * (h @ w3)) @ w2


def setup_inputs(seed: int = 0) -> dict:
    key = jax.random.key(seed)
    ks = jax.random.split(key, 24)
    D = D_MODEL
    L = DEPTH

    def nrm(k, shape, s):
        return jax.random.normal(k, shape, F32) * s

    return {
        "x": nrm(ks[0], (BATCH, SEQ, D), 1.0),
        "c": nrm(ks[1], (BATCH, D), 1.0),
        "ctx": nrm(ks[2], (BATCH, CTX_LEN, D), 1.0),
        "c_ctx": nrm(ks[3], (D,), 1.0),
        "ada_w": nrm(ks[4], (L, D, 6 * D), D ** -0.5),
        "ada_b": nrm(ks[5], (L, 6 * D), 0.01),
        "norm1_g": 1.0 + nrm(ks[6], (L, D), 0.1),
        "norm2_g": 1.0 + nrm(ks[7], (L, D), 0.1),
        "w_in": nrm(ks[8], (L, D, IN_COLS), D ** -0.5),
        "pool_w": nrm(ks[9], (L, POOL_GROUPS, POOL_GROUP_DIM, POOL_GROUP_DIM), POOL_GROUP_DIM ** -0.5),
        "pool_scale": 1.0 + nrm(ks[10], (L, POOL_W), 0.1),
        "na_rpb": nrm(ks[11], (L, NA_HEADS, 2 * NA_ROWS - 1, 2 * NA_COLS - 1), 0.1),
        "swa_sink": nrm(ks[12], (L, SWA_HEADS), 0.5),
        "mla_q_norm": 1.0 + nrm(ks[13], (L, MLA_Q_RANK), 0.1),
        "mla_kv_norm": 1.0 + nrm(ks[14], (L, MLA_KV_RANK), 0.1),
        "mla_w_uq": nrm(ks[15], (L, MLA_Q_RANK, MLA_HEADS * (MLA_NOPE + MLA_ROPE)), MLA_Q_RANK ** -0.5),
        "mla_w_uk": nrm(ks[16], (L, MLA_KV_RANK, MLA_HEADS, MLA_NOPE), MLA_KV_RANK ** -0.5),
        "mla_w_uv": nrm(ks[17], (L, MLA_KV_RANK, MLA_HEADS, MLA_V), MLA_KV_RANK ** -0.5),
        "w_branch": nrm(ks[18], (L, N_BRANCH, BRANCH_W, D), BRANCH_W ** -0.5),
        "w_out": nrm(ks[19], (L, D, D), D ** -0.5),
        "ffn_w1": nrm(ks[20], (L, D, FFN_HIDDEN), D ** -0.5),
        "ffn_w3": nrm(ks[21], (L, D, FFN_HIDDEN), D ** -0.5),
        "ffn_w2": nrm(ks[22], (L, FFN_HIDDEN, D), FFN_HIDDEN ** -0.5),
        "final_norm_g": 1.0 + nrm(ks[23], (D,), 0.1),
    }


def reference(x, c, ctx, c_ctx, ada_w, ada_b, norm1_g, norm2_g, w_in, pool_w, pool_scale,
              na_rpb, swa_sink, mla_q_norm, mla_kv_norm, mla_w_uq, mla_w_uk, mla_w_uv,
              w_branch, w_out, ffn_w1, ffn_w3, ffn_w2, final_norm_g):
    n = x.shape[1]
    cos_h, sin_h = axial_rope(n, HEAD_DIM)
    cos_r, sin_r = axial_rope(n, MLA_ROPE)
    rope = (cos_h, sin_h, cos_r, sin_r)
    xc = ctx
    for l in range(DEPTH):
        last = l == DEPTH - 1
        sh1, sc1, g1, sh2, sc2, g2 = modulation(c, ada_w[l], ada_b[l], 6)
        if last:
            csh1, csc1 = modulation(c_ctx, ada_w[l], ada_b[l], 2)
        else:
            csh1, csc1, cg1, csh2, csc2, cg2 = modulation(c_ctx, ada_w[l], ada_b[l], 6)
        hx = modulate(x, norm1_g[l], sh1, sc1)
        hc = modulate(xc, norm1_g[l], csh1, csc1)
        ux = hx @ w_in[l]
        uc = hc @ (w_in[l][:, :KV_COLS] if last else w_in[l])
        kv_c = kv_heads(uc[..., :KV_COLS], mla_kv_norm[l], None)
        kv_x = kv_heads(ux[..., :KV_COLS], mla_kv_norm[l], rope)
        q_x = query_heads(ux, mla_q_norm[l], mla_w_uq[l], mla_w_uk[l], rope)
        br_x = latent_branches(q_x, kv_x, kv_c, pool_w[l], pool_scale[l], na_rpb[l], swa_sink[l], mla_w_uv[l])
        mixed_x = merge_branches(br_x, q_x[5], w_branch[l], w_out[l])
        if not last:
            q_c = query_heads(uc, mla_q_norm[l], mla_w_uq[l], mla_w_uk[l], None)
            br_c = context_branches(q_c, kv_c, pool_w[l], pool_scale[l], swa_sink[l], mla_w_uv[l])
            xc = xc + cg1 * merge_branches(br_c, q_c[5], w_branch[l], w_out[l])
            xc = xc + cg2 * swiglu(modulate(xc, norm2_g[l], csh2, csc2), ffn_w1[l], ffn_w3[l], ffn_w2[l])
        x = x + g1[:, None, :] * mixed_x
        x = x + g2[:, None, :] * swiglu(modulate(x, norm2_g[l], sh2, sc2), ffn_w1[l], ffn_w3[l], ffn_w2[l])
    return rms_norm(x, final_norm_g)
```

```cpp
#include <hip/hip_runtime.h>
#include <hip/hip_cooperative_groups.h>
#include <cstdio>
#include <cstdint>
namespace cg = cooperative_groups;

#define LAS __attribute__((address_space(3)))
typedef unsigned short bf16_t;
typedef short bf16x8 __attribute__((ext_vector_type(8)));
typedef short s16x4 __attribute__((ext_vector_type(4)));
typedef short v4i16_t __attribute__((ext_vector_type(4)));
typedef float f32x4 __attribute__((ext_vector_type(4)));
typedef float f32x16 __attribute__((ext_vector_type(16)));
typedef unsigned u32x4 __attribute__((ext_vector_type(4)));
typedef unsigned u32x2 __attribute__((ext_vector_type(2)));
typedef float f32x2_t __attribute__((ext_vector_type(2)));
typedef __bf16 bf16x2_t __attribute__((ext_vector_type(2)));

constexpr int D = 1024, NB = 2, SEQ = 16384, NLAT = NB * SEQ, CTXL = 256, NCTX = NB * CTXL, MT = NLAT + NCTX;
constexpr int INC = 6048, FF = 2816, DEPTH = 2;
constexpr int UW = 2048, QW = 768, YW = 1280;
constexpr int U_NAK = 0, U_NAV = 256, U_SWK = 512, U_SWV = 640, U_CKV = 768, U_KR = 896, U_NAQ = 928, U_SWQ = 1184, U_CQ = 1440, U_POOL = 1696, U_END = 1952;
constexpr float EPSV = 1e-6f;
constexpr float LOG2E = 1.4426950408889634f;
constexpr float QSC64 = 0.125f * LOG2E;
constexpr float QSCMLA = 0.10206207261596577f * LOG2E;

constexpr size_t MiB = 1u << 20;
constexpr size_t WS_MOD = 1 * MiB, WS_XC = 2 * MiB, WS_W = 8 * MiB, WS_H = 80 * MiB, WS_Y = 145 * MiB, WS_R4 = 227 * MiB, WS_QM = WS_R4 + 130 * MiB, WS_END = 487 * MiB;
constexpr size_t WL = 35 * MiB;
constexpr size_t W_U = 0, W_G = 4 * MiB, W_QF = 12 * MiB, W_B = 12 * MiB + 512 * 1024, W_O = 16 * MiB + 512 * 1024, W_13 = 18 * MiB + 512 * 1024, W_2 = 29 * MiB + 512 * 1024;

constexpr int NTHREADS = 512;
constexpr int LDS_BYTES = 147456;

__device__ __forceinline__ unsigned cvtpk(float lo, float hi) { f32x2_t v = {lo, hi}; bf16x2_t b = __builtin_convertvector(v, bf16x2_t); return __builtin_bit_cast(unsigned, b); }
__device__ __forceinline__ float bflo(unsigned w) { return __uint_as_float(w << 16); }
__device__ __forceinline__ float bfhi(unsigned w) { return __uint_as_float(w & 0xffff0000u); }
__device__ __forceinline__ float bf2f(bf16_t h) { return __uint_as_float(((unsigned)h) << 16); }
__device__ __forceinline__ bf16_t f2bf(float f) { return (bf16_t)(cvtpk(f, 0.f) & 0xffffu); }
__device__ __forceinline__ float wave_sum_l(float v, int lane) {
#pragma unroll
    for (int o = 1; o < 64; o <<= 1) v += __uint_as_float((unsigned)__builtin_amdgcn_ds_bpermute((lane ^ o) << 2, (int)__float_as_uint(v)));
    return v;
}
__device__ __forceinline__ float xhalf_max(float m) { auto rr = __builtin_amdgcn_permlane32_swap(__float_as_uint(m), __float_as_uint(m), false, false); return fmaxf(__uint_as_float(rr[0]), __uint_as_float(rr[1])); }
__device__ __forceinline__ float xhalf_sum(float m) { auto rr = __builtin_amdgcn_permlane32_swap(__float_as_uint(m), __float_as_uint(m), false, false); return __uint_as_float(rr[0]) + __uint_as_float(rr[1]); }
__device__ __forceinline__ int fresh_tid() { int t = threadIdx.x; asm volatile("" : "+v"(t)); return t; }
__device__ __forceinline__ float fexp2(float x) { return __builtin_amdgcn_exp2f(x); }
__device__ __forceinline__ float frcp(float x) { return __builtin_amdgcn_rcpf(x); }
__device__ __forceinline__ float sigmoidf_(float x) { return frcp(1.f + fexp2(-x * LOG2E)); }

namespace pg8 {
constexpr int BM = 256, BK = 64, HALF = 128, HTB = HALF * BK * 2, STAGE_BYTES = 8 * HTB, NXCD = 8, WGM = 8;
__device__ __forceinline__ int lds_byte(int r, int c) { const int st = (r >> 4) * 2 + (c >> 5), rr = r & 15, cc = c & 31, ob = rr * 64 + cc * 2; return st * 1024 + (ob ^ (((ob >> 9) & 1) << 5)); }
__device__ __forceinline__ void stage_rc(int b, int& R, int& C) { const int st = b / 1024, sb = b % 1024, swz = sb ^ (((sb >> 9) & 1) << 5); R = (st >> 1) * 16 + swz / 64; C = (st & 1) * 32 + (swz % 64) / 2; }

struct Unit { const char* A; const char* B; int pm, pn, nt; };

struct StaticOrder {
    int nM, nN, nwg, G, c;
    __device__ void init(int M, int N, int G_, int c_) { nM = M / BM; nN = N / BM; nwg = nM * nN; G = G_; c = c_; }
    __device__ bool next(int i, int& pm, int& pn) const {
        const long L = (long)i * G + c; if (L >= nwg) return false;
        int wgid = (int)L; { const int q = nwg / NXCD, r = nwg % NXCD, xcd = wgid % NXCD, off = wgid / NXCD; wgid = (xcd < r ? xcd * (q + 1) : r * (q + 1) + (xcd - r) * q) + off; }
        const int nig = WGM * nN, gid = wgid / nig, fm = gid * WGM, gsz = (nM - fm) < WGM ? (nM - fm) : WGM;
        pm = fm + ((wgid % nig) % gsz); pn = (wgid % nig) / gsz; return true;
    }
};
struct SchedPlain {
    StaticOrder so; const char* A; const char* B; size_t a_t, b_t; int nt;
    __device__ bool next(int i, Unit& u) const { int pm, pn; if (!so.next(i, pm, pn)) return false; u.pm = pm; u.pn = pn; u.A = A + (size_t)pm * a_t; u.B = B + (size_t)pn * b_t; u.nt = nt; return true; }
};
struct SchedBranch {
    StaticOrder so; const char* A; const char* B; size_t a_t;
    __device__ bool next(int i, Unit& u) const { int pm, pn; if (!so.next(i, pm, pn)) return false; u.pm = pm; u.pn = pn; const int br = pn >> 2;
        u.A = A + (size_t)pm * a_t + (size_t)br * 512; u.B = B + (size_t)br * (1024 * 512 * 2) + (size_t)(pn & 3) * (256 * 512 * 2); u.nt = br == 3 ? 8 : 4; return true; }
};

template <class Epi, class Sched>
__device__ __forceinline__ void gemm_phase(LAS unsigned char* lds, const int lda, const int ldb, const Sched& S, Epi& E) {
    const int tid = fresh_tid(), wid = __builtin_amdgcn_readfirstlane(tid >> 6), lane = tid & 63, wr = wid >> 2, wc = wid & 3, fr = lane & 15, fq = lane >> 4;
    unsigned voffA[2], voffB[2];
#pragma unroll
    for (int i = 0; i < 2; ++i) { int R, C; stage_rc(tid * 16 + i * 8192, R, C); voffA[i] = (unsigned)(R * lda + C * 2); voffB[i] = (unsigned)(R * ldb + C * 2); }
    const size_t kstep = (size_t)(BK * 2);
    const size_t hstepA = (size_t)HALF * lda, hstepB = (size_t)HALF * ldb;
    const unsigned ldsw = (unsigned)wid * 1024u;
    const int aoff = lds_byte(wr * 64 + fr, fq * 8), boff = lds_byte(wc * 32 + fr, fq * 8);
#define PG8_SA(b, h) (((b) * 2 + (h)) * HTB)
#define PG8_SB(b, h) ((4 + (b) * 2 + (h)) * HTB)
#define PG8_STAGE(bufoff, gbase, voff) do { _Pragma("unroll") for (int _i = 0; _i < 2; ++_i) \
        __builtin_amdgcn_global_load_lds((const unsigned*)((const char*)(gbase) + (voff)[_i]), (LAS unsigned*)(lds + (bufoff) + ldsw + _i * 8192), 16, 0, 0); } while (0)
#define PG8_LDA(dst, b, h) do { _Pragma("unroll") for (int m = 0; m < 4; ++m) _Pragma("unroll") for (int k = 0; k < 2; ++k) dst[m][k] = *(const LAS bf16x8*)(lds + PG8_SA(b, h) + aoff + m * 2048 + k * 1024); } while (0)
#define PG8_LDB(dst, b, h) do { _Pragma("unroll") for (int n = 0; n < 2; ++n) _Pragma("unroll") for (int k = 0; k < 2; ++k) dst[n][k] = *(const LAS bf16x8*)(lds + PG8_SB(b, h) + boff + n * 2048 + k * 1024); } while (0)
#define PG8_MMA(ai, bj, At, Bt) do { __builtin_amdgcn_s_setprio(1); _Pragma("unroll") for (int m = 0; m < 4; ++m) _Pragma("unroll") for (int n = 0; n < 2; ++n) _Pragma("unroll") for (int k = 0; k < 2; ++k) \
        acc[ai][bj][m][n] = __builtin_amdgcn_mfma_f32_16x16x32_bf16(Bt[n][k], At[m][k], acc[ai][bj][m][n], 0, 0, 0); __builtin_amdgcn_s_setprio(0); } while (0)
#define PG8_WAIT_V(n) asm volatile("s_waitcnt vmcnt(" #n ")" ::: "memory")
#define PG8_WAIT_L(n) asm volatile("s_waitcnt lgkmcnt(" #n ")" ::: "memory")
#define PG8_BAR __builtin_amdgcn_s_barrier()
#define PG8_SCHED __builtin_amdgcn_sched_barrier(0)
    Unit cur, nxt; int ui = 0;
    if (!S.next(0, cur)) return;
    f32x4 acc[2][2][4][2];
#pragma unroll
    for (int a = 0; a < 2; ++a)
#pragma unroll
        for (int b = 0; b < 2; ++b)
#pragma unroll
            for (int m = 0; m < 4; ++m)
#pragma unroll
                for (int n = 0; n < 2; ++n) acc[a][b][m][n] = (f32x4){0.f, 0.f, 0.f, 0.f};
    bf16x8 At[4][2], B0[2][2], B1[2][2];
    const char* cA = cur.A; const char* cB = cur.B;
    PG8_STAGE(PG8_SB(0, 0), cB, voffB); PG8_STAGE(PG8_SB(0, 1), cB + hstepB, voffB); PG8_STAGE(PG8_SA(0, 0), cA, voffA); PG8_STAGE(PG8_SA(0, 1), cA + hstepA, voffA);
    if (wr == 1) PG8_BAR;
    PG8_WAIT_V(2); PG8_BAR;
    PG8_STAGE(PG8_SB(1, 0), cB + kstep, voffB); PG8_STAGE(PG8_SA(1, 0), cA + kstep, voffA); PG8_STAGE(PG8_SB(1, 1), cB + hstepB + kstep, voffB);
    PG8_WAIT_V(6); PG8_BAR;
    for (;;) {
        const bool has_next = S.next(ui + 1, nxt);
        const char* nA = has_next ? nxt.A : cA; const char* nB = has_next ? nxt.B : cB;
        const int nt = cur.nt;
        for (int t = 0; t < nt; t += 2) {
            const bool last = (t == nt - 2);
            const char* a1 = cA + (size_t)(t + 1) * kstep;
            const char* a2 = last ? nA : cA + (size_t)(t + 2) * kstep; const char* b2 = last ? nB : cB + (size_t)(t + 2) * kstep;
            const char* a3 = a2 + kstep; const char* b3 = b2 + kstep;
            PG8_LDB(B0, 0, 0); PG8_LDB(B1, 0, 1); PG8_SCHED; PG8_LDA(At, 0, 0); PG8_STAGE(PG8_SA(1, 1), a1 + hstepA, voffA);
            PG8_WAIT_V(8); PG8_WAIT_L(0); PG8_BAR; PG8_MMA(0, 0, At, B0); PG8_MMA(0, 1, At, B1); PG8_BAR; PG8_SCHED;
            PG8_LDA(At, 0, 1); PG8_STAGE(PG8_SB(0, 0), b2, voffB); PG8_STAGE(PG8_SB(0, 1), b2 + hstepB, voffB); PG8_STAGE(PG8_SA(0, 0), a2, voffA);
            PG8_WAIT_V(8); PG8_WAIT_L(0); PG8_BAR; PG8_MMA(1, 0, At, B0); PG8_MMA(1, 1, At, B1); PG8_BAR; PG8_SCHED;
            PG8_LDB(B0, 1, 0); PG8_LDB(B1, 1, 1); PG8_SCHED; PG8_LDA(At, 1, 0); PG8_STAGE(PG8_SA(0, 1), a2 + hstepA, voffA);
            PG8_WAIT_V(8); PG8_WAIT_L(0); PG8_BAR; PG8_MMA(0, 0, At, B0); PG8_MMA(0, 1, At, B1); PG8_BAR; PG8_SCHED;
            PG8_LDA(At, 1, 1); PG8_STAGE(PG8_SB(1, 0), b3, voffB); PG8_STAGE(PG8_SB(1, 1), b3 + hstepB, voffB); PG8_STAGE(PG8_SA(1, 0), a3, voffA);
            PG8_WAIT_V(8); PG8_WAIT_L(0); PG8_BAR; PG8_MMA(1, 0, At, B0); PG8_MMA(1, 1, At, B1); PG8_BAR; PG8_SCHED;
        }
        if (wr == 0) PG8_BAR;
        E(acc, cur, wr, wc, fr, fq);
        if (!has_next) break;
#pragma unroll
        for (int a = 0; a < 2; ++a)
#pragma unroll
            for (int b = 0; b < 2; ++b)
#pragma unroll
                for (int m = 0; m < 4; ++m)
#pragma unroll
                    for (int n = 0; n < 2; ++n) acc[a][b][m][n] = (f32x4){0.f, 0.f, 0.f, 0.f};
        cur = nxt; cA = nA; cB = nB; ++ui;
        if (wr == 1) PG8_BAR;
    }
    PG8_WAIT_V(0);
    PG8_BAR;
#undef PG8_SA
#undef PG8_SB
#undef PG8_STAGE
#undef PG8_LDA
#undef PG8_LDB
#undef PG8_MMA
#undef PG8_WAIT_V
#undef PG8_WAIT_L
#undef PG8_BAR
#undef PG8_SCHED
}
}

typedef f32x4 acc_t[2][2][4][2];

struct EpiStore {
    bf16_t* O; int ldc;
    __device__ __forceinline__ void operator()(const acc_t& acc, const pg8::Unit& u, int wr, int wc, int fr, int fq) const {
        const int row0 = u.pm * 256 + wr * 64 + fr, col0 = u.pn * 256 + wc * 32 + 4 * fq;
#pragma unroll
        for (int ai = 0; ai < 2; ++ai)
#pragma unroll
            for (int m = 0; m < 4; ++m) { bf16_t* rowp = O + (size_t)(row0 + ai * 128 + m * 16) * ldc + col0;
#pragma unroll
                for (int bj = 0; bj < 2; ++bj)
#pragma unroll
                    for (int n = 0; n < 2; ++n) { const f32x4 v = acc[ai][bj][m][n]; u32x2 w; w.x = cvtpk(v[0], v[1]); w.y = cvtpk(v[2], v[3]); *(u32x2*)(rowp + bj * 128 + n * 16) = w; } }
    }
};
struct EpiQRope {
    bf16_t* O;
    __device__ __forceinline__ void operator()(const acc_t& acc, const pg8::Unit& u, int wr, int wc, int fr, int fq) const {
        const int row0 = u.pm * 256 + wr * 64 + fr, col0 = u.pn * 256 + wc * 32 + 4 * fq;
        const bool latent = u.pm < 128;
        float inv[4];
#pragma unroll
        for (int j = 0; j < 4; ++j) inv[j] = exp2f(-(float)(4 * (fq & 1) + j) * 1.6609640474436813f);
#pragma unroll
        for (int ai = 0; ai < 2; ++ai)
#pragma unroll
            for (int m = 0; m < 4; ++m) { const int row = row0 + ai * 128 + m * 16; bf16_t* rowp = O + (size_t)row * QW + col0;
                const int t = row & (SEQ - 1); const float pos = (float)((fq < 2) ? (t >> 6) : (t & 63));
#pragma unroll
                for (int bj = 0; bj < 2; ++bj) { const int cb = u.pn * 8 + bj * 4 + wc; f32x4 v0 = acc[ai][bj][m][0], v1 = acc[ai][bj][m][1];
                    if (latent && (cb == 4 || cb == 9 || cb == 14 || cb == 19)) {
#pragma unroll
                        for (int j = 0; j < 4; ++j) { const float a = pos * inv[j]; const float cs = __cosf(a), sn = __sinf(a); const float x1 = v0[j], x2 = v1[j]; v0[j] = x1 * cs - x2 * sn; v1[j] = x2 * cs + x1 * sn; }
                    }
                    u32x2 w; w.x = cvtpk(v0[0], v0[1]); w.y = cvtpk(v0[2], v0[3]); *(u32x2*)(rowp + bj * 128) = w;
                    w.x = cvtpk(v1[0], v1[1]); w.y = cvtpk(v1[2], v1[3]); *(u32x2*)(rowp + bj * 128 + 16) = w; } }
    }
};
struct EpiMerge {
    const bf16_t* Yall; bf16_t* Mg;
    __device__ __forceinline__ void operator()(const acc_t& acc, const pg8::Unit& u, int wr, int wc, int fr, int fq) const {
        const int row0 = u.pm * 256 + wr * 64 + fr, ocol = u.pn * 64 + wc * 16 + 4 * fq;
#pragma unroll
        for (int ai = 0; ai < 2; ++ai)
#pragma unroll
            for (int m = 0; m < 4; ++m) { const int row = row0 + ai * 128 + m * 16; const bf16_t* yr = Yall + (size_t)row * 4096 + ocol; f32x4 s = {0.f, 0.f, 0.f, 0.f};
#pragma unroll
                for (int bj = 0; bj < 2; ++bj)
#pragma unroll
                    for (int n = 0; n < 2; ++n) { const u32x2 w = *(const u32x2*)(yr + (2 * bj + n) * 1024); const f32x4 g = acc[ai][bj][m][n];
                        s[0] += sigmoidf_(g[0]) * bflo(w.x); s[1] += sigmoidf_(g[1]) * bfhi(w.x); s[2] += sigmoidf_(g[2]) * bflo(w.y); s[3] += sigmoidf_(g[3]) * bfhi(w.y); }
                u32x2 o; o.x = cvtpk(s[0], s[1]); o.y = cvtpk(s[2], s[3]); *(u32x2*)(Mg + (size_t)row * D + ocol) = o; }
    }
};
struct EpiResid {
    const float* res_lat_f32;
    bf16_t* rb;
    const float* res_ctx; float* out_ctx; const float* gate;
    __device__ __forceinline__ void operator()(const acc_t& acc, const pg8::Unit& u, int wr, int wc, int fr, int fq) const {
        const int lrow0 = wr * 64 + fr, col0 = u.pn * 256 + wc * 32 + 4 * fq;
        const int v = u.pm < 128 ? (u.pm >> 6) : 2;
        const float* gp = gate + v * 6144;
        f32x4 gv[2][2];
#pragma unroll
        for (int bj = 0; bj < 2; ++bj)
#pragma unroll
            for (int n = 0; n < 2; ++n) gv[bj][n] = *(const f32x4*)(gp + col0 + bj * 128 + n * 16);
        if (u.pm < 128) {
            bf16_t* rbt = rb + (size_t)u.pm * 256 * 2048 + 1024;
            if (res_lat_f32) {
                const float* res = res_lat_f32 + (size_t)u.pm * 256 * D;
#pragma unroll
                for (int ai = 0; ai < 2; ++ai)
#pragma unroll
                    for (int m = 0; m < 4; ++m) { const int lr = lrow0 + ai * 128 + m * 16;
#pragma unroll
                        for (int bj = 0; bj < 2; ++bj)
#pragma unroll
                            for (int n = 0; n < 2; ++n) { const int c = col0 + bj * 128 + n * 16; const f32x4 r = *(const f32x4*)(res + (size_t)lr * D + c);
                                const f32x4 o = r + gv[bj][n] * acc[ai][bj][m][n];
                                u32x2 w2; w2.x = cvtpk(o[0], o[1]); w2.y = cvtpk(o[2], o[3]); *(u32x2*)(rbt + (size_t)lr * 2048 + c) = w2; } }
            } else {
#pragma unroll
                for (int ai = 0; ai < 2; ++ai)
#pragma unroll
                    for (int m = 0; m < 4; ++m) { const int lr = lrow0 + ai * 128 + m * 16;
#pragma unroll
                        for (int bj = 0; bj < 2; ++bj)
#pragma unroll
                            for (int n = 0; n < 2; ++n) { const int c = col0 + bj * 128 + n * 16; const u32x2 w = *(const u32x2*)(rbt + (size_t)lr * 2048 + c);
                                const f32x4 r = (f32x4){bflo(w.x), bfhi(w.x), bflo(w.y), bfhi(w.y)};
                                const f32x4 o = r + gv[bj][n] * acc[ai][bj][m][n];
                                u32x2 w2; w2.x = cvtpk(o[0], o[1]); w2.y = cvtpk(o[2], o[3]); *(u32x2*)(rbt + (size_t)lr * 2048 + c) = w2; } }
            }
        } else {
            const float* res = res_ctx + (size_t)(u.pm - 128) * 256 * D; float* out = out_ctx + (size_t)(u.pm - 128) * 256 * D;
#pragma unroll
            for (int ai = 0; ai < 2; ++ai)
#pragma unroll
                for (int m = 0; m < 4; ++m) { const size_t off = (size_t)(lrow0 + ai * 128 + m * 16) * D + col0;
#pragma unroll
                    for (int bj = 0; bj < 2; ++bj)
#pragma unroll
                        for (int n = 0; n < 2; ++n) { const f32x4 r = *(const f32x4*)(res + off + bj * 128 + n * 16); *(f32x4*)(out + off + bj * 128 + n * 16) = r + gv[bj][n] * acc[ai][bj][m][n]; } }
        }
    }
};
struct EpiSwiGLU {
    bf16_t* Hd;
    __device__ __forceinline__ void operator()(const acc_t& acc, const pg8::Unit& u, int wr, int wc, int fr, int fq) const {
        const int row0 = u.pm * 256 + wr * 64 + fr, hcol = u.pn * 128 + wc * 32 + 4 * fq;
#pragma unroll
        for (int ai = 0; ai < 2; ++ai)
#pragma unroll
            for (int m = 0; m < 4; ++m) { bf16_t* rowp = Hd + (size_t)(row0 + ai * 128 + m * 16) * FF + hcol;
#pragma unroll
                for (int n = 0; n < 2; ++n) { const f32x4 a = acc[ai][0][m][n], b = acc[ai][1][m][n]; f32x4 v;
#pragma unroll
                    for (int j = 0; j < 4; ++j) v[j] = a[j] * sigmoidf_(a[j]) * b[j];
                    u32x2 w; w.x = cvtpk(v[0], v[1]); w.y = cvtpk(v[2], v[3]); *(u32x2*)(rowp + n * 16) = w; } }
    }
};

__device__ __forceinline__ s16x4 vtr(LAS const unsigned char* p) { return __builtin_bit_cast(s16x4, __builtin_amdgcn_ds_read_tr16_b64_v4i16((LAS v4i16_t*)p)); }
__device__ __forceinline__ int crow(int r, int hi) { return (r & 3) + 8 * (r >> 2) + 4 * hi; }

template <int MODE>
__device__ __forceinline__ void attn_unit(LAS unsigned char* lds, const bf16_t* __restrict__ u, const bf16_t* __restrict__ qm, bf16_t* __restrict__ y,
                                          const float* __restrict__ rpb, const float* __restrict__ sink,
                                          int qrow0, int kctx_row0, int nlocal, int loc_row0, int aux0, int aux1, int kvh) {
    constexpr int KW = MODE == 0 ? 160 : (MODE == 1 ? 256 : 64);
    constexpr int KSTR = KW * 2 + 16;
    constexpr int NKS = MODE == 0 ? 10 : 4;
    constexpr int NDB = MODE == 0 ? 4 : 2;
    constexpr bool VSEP = MODE != 0;
    constexpr int CPR = KW / 8, NCH = 64 * CPR, NLD = (NCH + 511) / 512;
    constexpr int STAGE = (VSEP ? 2 : 1) * 64 * KSTR;
    const int tid = fresh_tid(), lane = tid & 63, wid = __builtin_amdgcn_readfirstlane(tid >> 6), l32 = lane & 31, hi = lane >> 5;
    int head, qtok, kcolw, kgcol, vgcol, ycol;
    if (MODE == 0) { head = wid & 3; qtok = 32 * (wid >> 2) + l32; kcolw = 0; kgcol = U_CKV; vgcol = U_CKV; ycol = 768 + head * 128; }
    else if (MODE == 1) { head = wid & 3; qtok = 32 * (wid >> 2) + l32; kcolw = head * 64; kgcol = U_NAK; vgcol = U_NAV; ycol = 256 + head * 64; }
    else { head = kvh * 2 + (wid & 1); qtok = 32 * (wid >> 1) + l32; kcolw = 0; kgcol = U_SWK + kvh * 64; vgcol = U_SWV + kvh * 64; ycol = 512 + head * 64; }
    const bf16_t* qp = MODE == 0 ? qm + (size_t)(qrow0 + qtok) * QW + head * 160 : u + (size_t)(qrow0 + qtok) * UW + (MODE == 1 ? U_NAQ : U_SWQ) + head * 64;
    bf16x8 qf[NKS];
#pragma unroll
    for (int ks = 0; ks < NKS; ++ks) qf[ks] = *(const bf16x8*)(qp + 16 * ks + 8 * hi);
    f32x16 o[NDB];
#pragma unroll
    for (int c = 0; c < NDB; ++c)
#pragma unroll
        for (int r = 0; r < 16; ++r) o[c][r] = 0.f;
    float mrun = -1e30f, lrun = 0.f;
    int srow[NLD], sch[NLD];
#pragma unroll
    for (int i = 0; i < NLD; ++i) { const int idx = tid + 512 * i; srow[i] = idx / CPR; sch[i] = idx % CPR; }
    u32x4 kreg[NLD], vreg[NLD];
    const int ntile = 4 + nlocal;
    unsigned dvo[5];
    if (MODE == 1) {
#pragma unroll
        for (int i = 0; i < 5; ++i) { const int sl = (wid + 8 * i) * 64 + lane, row = (sl / 33) & 63, ch = sl % 33; dvo[i] = (unsigned)(row * (UW * 2) + (ch < 32 ? ch : 0) * 16); }
    }
#define ATT_DMA(t, buf) do { const char* tb_ = (const char*)u + (size_t)ATT_TROW(t) * (UW * 2); _Pragma("unroll") for (int i = 0; i < 5; ++i) if (wid + 8 * i < 33) { \
        __builtin_amdgcn_global_load_lds((const unsigned*)(tb_ + kgcol * 2 + dvo[i]), (LAS unsigned*)(lds + (buf) * STAGE + (wid + 8 * i) * 1024), 16, 0, 0); \
        __builtin_amdgcn_global_load_lds((const unsigned*)(tb_ + vgcol * 2 + dvo[i]), (LAS unsigned*)(lds + (buf) * STAGE + 64 * KSTR + (wid + 8 * i) * 1024), 16, 0, 0); } } while (0)
#define ATT_TROW(t) ((t) < 4 ? kctx_row0 + 64 * (t) : loc_row0 + 64 * ((t) - 4))
#define ATT_LOAD(t) do { const int rg_ = ATT_TROW(t); _Pragma("unroll") for (int i = 0; i < NLD; ++i) if (NCH % 512 == 0 || i < NLD - 1 || tid + 512 * i < NCH) { \
        const bf16_t* gp_ = u + (size_t)(rg_ + srow[i]) * UW + sch[i] * 8; kreg[i] = *(const u32x4*)(gp_ + kgcol); if (VSEP) vreg[i] = *(const u32x4*)(gp_ + vgcol); } } while (0)
#define ATT_STORE(buf) do { _Pragma("unroll") for (int i = 0; i < NLD; ++i) if (NCH % 512 == 0 || i < NLD - 1 || tid + 512 * i < NCH) { \
        LAS unsigned char* lp_ = lds + (buf) * STAGE + srow[i] * KSTR + sch[i] * 16; *(LAS u32x4*)lp_ = kreg[i]; if (VSEP) *(LAS u32x4*)(lp_ + 64 * KSTR) = vreg[i]; } } while (0)
    if (MODE == 1) { ATT_DMA(0, 0); asm volatile("s_waitcnt vmcnt(0)" ::: "memory"); } else { ATT_LOAD(0); ATT_STORE(0); }
    __syncthreads();
    const int q4 = (lane & 15) >> 2, p4 = lane & 3, blk = (lane >> 4) & 1;
    for (int t = 0; t < ntile; ++t) {
        const int buf = t & 1;
        if (t + 1 < ntile) { if (MODE == 1) ATT_DMA(t + 1, (t + 1) & 1); else ATT_LOAD(t + 1); }
        float rpv = 0.f;
        if (MODE == 1 && t >= 4) rpv = rpb[(head * 15 + (aux1 + (t - 4) - aux0 + 7)) * 31 + min(lane, 30)];
        LAS const unsigned char* Kb = lds + buf * STAGE;
        LAS const unsigned char* Vb = VSEP ? Kb + 64 * KSTR : Kb;
        f32x16 s0, s1;
#pragma unroll
        for (int r = 0; r < 16; ++r) { s0[r] = 0.f; s1[r] = 0.f; }
        {
            LAS const unsigned char* kp = Kb + l32 * KSTR + (kcolw + 8 * hi) * 2;
            bf16x8 ka0 = *(LAS const bf16x8*)(kp), ka1 = *(LAS const bf16x8*)(kp + 32 * KSTR);
#pragma unroll
            for (int ks = 0; ks < NKS; ++ks) {
                bf16x8 kb0 = ka0, kb1 = ka1;
                if (ks + 1 < NKS) { kb0 = *(LAS const bf16x8*)(kp + (ks + 1) * 32); kb1 = *(LAS const bf16x8*)(kp + (ks + 1) * 32 + 32 * KSTR); }
                s0 = __builtin_amdgcn_mfma_f32_32x32x16_bf16(ka0, qf[ks], s0, 0, 0, 0);
                s1 = __builtin_amdgcn_mfma_f32_32x32x16_bf16(ka1, qf[ks], s1, 0, 0, 0);
                __builtin_amdgcn_sched_barrier(0);
                ka0 = kb0; ka1 = kb1;
            }
        }
        if (MODE == 1 && t >= 4) {
            const int c = qtok, c0 = min(max(c - 8, 0), 48);
            const int rpi = (int)__float_as_uint(rpv);
#pragma unroll
            for (int r = 0; r < 16; ++r) {
                const int kc0 = crow(r, hi), kc1 = kc0 + 32;
                const bool v0 = (kc0 >= c0) && (kc0 < c0 + 16), v1 = (kc1 >= c0) && (kc1 < c0 + 16);
                const float b0 = __uint_as_float((unsigned)__builtin_amdgcn_ds_bpermute(min(max(kc0 - c + 15, 0), 30) << 2, rpi));
                const float b1 = __uint_as_float((unsigned)__builtin_amdgcn_ds_bpermute(min(max(kc1 - c + 15, 0), 30) << 2, rpi));
                s0[r] = v0 ? s0[r] + b0 * LOG2E : -INFINITY; s1[r] = v1 ? s1[r] + b1 * LOG2E : -INFINITY;
            }
        }
        if (MODE == 2 && t >= 4) {
            const int qpos = aux0 + qtok, kb0 = aux1 + 64 * (t - 4);
#pragma unroll
            for (int r = 0; r < 16; ++r) {
                const int d0 = kb0 + crow(r, hi) - qpos, d1 = d0 + 32;
                if (d0 > 128 || d0 < -128) s0[r] = -INFINITY;
                if (d1 > 128 || d1 < -128) s1[r] = -INFINITY;
            }
        }
        float mx = fmaxf(s0[0], s1[0]);
#pragma unroll
        for (int r = 1; r < 16; ++r) mx = fmaxf(mx, fmaxf(s0[r], s1[r]));
        mx = xhalf_max(mx);
        const float mnew = fmaxf(mrun, mx), alpha = fexp2(mrun - mnew);
        mrun = mnew;
        float rs = 0.f;
#pragma unroll
        for (int r = 0; r < 16; ++r) { s0[r] = fexp2(s0[r] - mnew); s1[r] = fexp2(s1[r] - mnew); rs += s0[r] + s1[r]; }
        lrun = lrun * alpha + rs;
#pragma unroll
        for (int c = 0; c < NDB; ++c)
#pragma unroll
            for (int r = 0; r < 16; ++r) o[c][r] *= alpha;
        u32x4 pw[2][2];
#pragma unroll
        for (int s = 0; s < 2; ++s) {
            pw[0][s] = (u32x4){cvtpk(s0[8 * s], s0[8 * s + 1]), cvtpk(s0[8 * s + 2], s0[8 * s + 3]), cvtpk(s0[8 * s + 4], s0[8 * s + 5]), cvtpk(s0[8 * s + 6], s0[8 * s + 7])};
            pw[1][s] = (u32x4){cvtpk(s1[8 * s], s1[8 * s + 1]), cvtpk(s1[8 * s + 2], s1[8 * s + 3]), cvtpk(s1[8 * s + 4], s1[8 * s + 5]), cvtpk(s1[8 * s + 6], s1[8 * s + 7])};
        }
        {
            LAS const unsigned char* vp = Vb + (4 * hi + q4) * KSTR + (kcolw + 16 * blk) * 2 + 8 * p4;
            s16x4 la = vtr(vp), ha = vtr(vp + 8 * KSTR);
#pragma unroll
            for (int it = 0; it < NDB * 4; ++it) {
                const int c = it >> 2, kb = (it >> 1) & 1, s = it & 1;
                s16x4 lb = la, hb = ha;
                if (it + 1 < NDB * 4) { const int c2 = (it + 1) >> 2, kb2 = ((it + 1) >> 1) & 1, s2 = (it + 1) & 1;
                    lb = vtr(vp + (32 * kb2 + 16 * s2) * KSTR + c2 * 64); hb = vtr(vp + (32 * kb2 + 16 * s2 + 8) * KSTR + c2 * 64); }
                const bf16x8 vf = (bf16x8){la[0], la[1], la[2], la[3], ha[0], ha[1], ha[2], ha[3]};
                o[c] = __builtin_amdgcn_mfma_f32_32x32x16_bf16(vf, __builtin_bit_cast(bf16x8, pw[kb][s]), o[c], 0, 0, 0);
                __builtin_amdgcn_sched_barrier(0);
                la = lb; ha = hb;
            }
        }
        if (MODE == 1) asm volatile("s_waitcnt vmcnt(0)" ::: "memory"); else if (t + 1 < ntile) ATT_STORE((t + 1) & 1);
        __syncthreads();
    }
    lrun = xhalf_sum(lrun);
    if (MODE == 2) lrun += fexp2(sink[head] * LOG2E - mrun);
    const float inv = 1.f / lrun;
    bf16_t* yp = y + (size_t)(qrow0 + qtok) * YW + ycol + 4 * hi;
#pragma unroll
    for (int c = 0; c < NDB; ++c)
#pragma unroll
        for (int g = 0; g < 4; ++g) { u32x2 w; w.x = cvtpk(o[c][4 * g] * inv, o[c][4 * g + 1] * inv); w.y = cvtpk(o[c][4 * g + 2] * inv, o[c][4 * g + 3] * inv); *(u32x2*)(yp + 32 * c + 8 * g) = w; }
#undef ATT_TROW
#undef ATT_DMA
#undef ATT_LOAD
#undef ATT_STORE
}


__device__ __forceinline__ void mla_unit(LAS unsigned char* lds, const bf16_t* __restrict__ u, const bf16_t* __restrict__ qm, bf16_t* __restrict__ y,
                                         int qrow0, int kctx_row0, int nlocal, int loc_row0) {
    constexpr int KSTR = 320, NKS = 10, STAGE = 41 * 1024, KB1 = 32 * KSTR + 64, HALFB = 64 * KSTR + 128;
    constexpr float THR = 6.f;
    const int tid = fresh_tid(), lane = tid & 63, wid = __builtin_amdgcn_readfirstlane(tid >> 6), l32 = lane & 31, hi = lane >> 5;
    const int head = wid & 3, qtok = 32 * (wid >> 2) + l32;
    const bf16_t* qp = qm + (size_t)(qrow0 + qtok) * QW + head * 160;
    bf16x8 qf[NKS];
#pragma unroll
    for (int ks = 0; ks < NKS; ++ks) qf[ks] = *(const bf16x8*)(qp + 16 * ks + 8 * hi);
    f32x16 o[4];
#pragma unroll
    for (int c = 0; c < 4; ++c)
#pragma unroll
        for (int r = 0; r < 16; ++r) o[c][r] = 0.f;
    float mref = -1e30f, lrun = 0.f;
    const int nmac = 2 + (nlocal >> 1);
#define MLA_TROW(T) ((T) < 2 ? kctx_row0 + 128 * (T) : loc_row0 + 128 * ((T) - 2))
    unsigned dvo[6];
#pragma unroll
    for (int i = 0; i < 6; ++i) { const int sl = (wid * 6 + i) * 64 + lane, g = sl / 161, rem = sl % 161; const bool ok = sl < 2576 && rem < 160;
        const int row = ok ? 8 * g + rem / 20 : 0, ch = ok ? rem % 20 : 0; dvo[i] = (unsigned)(row * (UW * 2) + ch * 16); }
    const char* kbase = (const char*)(u + U_CKV);
#define MLA_DMA(T, buf) do { const char* tb_ = kbase + (size_t)MLA_TROW(T) * (UW * 2); _Pragma("unroll") for (int i = 0; i < 6; ++i) if (wid * 6 + i < 41) \
        __builtin_amdgcn_global_load_lds((const unsigned*)(tb_ + dvo[i]), (LAS unsigned*)(lds + (buf) * STAGE + (wid * 6 + i) * 1024), 16, 0, 0); } while (0)
    MLA_DMA(0, 0); MLA_DMA(1, 1);
    asm volatile("s_waitcnt vmcnt(0)" ::: "memory");
    __syncthreads();
    const int q4 = (lane & 15) >> 2, p4 = lane & 3, blk = (lane >> 4) & 1;
    const int koff = l32 * KSTR + (l32 >> 3) * 16 + 16 * hi;
    const int voff = (4 * hi + q4) * KSTR + 32 * blk + 8 * p4;
    f32x16 sa0, sa1, sb0, sb1;
    u32x4 pw00, pw01, pw10, pw11;
    float mxn;
#define MLA_QKEXP(SD0, SD1, PA0, PA1, KOFF, DOEXP) do { \
        const f32x16 zero16_ = {0.f, 0.f, 0.f, 0.f, 0.f, 0.f, 0.f, 0.f, 0.f, 0.f, 0.f, 0.f, 0.f, 0.f, 0.f, 0.f}; \
        float rs = 0.f; \
        LAS const unsigned char* kp = lds + (KOFF) + koff; \
        bf16x8 ka0 = *(LAS const bf16x8*)(kp), ka1 = *(LAS const bf16x8*)(kp + KB1); \
        _Pragma("unroll") for (int ks = 0; ks < NKS; ++ks) { \
            bf16x8 kb0 = ka0, kb1 = ka1; \
            if (ks + 1 < NKS) { kb0 = *(LAS const bf16x8*)(kp + (ks + 1) * 32); kb1 = *(LAS const bf16x8*)(kp + (ks + 1) * 32 + KB1); } \
            SD0 = __builtin_amdgcn_mfma_f32_32x32x16_bf16(ka0, qf[ks], ks == 0 ? zero16_ : SD0, 0, 0, 0); \
            SD1 = __builtin_amdgcn_mfma_f32_32x32x16_bf16(ka1, qf[ks], ks == 0 ? zero16_ : SD1, 0, 0, 0); \
            if (DOEXP) { \
                if (ks < 4) { _Pragma("unroll") for (int j = 0; j < 4; ++j) { const float p = fexp2(PA0[4 * ks + j] - mref); PA0[4 * ks + j] = p; rs += p; } } \
                else if (ks < 8) { _Pragma("unroll") for (int j = 0; j < 4; ++j) { const float p = fexp2(PA1[4 * (ks - 4) + j] - mref); PA1[4 * (ks - 4) + j] = p; rs += p; } } \
                else if (ks == 8) { pw00 = (u32x4){cvtpk(PA0[0], PA0[1]), cvtpk(PA0[2], PA0[3]), cvtpk(PA0[4], PA0[5]), cvtpk(PA0[6], PA0[7])}; \
                                    pw01 = (u32x4){cvtpk(PA0[8], PA0[9]), cvtpk(PA0[10], PA0[11]), cvtpk(PA0[12], PA0[13]), cvtpk(PA0[14], PA0[15])}; } \
                else { pw10 = (u32x4){cvtpk(PA1[0], PA1[1]), cvtpk(PA1[2], PA1[3]), cvtpk(PA1[4], PA1[5]), cvtpk(PA1[6], PA1[7])}; \
                       pw11 = (u32x4){cvtpk(PA1[8], PA1[9]), cvtpk(PA1[10], PA1[11]), cvtpk(PA1[12], PA1[13]), cvtpk(PA1[14], PA1[15])}; } } \
            __builtin_amdgcn_sched_barrier(0); \
            ka0 = kb0; ka1 = kb1; } \
        lrun += rs; } while (0)
#define MLA_PV(VOFF, M0, M1) do { \
        LAS const unsigned char* vp = lds + (VOFF) + voff; \
        s16x4 vl[16], vh[16]; float mxa, mxb; \
        _Pragma("unroll") for (int it = 0; it < 16; ++it) { const int c = it >> 2, kb = (it >> 1) & 1, s_ = it & 1; \
            vl[it] = vtr(vp + (32 * kb + 16 * s_) * KSTR + 16 * (4 * kb + 2 * s_) + c * 64); vh[it] = vtr(vp + (32 * kb + 16 * s_ + 8) * KSTR + 16 * (4 * kb + 2 * s_ + 1) + c * 64); } \
        _Pragma("unroll") for (int it = 0; it < 16; ++it) { const int c = it >> 2, kb = (it >> 1) & 1, s_ = it & 1; \
            const bf16x8 vf = (bf16x8){vl[it][0], vl[it][1], vl[it][2], vl[it][3], vh[it][0], vh[it][1], vh[it][2], vh[it][3]}; \
            const u32x4 pwv = kb == 0 ? (s_ == 0 ? pw00 : pw01) : (s_ == 0 ? pw10 : pw11); \
            o[c] = __builtin_amdgcn_mfma_f32_32x32x16_bf16(vf, __builtin_bit_cast(bf16x8, pwv), o[c], 0, 0, 0); \
            if (it == 0) { mxa = M0[0]; mxb = M1[0]; } else { mxa = fmaxf(mxa, M0[it]); mxb = fmaxf(mxb, M1[it]); } } \
        mxn = xhalf_max(fmaxf(mxa, mxb)); } while (0)
#define MLA_RESCALE() do { if (__any(mxn > mref + THR)) { const float mnew = fmaxf(mref, mxn), alpha = fexp2(mref - mnew); mref = mnew; lrun *= alpha; \
        _Pragma("unroll") for (int c = 0; c < 4; ++c) _Pragma("unroll") for (int r = 0; r < 16; ++r) o[c][r] *= alpha; } __builtin_amdgcn_sched_barrier(0); } while (0)
    MLA_QKEXP(sa0, sa1, sa0, sa1, 0, false);
    { float a_ = fmaxf(sa0[0], sa1[0]);
#pragma unroll
      for (int r = 1; r < 16; ++r) a_ = fmaxf(a_, fmaxf(sa0[r], sa1[r]));
      mxn = xhalf_max(a_); }
    int bcur = 0;
    for (int T = 0; T < nmac; ++T) {
        const int bnxt = bcur == 2 ? 0 : bcur + 1, bnn = bnxt == 2 ? 0 : bnxt + 1;
        if (T + 2 < nmac) MLA_DMA(T + 2, bnn);
        MLA_RESCALE();
        MLA_QKEXP(sb0, sb1, sa0, sa1, bcur * STAGE + HALFB, true);
        MLA_PV(bcur * STAGE, sb0, sb1);
        MLA_RESCALE();
        MLA_QKEXP(sa0, sa1, sb0, sb1, bnxt * STAGE, true);
        MLA_PV(bcur * STAGE + HALFB, sa0, sa1);
        asm volatile("s_waitcnt vmcnt(0)" ::: "memory");
        __syncthreads();
        bcur = bnxt;
    }
    lrun = xhalf_sum(lrun);
    const float inv = 1.f / lrun;
    bf16_t* yp = y + (size_t)(qrow0 + qtok) * YW + 768 + head * 128 + 4 * hi;
#pragma unroll
    for (int c = 0; c < 4; ++c)
#pragma unroll
        for (int g = 0; g < 4; ++g) { u32x2 w; w.x = cvtpk(o[c][4 * g] * inv, o[c][4 * g + 1] * inv); w.y = cvtpk(o[c][4 * g + 2] * inv, o[c][4 * g + 3] * inv); *(u32x2*)(yp + 32 * c + 8 * g) = w; }
#undef MLA_TROW
#undef MLA_DMA
#undef MLA_QKEXP
#undef MLA_PV
#undef MLA_RESCALE
}

#define XB_TMO      128
#define XB_XCNT(j)  (256  + 64 * (j))
#define XB_XSUB(j)  (1280 + 64 * (j))
#define XB_XGEN(j)  (2304 + 64 * (j))
#define XB_TOP      3328
#define XB_TOPGEN   3392
#define XCD_BAR_WORDS 3456
#define XB_SPIN_CAP (1u << 18)
__device__ __forceinline__ unsigned xb_ld(unsigned* p)              { return __hip_atomic_load(p, __ATOMIC_RELAXED, __HIP_MEMORY_SCOPE_AGENT); }
__device__ __forceinline__ unsigned xb_add(unsigned* p, unsigned v) { return __hip_atomic_fetch_add(p, v, __ATOMIC_RELAXED, __HIP_MEMORY_SCOPE_AGENT); }
__device__ __forceinline__ unsigned xb_xcc_id() { return (unsigned)__builtin_amdgcn_s_getreg((3 << 11) | 20) & 0xFu; }
#define XB_SPIN(cond, bar) do { unsigned _sp = 0; while (cond) { __builtin_amdgcn_s_sleep(1); \
    if ((++_sp & 255u) == 0u) { if (xb_ld(&(bar)[XB_TMO])) break; if (_sp > XB_SPIN_CAP) { atomicAdd(&(bar)[XB_TMO], 1u); break; } } } } while (0)
struct XcdBarrier { unsigned* bar; unsigned x; volatile LAS unsigned* st; };
__device__ __forceinline__ XcdBarrier xcd_barrier_post(unsigned* bar, volatile LAS unsigned* st) {
    XcdBarrier b; b.bar = bar; b.x = xb_xcc_id(); b.st = st;
    if (threadIdx.x == 0) (void)xb_add(&bar[XB_XCNT(b.x)], 1u);
    return b;
}
__device__ __forceinline__ void xcd_barrier_complete(unsigned* bar, unsigned x, unsigned& nloc, unsigned& nx) {
    const unsigned G = gridDim.x * gridDim.y * gridDim.z;
    unsigned sum, cnt, mine, sp = 0u;
    for (;;) {
        sum = 0u; cnt = 0u; mine = 0u;
#pragma unroll
        for (unsigned j = 0; j < 16; ++j) { const unsigned c = xb_ld(&bar[XB_XCNT(j)]); sum += c; cnt += (c > 0u) ? 1u : 0u; mine = (j == x) ? c : mine; }
        if (sum == G) break;
        __builtin_amdgcn_s_sleep(1);
        if ((++sp & 255u) == 0u) { if (xb_ld(&bar[XB_TMO])) break; if (sp > XB_SPIN_CAP) { atomicAdd(&bar[XB_TMO], 1u); break; } }
    }
    nloc = mine > 0u ? mine : 1u; nx = cnt > 0u ? cnt : 1u;
}
__device__ __forceinline__ void xcd_barrier(const XcdBarrier& b) {
    asm volatile("s_waitcnt vmcnt(0)" ::: "memory");
    __syncthreads();
    if (threadIdx.x == 0) {
        unsigned* bar = b.bar; asm volatile("" : "+s"(bar));
        __builtin_amdgcn_s_waitcnt(0);
        unsigned nloc = b.st[0], nx = b.st[1];
        if (nloc == 0u) { xcd_barrier_complete(bar, b.x, nloc, nx); b.st[0] = nloc; b.st[1] = nx; }
        const unsigned old = xb_add(&bar[XB_XSUB(b.x)], 1u);
        const unsigned gen = old / nloc;
        if (old + 1u == (gen + 1u) * nloc) {
            __builtin_amdgcn_fence(__ATOMIC_RELEASE, "agent");
            asm volatile("s_waitcnt vmcnt(0)" ::: "memory");
            const unsigned og = xb_add(&bar[XB_TOP], 1u);
            const unsigned tg = og / nx;
            if (og + 1u == (tg + 1u) * nx) xb_add(&bar[XB_TOPGEN], 1u);
            else XB_SPIN(xb_ld(&bar[XB_TOPGEN]) == tg, bar);
            __builtin_amdgcn_fence(__ATOMIC_ACQUIRE, "agent");
            xb_add(&bar[XB_XGEN(b.x)], 1u);
            asm volatile("s_waitcnt vmcnt(0)" ::: "memory");
        } else {
            XB_SPIN(xb_ld(&bar[XB_XGEN(b.x)]) == gen, bar);
            __builtin_amdgcn_fence(__ATOMIC_ACQUIRE, "agent");
            asm volatile("s_waitcnt vmcnt(0)" ::: "memory");
        }
    }
    __syncthreads();
}

struct Args { const float* in[24]; float* out; unsigned char* ws; };
typedef __attribute__((address_space(4))) const Args CArgs;
__device__ __forceinline__ int fresh_sgpr(int v) { asm volatile("" : "+s"(v)); return v; }
__device__ __forceinline__ CArgs* fresh_args() { CArgs* p = (CArgs*)__builtin_amdgcn_kernarg_segment_ptr(); asm volatile("" : "+s"(p)); return p; }
enum { I_X = 0, I_C, I_CTX, I_CCTX, I_ADAW, I_ADAB, I_N1G, I_N2G, I_WIN, I_POOLW, I_POOLS, I_RPB, I_SINK, I_QNORM, I_KVNORM, I_WUQ, I_WUK, I_WUV, I_WBR, I_WOUT, I_W1, I_W3, I_W2, I_FNG };

__device__ __forceinline__ int rowmap(int mode, int n) {
    if (mode == 0) return n;
    if (mode == 1) { const int i = n >> 10, col = n & 1023, pn = col >> 6, cc = col & 63, wc = cc >> 4, fq = (cc >> 2) & 3, j = cc & 3; return 256 * pn + 128 * (i >> 1) + 32 * wc + 16 * (i & 1) + 4 * fq + j; }
    const int r = 256 * (n >> 7) + (n & 127); return mode == 2 ? r : r + 128;
}
__device__ __forceinline__ void tr_item(const float* __restrict__ W, int ldw, bf16_t* __restrict__ WT, int ldt, int nblk, int mode, LAS float* scr, int item, int lane, bool qscale = false) {
    const int kb = item / nblk, nb = item % nblk, k0 = 64 * kb, n0 = 32 * nb;
    float tv[32];
#pragma unroll
    for (int i = 0; i < 32; ++i) tv[i] = W[(size_t)(k0 + 2 * i + (lane >> 5)) * ldw + n0 + (lane & 31)];
#pragma unroll
    for (int i = 0; i < 32; ++i) scr[(2 * i + (lane >> 5)) * 33 + (lane & 31)] = tv[i];
    asm volatile("s_waitcnt lgkmcnt(0)" ::: "memory");
    const int c = lane & 7;
#pragma unroll
    for (int j = 0; j < 4; ++j) { const int n = (lane >> 3) + 8 * j; const LAS float* s = scr + (8 * c) * 33 + n;
        const float qs = (qscale && n0 + n >= U_NAQ && n0 + n < U_CQ) ? QSC64 : 1.f;
        u32x4 o; o.x = cvtpk(s[0 * 33] * qs, s[1 * 33] * qs); o.y = cvtpk(s[2 * 33] * qs, s[3 * 33] * qs); o.z = cvtpk(s[4 * 33] * qs, s[5 * 33] * qs); o.w = cvtpk(s[6 * 33] * qs, s[7 * 33] * qs);
        *(u32x4*)(WT + (size_t)rowmap(mode, n0 + n) * ldt + k0 + 8 * c) = o; }
    asm volatile("s_waitcnt lgkmcnt(0)" ::: "memory");
}

__global__ void __launch_bounds__(NTHREADS) mk_fwd(Args args) {
    extern __shared__ __attribute__((aligned(16))) unsigned char lds_raw[];
    LAS unsigned char* lds = (LAS unsigned char*)lds_raw;
    cg::grid_group grid = cg::this_grid();
    const int wid = __builtin_amdgcn_readfirstlane(threadIdx.x >> 6);
    const int bx = blockIdx.x;
    unsigned* barw = (unsigned*)args.ws;
    volatile LAS unsigned* bst = (volatile LAS unsigned*)(lds + LDS_BYTES - 16);
    if (threadIdx.x == 0) { bst[0] = 0u; bst[1] = 0u; }
    __syncthreads();
    if (gridDim.x == 0x7fffffffu) grid.sync();
    XcdBarrier xbar = xcd_barrier_post(barw, bst);
#define PH_BEGIN { const int tid = fresh_tid(); const int lane = tid & 63; (void)tid; (void)lane; CArgs* ap = fresh_args(); const int bx = fresh_sgpr((int)blockIdx.x); const int G = fresh_sgpr((int)gridDim.x); const int gw = bx * 8 + wid, NGW = G * 8; (void)gw; (void)NGW; unsigned char* ws = ap->ws; float* out = ap->out; \
    float* mod = (float*)(ws + WS_MOD); float* xc = (float*)(ws + WS_XC); bf16_t* Hb = (bf16_t*)(ws + WS_H); bf16_t* Yb = (bf16_t*)(ws + WS_Y); bf16_t* Ub = (bf16_t*)(ws + WS_R4); \
    bf16_t* Qm = (bf16_t*)(ws + WS_QM); bf16_t* Yall = (bf16_t*)(ws + WS_R4); bf16_t* Hid = (bf16_t*)(ws + WS_R4); bf16_t* Mg = (bf16_t*)(ws + WS_Y); \
    (void)mod; (void)xc; (void)Hb; (void)Yb; (void)Ub; (void)Qm; (void)Yall; (void)Hid; (void)Mg; (void)out;
#define PH_LAYER unsigned char* wl = ws + WS_W + (size_t)l * WL; const float* modl = mod + (size_t)l * 3 * 6144; const float* xres = l == 0 ? ap->in[I_X] : out; const float* cres = l == 0 ? ap->in[I_CTX] : xc; \
    const int Mq = l == 0 ? MT : NLAT; (void)wl; (void)modl; (void)xres; (void)cres; (void)Mq;
#define PH_END   xcd_barrier(xbar); }
#define PH_END0  xcd_barrier(xbar); }
#define PH_ENDL  }

    PH_BEGIN
    {
        LAS float* scr = (LAS float*)(lds + wid * 16384);
        constexpr int T_U = 976, T_G = 2048, T_B = 128, T_O = 512, T_1 = 1408, T_2 = 1408;
        constexpr int LTOT = T_U + T_G + 2 * T_B + T_O + 2 * T_1 + T_2;
        for (int it = gw; it < DEPTH * LTOT; it += NGW) {
            const int l = it / LTOT; int r = it % LTOT;
            unsigned char* wl = ws + WS_W + (size_t)l * WL;
            const float* win = ap->in[I_WIN] + (size_t)l * D * INC;
            if (r < T_U) { tr_item(win, INC, (bf16_t*)(wl + W_U), D, 61, 0, scr, r, lane, true); continue; } r -= T_U;
            if (r < T_G) { tr_item(win + U_END, INC, (bf16_t*)(wl + W_G), D, 128, 1, scr, r, lane); continue; } r -= T_G;
            if (r < T_B) { tr_item(ap->in[I_WBR] + ((size_t)l * 4 + 1) * 256 * D, D, (bf16_t*)(wl + W_B) + (size_t)1 * 1024 * 512, 512, 32, 0, scr, r, lane); continue; } r -= T_B;
            if (r < T_B) { tr_item(ap->in[I_WBR] + ((size_t)l * 4 + 2) * 256 * D, D, (bf16_t*)(wl + W_B) + (size_t)2 * 1024 * 512, 512, 32, 0, scr, r, lane); continue; } r -= T_B;
            if (r < T_O) { tr_item(ap->in[I_WOUT] + (size_t)l * D * D, D, (bf16_t*)(wl + W_O), D, 32, 0, scr, r, lane); continue; } r -= T_O;
            if (r < T_1) { tr_item(ap->in[I_W1] + (size_t)l * D * FF, FF, (bf16_t*)(wl + W_13), D, 88, 2, scr, r, lane); continue; } r -= T_1;
            if (r < T_1) { tr_item(ap->in[I_W3] + (size_t)l * D * FF, FF, (bf16_t*)(wl + W_13), D, 88, 3, scr, r, lane); continue; } r -= T_1;
            tr_item(ap->in[I_W2] + (size_t)l * FF * D, D, (bf16_t*)(wl + W_2), FF, 32, 0, scr, r, lane);
        }
        constexpr int F_Q = 640 * 256, F_3 = 512 * 256, F_0 = 256 * 256, FTOT = F_Q + F_3 + F_0;
        for (int it = bx * NTHREADS + tid; it < DEPTH * FTOT; it += G * NTHREADS) {
            const int l = it / FTOT; int r = it % FTOT;
            unsigned char* wl = ws + WS_W + (size_t)l * WL;
            if (r < F_Q) {
                const int k = r / 640, n = r % 640, h = n / 160, c = n % 160;
                const float* uq = ap->in[I_WUQ] + (size_t)l * 256 * 384 + (size_t)k * 384 + h * 96;
                float s;
                if (c < 128) { const float* uk = ap->in[I_WUK] + (size_t)l * 128 * 256 + (size_t)c * 256 + h * 64; f32x4 a4 = {0.f, 0.f, 0.f, 0.f};
#pragma unroll
                    for (int d = 0; d < 64; d += 4) a4 += *(const f32x4*)(uq + d) * *(const f32x4*)(uk + d);
                    s = (a4[0] + a4[1]) + (a4[2] + a4[3]); }
                else s = uq[64 + (c - 128)];
                ((bf16_t*)(wl + W_QF))[(size_t)n * 256 + k] = f2bf(s * QSCMLA);
            } else if (r < F_Q + F_3) {
                r -= F_Q; const int k = r / 256, n = (r % 256) * 4, h = k / 128, c = k % 128;
                const float* uv = ap->in[I_WUV] + (size_t)l * 128 * 256 + (size_t)c * 256 + h * 64;
                const float* wb = ap->in[I_WBR] + ((size_t)l * 4 + 3) * 256 * D + (size_t)(h * 64) * D + n;
                f32x4 a4 = {0.f, 0.f, 0.f, 0.f};
#pragma unroll 16
                for (int d = 0; d < 64; ++d) a4 += *(const f32x4*)(wb + (size_t)d * D) * uv[d];
                bf16_t* dst = (bf16_t*)(wl + W_B) + (size_t)3 * 1024 * 512 + (size_t)n * 512 + k;
                dst[0] = f2bf(a4[0]); dst[512] = f2bf(a4[1]); dst[1024] = f2bf(a4[2]); dst[1536] = f2bf(a4[3]);
            } else {
                r -= F_Q + F_3; const int k = r / 256, n = (r % 256) * 4, g = k / 64, c = k % 64;
                const float* pw = ap->in[I_POOLW] + (size_t)l * 4 * 64 * 64 + (size_t)g * 4096 + c * 64;
                const float* ps = ap->in[I_POOLS] + (size_t)l * 256 + g * 64;
                const float* wb = ap->in[I_WBR] + ((size_t)l * 4 + 0) * 256 * D + (size_t)(g * 64) * D + n;
                f32x4 a4 = {0.f, 0.f, 0.f, 0.f};
#pragma unroll 16
                for (int d = 0; d < 64; ++d) a4 += *(const f32x4*)(wb + (size_t)d * D) * (pw[d] * ps[d]);
                bf16_t* dst = (bf16_t*)(wl + W_B) + (size_t)n * 512 + k;
                dst[0] = f2bf(a4[0]); dst[512] = f2bf(a4[1]); dst[1024] = f2bf(a4[2]); dst[1536] = f2bf(a4[3]);
            }
        }
        __syncthreads();
        LAS float* sc = (LAS float*)lds;
        LAS float* red = sc + 3072;
        for (int i = tid; i < 3072; i += NTHREADS) { const int v = i >> 10, k = i & 1023; const float cv = v < 2 ? ap->in[I_C][v * D + k] : ap->in[I_CCTX][k]; sc[i] = cv / (1.f + expf(-cv)); }
        __syncthreads();
        for (int it = bx; it < DEPTH * 96; it += G) {
            const int l = it / 96, cgp = it % 96, col = cgp * 64 + lane;
            const float* aw = ap->in[I_ADAW] + (size_t)l * D * 6144 + col;
            float a0 = 0.f, a1 = 0.f, a2 = 0.f;
#pragma unroll 1
            for (int k0 = wid * 128; k0 < wid * 128 + 128; k0 += 32) { float wv[32];
#pragma unroll
                for (int j = 0; j < 32; ++j) wv[j] = aw[(size_t)(k0 + j) * 6144];
#pragma unroll
                for (int j = 0; j < 32; ++j) { a0 += sc[k0 + j] * wv[j]; a1 += sc[1024 + k0 + j] * wv[j]; a2 += sc[2048 + k0 + j] * wv[j]; } }
            red[(wid * 3 + 0) * 64 + lane] = a0; red[(wid * 3 + 1) * 64 + lane] = a1; red[(wid * 3 + 2) * 64 + lane] = a2;
            __syncthreads();
            if (tid < 192) { const int v = tid >> 6, ln = tid & 63; float s = 0.f;
#pragma unroll
                for (int w = 0; w < 8; ++w) s += red[(w * 3 + v) * 64 + ln];
                const int colo = cgp * 64 + ln; mod[(l * 3 + v) * 6144 + colo] = s + ap->in[I_ADAB][l * 6144 + colo]; }
            __syncthreads();
        }
    }
    PH_END0

    for (int l = 0; l < DEPTH; ++l) {

#define NORM_PHASE(XL, XC, GAMMA, SHC, SCC, LB) \
        for (int r0 = gw * 4; r0 < MT; r0 += NGW * 4) { \
            const float* src = r0 < NLAT ? (XL) + (size_t)r0 * D : (XC) + (size_t)(r0 - NLAT) * D; \
            const int v = r0 < NLAT ? r0 / SEQ : 2; const float* mv = modl + v * 6144; \
            f32x4 xv[4][4]; float ss[4]; \
            if ((LB) && r0 < NLAT) { const bf16_t* sb_ = (const bf16_t*)out + (size_t)r0 * 2048 + 1024; \
                _Pragma("unroll") for (int rr = 0; rr < 4; ++rr) _Pragma("unroll") for (int j = 0; j < 4; ++j) { const u32x2 w_ = *(const u32x2*)(sb_ + rr * 2048 + lane * 4 + 256 * j); xv[rr][j] = (f32x4){bflo(w_.x), bfhi(w_.x), bflo(w_.y), bfhi(w_.y)}; } } \
            else { _Pragma("unroll") for (int rr = 0; rr < 4; ++rr) _Pragma("unroll") for (int j = 0; j < 4; ++j) xv[rr][j] = *(const f32x4*)(src + rr * D + lane * 4 + 256 * j); } \
            _Pragma("unroll") for (int rr = 0; rr < 4; ++rr) { float a_ = 0.f; _Pragma("unroll") for (int j = 0; j < 4; ++j) a_ += xv[rr][j][0] * xv[rr][j][0] + xv[rr][j][1] * xv[rr][j][1] + xv[rr][j][2] * xv[rr][j][2] + xv[rr][j][3] * xv[rr][j][3]; ss[rr] = a_; } \
            _Pragma("unroll") for (int o_ = 1; o_ < 64; o_ <<= 1) _Pragma("unroll") for (int rr = 0; rr < 4; ++rr) ss[rr] += __uint_as_float((unsigned)__builtin_amdgcn_ds_bpermute((lane ^ o_) << 2, (int)__float_as_uint(ss[rr]))); \
            _Pragma("unroll") for (int rr = 0; rr < 4; ++rr) ss[rr] = rsqrtf(ss[rr] * (1.f / D) + EPSV); \
            _Pragma("unroll") for (int j = 0; j < 4; ++j) { const int c0 = lane * 4 + 256 * j; const f32x4 g = *(const f32x4*)((GAMMA) + c0), sh = *(const f32x4*)(mv + (SHC) * D + c0), sc = *(const f32x4*)(mv + (SCC) * D + c0); \
                const f32x4 gs = g * (sc + 1.f); \
                _Pragma("unroll") for (int rr = 0; rr < 4; ++rr) { const f32x4 yv = xv[rr][j] * ss[rr] * gs + sh; u32x2 w; w.x = cvtpk(yv[0], yv[1]); w.y = cvtpk(yv[2], yv[3]); *(u32x2*)(Hb + (size_t)(r0 + rr) * D + c0) = w; } } \
        }
        PH_BEGIN PH_LAYER
        NORM_PHASE(ap->in[I_X], cres, ap->in[I_N1G] + l * D, 0, 1, l != 0)
        PH_END

        PH_BEGIN PH_LAYER
        { pg8::SchedPlain S; S.so.init(MT, UW, G, bx); S.A = (const char*)Hb; S.B = (const char*)(wl + W_U); S.a_t = (size_t)256 * D * 2; S.b_t = (size_t)256 * D * 2; S.nt = D / 64;
          EpiStore E{Ub, UW}; pg8::gemm_phase(lds, D * 2, D * 2, S, E); }
        PH_END

        PH_BEGIN PH_LAYER
        {
            const float* qng = ap->in[I_QNORM] + l * 256; const float* kvg = ap->in[I_KVNORM] + l * 128;
            const f32x4 gq = *(const f32x4*)(qng + lane * 4); const float gk0 = kvg[lane * 2], gk1 = kvg[lane * 2 + 1];
            const int si = 2 * (lane & 15);
            const float sf0 = exp2f(-(float)(si & 15) * 0.8304820237218406f), sf1 = exp2f(-(float)((si + 1) & 15) * 0.8304820237218406f);
            const int ki = 2 * (lane & 7);
            const float kf0 = exp2f(-(float)(ki & 7) * 1.6609640474436813f), kf1 = exp2f(-(float)((ki + 1) & 7) * 1.6609640474436813f);
            const int pg = lane >> 4, pw_ = 2 << pg;
#define P2B_DECL(S) bf16_t* ur##S; int tloc##S, nseq##S, base##S; bool lat##S; u32x2 cq##S, ps##S, nb##S[16]; unsigned ckv##S, q1##S, q2##S, k1##S = 0, k2##S = 0, r1##S = 0, r2##S = 0;
#define P2B_LOAD(S, ROW) do { const int row_ = (ROW); ur##S = Ub + (size_t)row_ * UW; lat##S = row_ < NLAT; \
                if (lat##S) { tloc##S = row_ & (SEQ - 1); nseq##S = SEQ; } else { tloc##S = (row_ - NLAT) & (CTXL - 1); nseq##S = CTXL; } base##S = row_ - tloc##S; \
                cq##S = *(const u32x2*)(ur##S + U_CQ + lane * 4); ckv##S = *(const unsigned*)(ur##S + U_CKV + lane * 2); ps##S = *(const u32x2*)(ur##S + U_POOL + lane * 4); \
                q1##S = *(const unsigned*)(ur##S + U_SWQ + (lane >> 4) * 64 + si); q2##S = *(const unsigned*)(ur##S + U_SWQ + (lane >> 4) * 64 + 32 + si); \
                if (lat##S) { if (lane < 32) { k1##S = *(const unsigned*)(ur##S + U_SWK + (lane >> 4) * 64 + si); k2##S = *(const unsigned*)(ur##S + U_SWK + (lane >> 4) * 64 + 32 + si); } \
                              if (lane < 8) { r1##S = *(const unsigned*)(ur##S + U_KR + ki); r2##S = *(const unsigned*)(ur##S + U_KR + 16 + ki); } } \
                _Pragma("unroll") for (int i = 0; i < 16; ++i) { const int t_ = min(max(tloc##S - 8 + i, 0), nseq##S - 1); nb##S[i] = *(const u32x2*)(Ub + (size_t)(base##S + t_) * UW + U_POOL + lane * 4); } } while (0)
#define P2B_PROC(S, ROW) do { const int row_ = (ROW); const float prow = (float)(tloc##S >> 6), pcol = (float)(tloc##S & 63); \
                { float a = bflo(cq##S.x), b = bfhi(cq##S.x), c = bflo(cq##S.y), d = bfhi(cq##S.y); float sq = a * a + b * b + c * c + d * d; float a2 = bflo(ckv##S), b2 = bfhi(ckv##S); float sk = a2 * a2 + b2 * b2; \
                  _Pragma("unroll") for (int o_ = 1; o_ < 64; o_ <<= 1) { sq += __uint_as_float((unsigned)__builtin_amdgcn_ds_bpermute((lane ^ o_) << 2, (int)__float_as_uint(sq))); sk += __uint_as_float((unsigned)__builtin_amdgcn_ds_bpermute((lane ^ o_) << 2, (int)__float_as_uint(sk))); } \
                  const float rq = rsqrtf(sq * (1.f / 256.f) + EPSV), rk = rsqrtf(sk * (1.f / 128.f) + EPSV); u32x2 w; w.x = cvtpk(a * rq * gq[0], b * rq * gq[1]); w.y = cvtpk(c * rq * gq[2], d * rq * gq[3]); \
                  *(u32x2*)(ur##S + U_CQ + lane * 4) = w; *(unsigned*)(ur##S + U_CKV + lane * 2) = cvtpk(a2 * rk * gk0, b2 * rk * gk1); } \
                if (lat##S) { const float ps_ = si < 16 ? prow : pcol; const float a0 = ps_ * sf0, a1 = ps_ * sf1; const float c0 = __cosf(a0), s0 = __sinf(a0), c1 = __cosf(a1), s1 = __sinf(a1); \
                  { const float x1a = bflo(q1##S), x1b = bfhi(q1##S), x2a = bflo(q2##S), x2b = bfhi(q2##S); \
                    *(unsigned*)(ur##S + U_SWQ + (lane >> 4) * 64 + si) = cvtpk(x1a * c0 - x2a * s0, x1b * c1 - x2b * s1); *(unsigned*)(ur##S + U_SWQ + (lane >> 4) * 64 + 32 + si) = cvtpk(x2a * c0 + x1a * s0, x2b * c1 + x1b * s1); } \
                  if (lane < 32) { const float x1a = bflo(k1##S), x1b = bfhi(k1##S), x2a = bflo(k2##S), x2b = bfhi(k2##S); \
                    *(unsigned*)(ur##S + U_SWK + (lane >> 4) * 64 + si) = cvtpk(x1a * c0 - x2a * s0, x1b * c1 - x2b * s1); *(unsigned*)(ur##S + U_SWK + (lane >> 4) * 64 + 32 + si) = cvtpk(x2a * c0 + x1a * s0, x2b * c1 + x1b * s1); } \
                  if (lane < 8) { const float pk_ = ki < 8 ? prow : pcol; const float b0 = pk_ * kf0, b1 = pk_ * kf1; const float d0 = __cosf(b0), e0 = __sinf(b0), d1 = __cosf(b1), e1 = __sinf(b1); \
                    const float x1a = bflo(r1##S), x1b = bfhi(r1##S), x2a = bflo(r2##S), x2b = bfhi(r2##S); \
                    *(unsigned*)(ur##S + U_KR + ki) = cvtpk(x1a * d0 - x2a * e0, x1b * d1 - x2b * e1); *(unsigned*)(ur##S + U_KR + 16 + ki) = cvtpk(x2a * d0 + x1a * e0, x2b * d1 + x1b * e1); } } \
                { const int plo = max(tloc##S - (pw_ >> 1), 0), phi = min(tloc##S - (pw_ >> 1) + pw_, nseq##S); f32x4 s_ = {0.f, 0.f, 0.f, 0.f}; \
                  _Pragma("unroll") for (int i = 0; i < 16; ++i) { const int t_ = tloc##S - 8 + i; const float wt = (t_ >= plo && t_ < phi) ? 1.f : 0.f; \
                      s_[0] += wt * bflo(nb##S[i].x); s_[1] += wt * bfhi(nb##S[i].x); s_[2] += wt * bflo(nb##S[i].y); s_[3] += wt * bfhi(nb##S[i].y); } \
                  const float ic = 1.f / (float)(phi - plo); u32x2 o_; o_.x = cvtpk(s_[0] * ic - bflo(ps##S.x), s_[1] * ic - bfhi(ps##S.x)); o_.y = cvtpk(s_[2] * ic - bflo(ps##S.y), s_[3] * ic - bfhi(ps##S.y)); \
                  *(u32x2*)(Yb + (size_t)row_ * YW + lane * 4) = o_; } } while (0)
            P2B_DECL(A) P2B_DECL(B)
            for (int row = gw * 2; row < MT; row += NGW * 2) {
                P2B_LOAD(A, row); P2B_LOAD(B, row + 1);
                P2B_PROC(A, row); P2B_PROC(B, row + 1);
            }
#undef P2B_DECL
#undef P2B_LOAD
#undef P2B_PROC
        }
        PH_END

        PH_BEGIN PH_LAYER
        { pg8::SchedPlain S; S.so.init(Mq, QW, G, bx); S.A = (const char*)(Ub + U_CQ); S.B = (const char*)(wl + W_QF); S.a_t = (size_t)256 * UW * 2; S.b_t = (size_t)256 * 256 * 2; S.nt = 4;
          EpiQRope E{Qm}; pg8::gemm_phase(lds, UW * 2, 256 * 2, S, E); }
        PH_END

        PH_BEGIN PH_LAYER
        {
            const float* rpb = ap->in[I_RPB] + (size_t)l * 4 * 15 * 31; const float* snk = ap->in[I_SINK] + l * 4;
            for (int i = bx; i < 512; i += G) { const int b = i >> 8, tb = i & 255;
                mla_unit(lds, Ub, Qm, Yb, b * SEQ + tb * 64, NLAT + b * CTXL, 256, b * SEQ); }
            for (int i = bx; i < 512; i += G) { const int b = i >> 8, r = i & 255, r0 = min(max(r - 4, 0), 248);
                attn_unit<1>(lds, Ub, Qm, Yb, rpb, snk, b * SEQ + r * 64, NLAT + b * CTXL, 8, b * SEQ + r0 * 64, r, r0, 0); }
            for (int i = bx; i < 512; i += G) { const int b = i >> 8, rem = i & 255, kvh = rem >> 7, n = rem & 127;
                const int jlo = n == 0 ? 2 : 0, jhi = n == 127 ? 4 : 6, kp0 = (n - 1) * 128 + 64 * jlo;
                attn_unit<2>(lds, Ub, Qm, Yb, rpb, snk, b * SEQ + n * 128, NLAT + b * CTXL, jhi - jlo, b * SEQ + kp0, n * 128, kp0, kvh); }
            if (l == 0) {
                for (int i = bx; i < 24; i += G) { const int kind = i >> 3, j = i & 7, b = j >> 2;
                    if (kind == 0) mla_unit(lds, Ub, Qm, Yb, NLAT + b * CTXL + 64 * (j & 3), NLAT + b * CTXL, 0, 0);
                    else if (kind == 1) attn_unit<1>(lds, Ub, Qm, Yb, rpb, snk, NLAT + b * CTXL + 64 * (j & 3), NLAT + b * CTXL, 0, 0, 0, 0, 0);
                    else attn_unit<2>(lds, Ub, Qm, Yb, rpb, snk, NLAT + b * CTXL + 128 * (j & 1), NLAT + b * CTXL, 0, 0, 0, 0, (j >> 1) & 1); }
            }
        }
        PH_END

        PH_BEGIN PH_LAYER
        { pg8::SchedBranch S; S.so.init(Mq, 4096, G, bx); S.A = (const char*)Yb; S.B = (const char*)(wl + W_B); S.a_t = (size_t)256 * YW * 2;
          EpiStore E{Yall, 4096}; pg8::gemm_phase(lds, YW * 2, 512 * 2, S, E); }
        PH_END

        PH_BEGIN PH_LAYER
        { pg8::SchedPlain S; S.so.init(Mq, 4096, G, bx); S.A = (const char*)Hb; S.B = (const char*)(wl + W_G); S.a_t = (size_t)256 * D * 2; S.b_t = (size_t)256 * D * 2; S.nt = D / 64;
          EpiMerge E{Yall, Mg}; pg8::gemm_phase(lds, D * 2, D * 2, S, E); }
        PH_END

        PH_BEGIN PH_LAYER
        { pg8::SchedPlain S; S.so.init(Mq, D, G, bx); S.A = (const char*)Mg; S.B = (const char*)(wl + W_O); S.a_t = (size_t)256 * D * 2; S.b_t = (size_t)256 * D * 2; S.nt = D / 64;
          EpiResid E{l == 0 ? ap->in[I_X] : nullptr, (bf16_t*)out, cres, xc, modl + 2 * D}; pg8::gemm_phase(lds, D * 2, D * 2, S, E); }
        PH_END

        PH_BEGIN PH_LAYER
        NORM_PHASE(out, xc, ap->in[I_N2G] + l * D, 3, 4, true)
        PH_END

        PH_BEGIN PH_LAYER
        { pg8::SchedPlain S; S.so.init(Mq, 2 * FF, G, bx); S.A = (const char*)Hb; S.B = (const char*)(wl + W_13); S.a_t = (size_t)256 * D * 2; S.b_t = (size_t)256 * D * 2; S.nt = D / 64;
          EpiSwiGLU E{Hid}; pg8::gemm_phase(lds, D * 2, D * 2, S, E); }
        PH_END

        PH_BEGIN PH_LAYER
        { pg8::SchedPlain S; S.so.init(Mq, D, G, bx); S.A = (const char*)Hid; S.B = (const char*)(wl + W_2); S.a_t = (size_t)256 * FF * 2; S.b_t = (size_t)256 * FF * 2; S.nt = FF / 64;
          EpiResid E{nullptr, (bf16_t*)out, xc, xc, modl + 5 * D}; pg8::gemm_phase(lds, FF * 2, FF * 2, S, E); }
        PH_END
    }

    PH_BEGIN
    {
        const float* fg = ap->in[I_FNG];
        for (int r0 = gw * 4; r0 < NLAT; r0 += NGW * 4) {
            float* src = out + (size_t)r0 * D; f32x4 xv[4][4]; float ss[4];
            const bf16_t* sb_ = (const bf16_t*)out + (size_t)r0 * 2048 + 1024;
#pragma unroll
            for (int rr = 0; rr < 4; ++rr)
#pragma unroll
                for (int j = 0; j < 4; ++j) { const u32x2 w_ = *(const u32x2*)(sb_ + rr * 2048 + lane * 4 + 256 * j); xv[rr][j] = (f32x4){bflo(w_.x), bfhi(w_.x), bflo(w_.y), bfhi(w_.y)}; }
            asm volatile("s_waitcnt vmcnt(0)" ::: "memory");
#pragma unroll
            for (int rr = 0; rr < 4; ++rr) { float a_ = 0.f;
#pragma unroll
                for (int j = 0; j < 4; ++j) a_ += xv[rr][j][0] * xv[rr][j][0] + xv[rr][j][1] * xv[rr][j][1] + xv[rr][j][2] * xv[rr][j][2] + xv[rr][j][3] * xv[rr][j][3];
                ss[rr] = a_; }
#pragma unroll
            for (int o_ = 1; o_ < 64; o_ <<= 1)
#pragma unroll
                for (int rr = 0; rr < 4; ++rr) ss[rr] += __uint_as_float((unsigned)__builtin_amdgcn_ds_bpermute((lane ^ o_) << 2, (int)__float_as_uint(ss[rr])));
#pragma unroll
            for (int rr = 0; rr < 4; ++rr) ss[rr] = rsqrtf(ss[rr] * (1.f / D) + EPSV);
#pragma unroll
            for (int j = 0; j < 4; ++j) { const f32x4 g = *(const f32x4*)(fg + lane * 4 + 256 * j);
#pragma unroll
                for (int rr = 0; rr < 4; ++rr) *(f32x4*)(src + rr * D + lane * 4 + 256 * j) = xv[rr][j] * ss[rr] * g; }
        }
    }
    PH_ENDL
}

extern "C" void kernel_launch(void* const* d_in, const int* in_sizes, int n_in, void* d_out, int out_size, void* d_ws, size_t ws_size, hipStream_t stream) {
    static int grid = 0;
    if (grid == 0) {
        if (n_in != 24 || out_size != NLAT * D || ws_size < WS_END) { fprintf(stderr, "kernel_launch: unexpected shapes (n_in %d out %d ws %zu)\n", n_in, out_size, ws_size); grid = -1; return; }
        int dev = 0, cus = 0, per_cu = 0;
        hipGetDevice(&dev);
        hipDeviceGetAttribute(&cus, hipDeviceAttributeMultiprocessorCount, dev);
        hipFuncSetAttribute((const void*)mk_fwd, hipFuncAttributeMaxDynamicSharedMemorySize, LDS_BYTES);
        hipOccupancyMaxActiveBlocksPerMultiprocessor(&per_cu, (const void*)mk_fwd, NTHREADS, LDS_BYTES);
        if (per_cu < 1) { fprintf(stderr, "kernel_launch: occupancy query returned %d\n", per_cu); per_cu = 1; }
        (void)hipGetLastError();
        grid = cus * per_cu;
    }
    if (grid < 0) return;
    Args a{};
    for (int i = 0; i < 24; ++i) a.in[i] = (const float*)d_in[i];
    a.out = (float*)d_out; a.ws = (unsigned char*)d_ws;
    if (hipMemsetAsync(d_ws, 0, XCD_BAR_WORDS * 4, stream) != hipSuccess) { fprintf(stderr, "memset of barrier words failed\n"); return; }
    void* kargs[] = {&a};
    hipError_t e = hipLaunchCooperativeKernel((const void*)mk_fwd, dim3(grid), dim3(NTHREADS), kargs, LDS_BYTES, stream);
    if (e != hipSuccess) fprintf(stderr, "cooperative launch failed: %s (grid %d)\n", hipGetErrorString(e), grid);
}
```

```cpp
#include <hip/hip_runtime.h>
#include <hip/hip_cooperative_groups.h>
#include <cstdio>
#include <cstdint>
namespace cg = cooperative_groups;

#define LAS __attribute__((address_space(3)))
typedef unsigned short bf16_t;
typedef short bf16x8 __attribute__((ext_vector_type(8)));
typedef short s16x4 __attribute__((ext_vector_type(4)));
typedef short v4i16_t __attribute__((ext_vector_type(4)));
typedef float f32x4 __attribute__((ext_vector_type(4)));
typedef float f32x16 __attribute__((ext_vector_type(16)));
typedef unsigned u32x4 __attribute__((ext_vector_type(4)));
typedef unsigned u32x2 __attribute__((ext_vector_type(2)));
typedef float f32x2_t __attribute__((ext_vector_type(2)));
typedef __bf16 bf16x2_t __attribute__((ext_vector_type(2)));

constexpr int D = 1024, NB = 2, SEQ = 16384, NLAT = NB * SEQ, CTXL = 256, NCTX = NB * CTXL, MT = NLAT + NCTX;
constexpr int INC = 6048, FF = 2816, DEPTH = 2;
constexpr int UW = 2048, QW = 768, YW = 1280;
constexpr int U_NAK = 0, U_NAV = 256, U_SWK = 512, U_SWV = 640, U_CKV = 768, U_KR = 896, U_NAQ = 928, U_SWQ = 1184, U_CQ = 1440, U_POOL = 1696, U_END = 1952;
constexpr float EPSV = 1e-6f;
constexpr float LOG2E = 1.4426950408889634f;
constexpr float QSC64 = 0.125f * LOG2E;
constexpr float QSCMLA = 0.10206207261596577f * LOG2E;

constexpr size_t MiB = 1u << 20;
constexpr size_t WS_MOD = 1 * MiB, WS_XC = 2 * MiB, WS_W = 8 * MiB, WS_H = 80 * MiB, WS_Y = 145 * MiB, WS_R4 = 227 * MiB, WS_QM = WS_R4 + 130 * MiB, WS_END = 487 * MiB;
constexpr size_t WL = 35 * MiB;
constexpr size_t W_U = 0, W_G = 4 * MiB, W_QF = 12 * MiB, W_B = 12 * MiB + 512 * 1024, W_O = 16 * MiB + 512 * 1024, W_13 = 18 * MiB + 512 * 1024, W_2 = 29 * MiB + 512 * 1024;

constexpr int NTHREADS = 512;
constexpr int LDS_BYTES = 147456;

__device__ __forceinline__ unsigned cvtpk(float lo, float hi) { f32x2_t v = {lo, hi}; bf16x2_t b = __builtin_convertvector(v, bf16x2_t); return __builtin_bit_cast(unsigned, b); }
__device__ __forceinline__ float bflo(unsigned w) { return __uint_as_float(w << 16); }
__device__ __forceinline__ float bfhi(unsigned w) { return __uint_as_float(w & 0xffff0000u); }
__device__ __forceinline__ float bf2f(bf16_t h) { return __uint_as_float(((unsigned)h) << 16); }
__device__ __forceinline__ bf16_t f2bf(float f) { return (bf16_t)(cvtpk(f, 0.f) & 0xffffu); }
__device__ __forceinline__ float wave_sum_l(float v, int lane) {
#pragma unroll
    for (int o = 1; o < 64; o <<= 1) v += __uint_as_float((unsigned)__builtin_amdgcn_ds_bpermute((lane ^ o) << 2, (int)__float_as_uint(v)));
    return v;
}
__device__ __forceinline__ float xhalf_max(float m) { auto rr = __builtin_amdgcn_permlane32_swap(__float_as_uint(m), __float_as_uint(m), false, false); return fmaxf(__uint_as_float(rr[0]), __uint_as_float(rr[1])); }
__device__ __forceinline__ float xhalf_sum(float m) { auto rr = __builtin_amdgcn_permlane32_swap(__float_as_uint(m), __float_as_uint(m), false, false); return __uint_as_float(rr[0]) + __uint_as_float(rr[1]); }
__device__ __forceinline__ int fresh_tid() { int t = threadIdx.x; asm volatile("" : "+v"(t)); return t; }
__device__ __forceinline__ float fexp2(float x) { return __builtin_amdgcn_exp2f(x); }
__device__ __forceinline__ float frcp(float x) { return __builtin_amdgcn_rcpf(x); }
__device__ __forceinline__ float sigmoidf_(float x) { return frcp(1.f + fexp2(-x * LOG2E)); }

namespace pg8 {
constexpr int BM = 256, BK = 64, HALF = 128, HTB = HALF * BK * 2, STAGE_BYTES = 8 * HTB, NXCD = 8, WGM = 8;
__device__ __forceinline__ int lds_byte(int r, int c) { const int st = (r >> 4) * 2 + (c >> 5), rr = r & 15, cc = c & 31, ob = rr * 64 + cc * 2; return st * 1024 + (ob ^ (((ob >> 9) & 1) << 5)); }
__device__ __forceinline__ void stage_rc(int b, int& R, int& C) { const int st = b / 1024, sb = b % 1024, swz = sb ^ (((sb >> 9) & 1) << 5); R = (st >> 1) * 16 + swz / 64; C = (st & 1) * 32 + (swz % 64) / 2; }

struct Unit { const char* A; const char* B; int pm, pn, nt; };

struct StaticOrder {
    int nM, nN, nwg, G, c;
    __device__ void init(int M, int N, int G_, int c_) { nM = M / BM; nN = N / BM; nwg = nM * nN; G = G_; c = c_; }
    __device__ bool next(int i, int& pm, int& pn) const {
        const long L = (long)i * G + c; if (L >= nwg) return false;
        int wgid = (int)L; { const int q = nwg / NXCD, r = nwg % NXCD, xcd = wgid % NXCD, off = wgid / NXCD; wgid = (xcd < r ? xcd * (q + 1) : r * (q + 1) + (xcd - r) * q) + off; }
        const int nig = WGM * nN, gid = wgid / nig, fm = gid * WGM, gsz = (nM - fm) < WGM ? (nM - fm) : WGM;
        pm = fm + ((wgid % nig) % gsz); pn = (wgid % nig) / gsz; return true;
    }
};
struct SchedPlain {
    StaticOrder so; const char* A; const char* B; size_t a_t, b_t; int nt;
    __device__ bool next(int i, Unit& u) const { int pm, pn; if (!so.next(i, pm, pn)) return false; u.pm = pm; u.pn = pn; u.A = A + (size_t)pm * a_t; u.B = B + (size_t)pn * b_t; u.nt = nt; return true; }
};
struct SchedBranch {
    StaticOrder so; const char* A; const char* B; size_t a_t;
    __device__ bool next(int i, Unit& u) const { int pm, pn; if (!so.next(i, pm, pn)) return false; u.pm = pm; u.pn = pn; const int br = pn >> 2;
        u.A = A + (size_t)pm * a_t + (size_t)br * 512; u.B = B + (size_t)br * (1024 * 512 * 2) + (size_t)(pn & 3) * (256 * 512 * 2); u.nt = br == 3 ? 8 : 4; return true; }
};

template <class Epi, class Sched>
__device__ __forceinline__ void gemm_phase(LAS unsigned char* lds, const int lda, const int ldb, const Sched& S, Epi& E) {
    const int tid = fresh_tid(), wid = __builtin_amdgcn_readfirstlane(tid >> 6), lane = tid & 63, wr = wid >> 2, wc = wid & 3, fr = lane & 15, fq = lane >> 4;
    unsigned voffA[2], voffB[2];
#pragma unroll
    for (int i = 0; i < 2; ++i) { int R, C; stage_rc(tid * 16 + i * 8192, R, C); voffA[i] = (unsigned)(R * lda + C * 2); voffB[i] = (unsigned)(R * ldb + C * 2); }
    const size_t kstep = (size_t)(BK * 2);
    const size_t hstepA = (size_t)HALF * lda, hstepB = (size_t)HALF * ldb;
    const unsigned ldsw = (unsigned)wid * 1024u;
    const int aoff = lds_byte(wr * 64 + fr, fq * 8), boff = lds_byte(wc * 32 + fr, fq * 8);
#define PG8_SA(b, h) (((b) * 2 + (h)) * HTB)
#define PG8_SB(b, h) ((4 + (b) * 2 + (h)) * HTB)
#define PG8_STAGE(bufoff, gbase, voff) do { _Pragma("unroll") for (int _i = 0; _i < 2; ++_i) \
        __builtin_amdgcn_global_load_lds((const unsigned*)((const char*)(gbase) + (voff)[_i]), (LAS unsigned*)(lds + (bufoff) + ldsw + _i * 8192), 16, 0, 0); } while (0)
#define PG8_LDA(dst, b, h) do { _Pragma("unroll") for (int m = 0; m < 4; ++m) _Pragma("unroll") for (int k = 0; k < 2; ++k) dst[m][k] = *(const LAS bf16x8*)(lds + PG8_SA(b, h) + aoff + m * 2048 + k * 1024); } while (0)
#define PG8_LDB(dst, b, h) do { _Pragma("unroll") for (int n = 0; n < 2; ++n) _Pragma("unroll") for (int k = 0; k < 2; ++k) dst[n][k] = *(const LAS bf16x8*)(lds + PG8_SB(b, h) + boff + n * 2048 + k * 1024); } while (0)
#define PG8_MMA(ai, bj, At, Bt) do { __builtin_amdgcn_s_setprio(1); _Pragma("unroll") for (int m = 0; m < 4; ++m) _Pragma("unroll") for (int n = 0; n < 2; ++n) _Pragma("unroll") for (int k = 0; k < 2; ++k) \
        acc[ai][bj][m][n] = __builtin_amdgcn_mfma_f32_16x16x32_bf16(Bt[n][k], At[m][k], acc[ai][bj][m][n], 0, 0, 0); __builtin_amdgcn_s_setprio(0); } while (0)
#define PG8_WAIT_V(n) asm volatile("s_waitcnt vmcnt(" #n ")" ::: "memory")
#define PG8_WAIT_L(n) asm volatile("s_waitcnt lgkmcnt(" #n ")" ::: "memory")
#define PG8_BAR __builtin_amdgcn_s_barrier()
#define PG8_SCHED __builtin_amdgcn_sched_barrier(0)
    Unit cur, nxt; int ui = 0;
    if (!S.next(0, cur)) return;
    f32x4 acc[2][2][4][2];
#pragma unroll
    for (int a = 0; a < 2; ++a)
#pragma unroll
        for (int b = 0; b < 2; ++b)
#pragma unroll
            for (int m = 0; m < 4; ++m)
#pragma unroll
                for (int n = 0; n < 2; ++n) acc[a][b][m][n] = (f32x4){0.f, 0.f, 0.f, 0.f};
    bf16x8 At[4][2], B0[2][2], B1[2][2];
    const char* cA = cur.A; const char* cB = cur.B;
    PG8_STAGE(PG8_SB(0, 0), cB, voffB); PG8_STAGE(PG8_SB(0, 1), cB + hstepB, voffB); PG8_STAGE(PG8_SA(0, 0), cA, voffA); PG8_STAGE(PG8_SA(0, 1), cA + hstepA, voffA);
    if (wr == 1) PG8_BAR;
    PG8_WAIT_V(2); PG8_BAR;
    PG8_STAGE(PG8_SB(1, 0), cB + kstep, voffB); PG8_STAGE(PG8_SA(1, 0), cA + kstep, voffA); PG8_STAGE(PG8_SB(1, 1), cB + hstepB + kstep, voffB);
    PG8_WAIT_V(6); PG8_BAR;
    for (;;) {
        const bool has_next = S.next(ui + 1, nxt);
        const char* nA = has_next ? nxt.A : cA; const char* nB = has_next ? nxt.B : cB;
        const int nt = cur.nt;
        for (int t = 0; t < nt; t += 2) {
            const bool last = (t == nt - 2);
            const char* a1 = cA + (size_t)(t + 1) * kstep;
            const char* a2 = last ? nA : cA + (size_t)(t + 2) * kstep; const char* b2 = last ? nB : cB + (size_t)(t + 2) * kstep;
            const char* a3 = a2 + kstep; const char* b3 = b2 + kstep;
            PG8_LDB(B0, 0, 0); PG8_LDB(B1, 0, 1); PG8_SCHED; PG8_LDA(At, 0, 0); PG8_STAGE(PG8_SA(1, 1), a1 + hstepA, voffA);
            PG8_WAIT_V(8); PG8_WAIT_L(0); PG8_BAR; PG8_MMA(0, 0, At, B0); PG8_MMA(0, 1, At, B1); PG8_BAR; PG8_SCHED;
            PG8_LDA(At, 0, 1); PG8_STAGE(PG8_SB(0, 0), b2, voffB); PG8_STAGE(PG8_SB(0, 1), b2 + hstepB, voffB); PG8_STAGE(PG8_SA(0, 0), a2, voffA);
            PG8_WAIT_V(8); PG8_WAIT_L(0); PG8_BAR; PG8_MMA(1, 0, At, B0); PG8_MMA(1, 1, At, B1); PG8_BAR; PG8_SCHED;
            PG8_LDB(B0, 1, 0); PG8_LDB(B1, 1, 1); PG8_SCHED; PG8_LDA(At, 1, 0); PG8_STAGE(PG8_SA(0, 1), a2 + hstepA, voffA);
            PG8_WAIT_V(8); PG8_WAIT_L(0); PG8_BAR; PG8_MMA(0, 0, At, B0); PG8_MMA(0, 1, At, B1); PG8_BAR; PG8_SCHED;
            PG8_LDA(At, 1, 1); PG8_STAGE(PG8_SB(1, 0), b3, voffB); PG8_STAGE(PG8_SB(1, 1), b3 + hstepB, voffB); PG8_STAGE(PG8_SA(1, 0), a3, voffA);
            PG8_WAIT_V(8); PG8_WAIT_L(0); PG8_BAR; PG8_MMA(1, 0, At, B0); PG8_MMA(1, 1, At, B1); PG8_BAR; PG8_SCHED;
        }
        if (wr == 0) PG8_BAR;
        E(acc, cur, wr, wc, fr, fq);
        if (!has_next) break;
#pragma unroll
        for (int a = 0; a < 2; ++a)
#pragma unroll
            for (int b = 0; b < 2; ++b)
#pragma unroll
                for (int m = 0; m < 4; ++m)
#pragma unroll
                    for (int n = 0; n < 2; ++n) acc[a][b][m][n] = (f32x4){0.f, 0.f, 0.f, 0.f};
        cur = nxt; cA = nA; cB = nB; ++ui;
        if (wr == 1) PG8_BAR;
    }
    PG8_WAIT_V(0);
    PG8_BAR;
#undef PG8_SA
#undef PG8_SB
#undef PG8_STAGE
#undef PG8_LDA
#undef PG8_LDB
#undef PG8_MMA
#undef PG8_WAIT_V
#undef PG8_WAIT_L
#undef PG8_BAR
#undef PG8_SCHED
}
}

typedef f32x4 acc_t[2][2][4][2];

struct EpiStore {
    bf16_t* O; int ldc;
    __device__ __forceinline__ void operator()(const acc_t& acc, const pg8::Unit& u, int wr, int wc, int fr, int fq) const {
        const int row0 = u.pm * 256 + wr * 64 + fr, col0 = u.pn * 256 + wc * 32 + 4 * fq;
#pragma unroll
        for (int ai = 0; ai < 2; ++ai)
#pragma unroll
            for (int m = 0; m < 4; ++m) { bf16_t* rowp = O + (size_t)(row0 + ai * 128 + m * 16) * ldc + col0;
#pragma unroll
                for (int bj = 0; bj < 2; ++bj)
#pragma unroll
                    for (int n = 0; n < 2; ++n) { const f32x4 v = acc[ai][bj][m][n]; u32x2 w; w.x = cvtpk(v[0], v[1]); w.y = cvtpk(v[2], v[3]); *(u32x2*)(rowp + bj * 128 + n * 16) = w; } }
    }
};
struct EpiQRope {
    bf16_t* O;
    __device__ __forceinline__ void operator()(const acc_t& acc, const pg8::Unit& u, int wr, int wc, int fr, int fq) const {
        const int row0 = u.pm * 256 + wr * 64 + fr, col0 = u.pn * 256 + wc * 32 + 4 * fq;
        const bool latent = u.pm < 128;
        float inv[4];
#pragma unroll
        for (int j = 0; j < 4; ++j) inv[j] = exp2f(-(float)(4 * (fq & 1) + j) * 1.6609640474436813f);
#pragma unroll
        for (int ai = 0; ai < 2; ++ai)
#pragma unroll
            for (int m = 0; m < 4; ++m) { const int row = row0 + ai * 128 + m * 16; bf16_t* rowp = O + (size_t)row * QW + col0;
                const int t = row & (SEQ - 1); const float pos = (float)((fq < 2) ? (t >> 6) : (t & 63));
#pragma unroll
                for (int bj = 0; bj < 2; ++bj) { const int cb = u.pn * 8 + bj * 4 + wc; f32x4 v0 = acc[ai][bj][m][0], v1 = acc[ai][bj][m][1];
                    if (latent && (cb == 4 || cb == 9 || cb == 14 || cb == 19)) {
#pragma unroll
                        for (int j = 0; j < 4; ++j) { const float a = pos * inv[j]; const float cs = __cosf(a), sn = __sinf(a); const float x1 = v0[j], x2 = v1[j]; v0[j] = x1 * cs - x2 * sn; v1[j] = x2 * cs + x1 * sn; }
                    }
                    u32x2 w; w.x = cvtpk(v0[0], v0[1]); w.y = cvtpk(v0[2], v0[3]); *(u32x2*)(rowp + bj * 128) = w;
                    w.x = cvtpk(v1[0], v1[1]); w.y = cvtpk(v1[2], v1[3]); *(u32x2*)(rowp + bj * 128 + 16) = w; } }
    }
};
struct EpiMerge {
    const bf16_t* Yall; bf16_t* Mg;
    __device__ __forceinline__ void operator()(const acc_t& acc, const pg8::Unit& u, int wr, int wc, int fr, int fq) const {
        const int row0 = u.pm * 256 + wr * 64 + fr, ocol = u.pn * 64 + wc * 16 + 4 * fq;
#pragma unroll
        for (int ai = 0; ai < 2; ++ai)
#pragma unroll
            for (int m = 0; m < 4; ++m) { const int row = row0 + ai * 128 + m * 16; const bf16_t* yr = Yall + (size_t)row * 4096 + ocol; f32x4 s = {0.f, 0.f, 0.f, 0.f};
#pragma unroll
                for (int bj = 0; bj < 2; ++bj)
#pragma unroll
                    for (int n = 0; n < 2; ++n) { const u32x2 w = *(const u32x2*)(yr + (2 * bj + n) * 1024); const f32x4 g = acc[ai][bj][m][n];
                        s[0] += sigmoidf_(g[0]) * bflo(w.x); s[1] += sigmoidf_(g[1]) * bfhi(w.x); s[2] += sigmoidf_(g[2]) * bflo(w.y); s[3] += sigmoidf_(g[3]) * bfhi(w.y); }
                u32x2 o; o.x = cvtpk(s[0], s[1]); o.y = cvtpk(s[2], s[3]); *(u32x2*)(Mg + (size_t)row * D + ocol) = o; }
    }
};
struct EpiResid {
    const float* res_lat_f32;
    bf16_t* rb;
    const float* res_ctx; float* out_ctx; const float* gate;
    __device__ __forceinline__ void operator()(const acc_t& acc, const pg8::Unit& u, int wr, int wc, int fr, int fq) const {
        const int lrow0 = wr * 64 + fr, col0 = u.pn * 256 + wc * 32 + 4 * fq;
        const int v = u.pm < 128 ? (u.pm >> 6) : 2;
        const float* gp = gate + v * 6144;
        f32x4 gv[2][2];
#pragma unroll
        for (int bj = 0; bj < 2; ++bj)
#pragma unroll
            for (int n = 0; n < 2; ++n) gv[bj][n] = *(const f32x4*)(gp + col0 + bj * 128 + n * 16);
        if (u.pm < 128) {
            bf16_t* rbt = rb + (size_t)u.pm * 256 * 2048 + 1024;
            if (res_lat_f32) {
                const float* res = res_lat_f32 + (size_t)u.pm * 256 * D;
#pragma unroll
                for (int ai = 0; ai < 2; ++ai)
#pragma unroll
                    for (int m = 0; m < 4; ++m) { const int lr = lrow0 + ai * 128 + m * 16;
#pragma unroll
                        for (int bj = 0; bj < 2; ++bj)
#pragma unroll
                            for (int n = 0; n < 2; ++n) { const int c = col0 + bj * 128 + n * 16; const f32x4 r = *(const f32x4*)(res + (size_t)lr * D + c);
                                const f32x4 o = r + gv[bj][n] * acc[ai][bj][m][n];
                                u32x2 w2; w2.x = cvtpk(o[0], o[1]); w2.y = cvtpk(o[2], o[3]); *(u32x2*)(rbt + (size_t)lr * 2048 + c) = w2; } }
            } else {
#pragma unroll
                for (int ai = 0; ai < 2; ++ai)
#pragma unroll
                    for (int m = 0; m < 4; ++m) { const int lr = lrow0 + ai * 128 + m * 16;
#pragma unroll
                        for (int bj = 0; bj < 2; ++bj)
#pragma unroll
                            for (int n = 0; n < 2; ++n) { const int c = col0 + bj * 128 + n * 16; const u32x2 w = *(const u32x2*)(rbt + (size_t)lr * 2048 + c);
                                const f32x4 r = (f32x4){bflo(w.x), bfhi(w.x), bflo(w.y), bfhi(w.y)};
                                const f32x4 o = r + gv[bj][n] * acc[ai][bj][m][n];
                                u32x2 w2; w2.x = cvtpk(o[0], o[1]); w2.y = cvtpk(o[2], o[3]); *(u32x2*)(rbt + (size_t)lr * 2048 + c) = w2; } }
            }
        } else {
            const float* res = res_ctx + (size_t)(u.pm - 128) * 256 * D; float* out = out_ctx + (size_t)(u.pm - 128) * 256 * D;
#pragma unroll
            for (int ai = 0; ai < 2; ++ai)
#pragma unroll
                for (int m = 0; m < 4; ++m) { const size_t off = (size_t)(lrow0 + ai * 128 + m * 16) * D + col0;
#pragma unroll
                    for (int bj = 0; bj < 2; ++bj)
#pragma unroll
                        for (int n = 0; n < 2; ++n) { const f32x4 r = *(const f32x4*)(res + off + bj * 128 + n * 16); *(f32x4*)(out + off + bj * 128 + n * 16) = r + gv[bj][n] * acc[ai][bj][m][n]; } }
        }
    }
};
struct EpiSwiGLU {
    bf16_t* Hd;
    __device__ __forceinline__ void operator()(const acc_t& acc, const pg8::Unit& u, int wr, int wc, int fr, int fq) const {
        const int row0 = u.pm * 256 + wr * 64 + fr, hcol = u.pn * 128 + wc * 32 + 4 * fq;
#pragma unroll
        for (int ai = 0; ai < 2; ++ai)
#pragma unroll
            for (int m = 0; m < 4; ++m) { bf16_t* rowp = Hd + (size_t)(row0 + ai * 128 + m * 16) * FF + hcol;
#pragma unroll
                for (int n = 0; n < 2; ++n) { const f32x4 a = acc[ai][0][m][n], b = acc[ai][1][m][n]; f32x4 v;
#pragma unroll
                    for (int j = 0; j < 4; ++j) v[j] = a[j] * sigmoidf_(a[j]) * b[j];
                    u32x2 w; w.x = cvtpk(v[0], v[1]); w.y = cvtpk(v[2], v[3]); *(u32x2*)(rowp + n * 16) = w; } }
    }
};

__device__ __forceinline__ s16x4 vtr(LAS const unsigned char* p) { return __builtin_bit_cast(s16x4, __builtin_amdgcn_ds_read_tr16_b64_v4i16((LAS v4i16_t*)p)); }
__device__ __forceinline__ int crow(int r, int hi) { return (r & 3) + 8 * (r >> 2) + 4 * hi; }

template <int MODE>
__device__ __forceinline__ void attn_unit(LAS unsigned char* lds, const bf16_t* __restrict__ u, const bf16_t* __restrict__ qm, bf16_t* __restrict__ y,
                                          const float* __restrict__ rpb, const float* __restrict__ sink,
                                          int qrow0, int kctx_row0, int nlocal, int loc_row0, int aux0, int aux1, int kvh) {
    constexpr int KW = MODE == 0 ? 160 : (MODE == 1 ? 256 : 64);
    constexpr int KSTR = KW * 2 + 16;
    constexpr int NKS = MODE == 0 ? 10 : 4;
    constexpr int NDB = MODE == 0 ? 4 : 2;
    constexpr bool VSEP = MODE != 0;
    constexpr int CPR = KW / 8, NCH = 64 * CPR, NLD = (NCH + 511) / 512;
    constexpr int STAGE = (VSEP ? 2 : 1) * 64 * KSTR;
    const int tid = fresh_tid(), lane = tid & 63, wid = __builtin_amdgcn_readfirstlane(tid >> 6), l32 = lane & 31, hi = lane >> 5;
    int head, qtok, kcolw, kgcol, vgcol, ycol;
    if (MODE == 0) { head = wid & 3; qtok = 32 * (wid >> 2) + l32; kcolw = 0; kgcol = U_CKV; vgcol = U_CKV; ycol = 768 + head * 128; }
    else if (MODE == 1) { head = wid & 3; qtok = 32 * (wid >> 2) + l32; kcolw = head * 64; kgcol = U_NAK; vgcol = U_NAV; ycol = 256 + head * 64; }
    else { head = kvh * 2 + (wid & 1); qtok = 32 * (wid >> 1) + l32; kcolw = 0; kgcol = U_SWK + kvh * 64; vgcol = U_SWV + kvh * 64; ycol = 512 + head * 64; }
    const bf16_t* qp = MODE == 0 ? qm + (size_t)(qrow0 + qtok) * QW + head * 160 : u + (size_t)(qrow0 + qtok) * UW + (MODE == 1 ? U_NAQ : U_SWQ) + head * 64;
    bf16x8 qf[NKS];
#pragma unroll
    for (int ks = 0; ks < NKS; ++ks) qf[ks] = *(const bf16x8*)(qp + 16 * ks + 8 * hi);
    f32x16 o[NDB];
#pragma unroll
    for (int c = 0; c < NDB; ++c)
#pragma unroll
        for (int r = 0; r < 16; ++r) o[c][r] = 0.f;
    float mrun = -1e30f, lrun = 0.f;
    int srow[NLD], sch[NLD];
#pragma unroll
    for (int i = 0; i < NLD; ++i) { const int idx = tid + 512 * i; srow[i] = idx / CPR; sch[i] = idx % CPR; }
    u32x4 kreg[NLD], vreg[NLD];
    const int ntile = 4 + nlocal;
    unsigned dvo[5];
    if (MODE == 1) {
#pragma unroll
        for (int i = 0; i < 5; ++i) { const int sl = (wid + 8 * i) * 64 + lane, row = (sl / 33) & 63, ch = sl % 33; dvo[i] = (unsigned)(row * (UW * 2) + (ch < 32 ? ch : 0) * 16); }
    }
#define ATT_DMA(t, buf) do { const char* tb_ = (const char*)u + (size_t)ATT_TROW(t) * (UW * 2); _Pragma("unroll") for (int i = 0; i < 5; ++i) if (wid + 8 * i < 33) { \
        __builtin_amdgcn_global_load_lds((const unsigned*)(tb_ + kgcol * 2 + dvo[i]), (LAS unsigned*)(lds + (buf) * STAGE + (wid + 8 * i) * 1024), 16, 0, 0); \
        __builtin_amdgcn_global_load_lds((const unsigned*)(tb_ + vgcol * 2 + dvo[i]), (LAS unsigned*)(lds + (buf) * STAGE + 64 * KSTR + (wid + 8 * i) * 1024), 16, 0, 0); } } while (0)
#define ATT_TROW(t) ((t) < 4 ? kctx_row0 + 64 * (t) : loc_row0 + 64 * ((t) - 4))
#define ATT_LOAD(t) do { const int rg_ = ATT_TROW(t); _Pragma("unroll") for (int i = 0; i < NLD; ++i) if (NCH % 512 == 0 || i < NLD - 1 || tid + 512 * i < NCH) { \
        const bf16_t* gp_ = u + (size_t)(rg_ + srow[i]) * UW + sch[i] * 8; kreg[i] = *(const u32x4*)(gp_ + kgcol); if (VSEP) vreg[i] = *(const u32x4*)(gp_ + vgcol); } } while (0)
#define ATT_STORE(buf) do { _Pragma("unroll") for (int i = 0; i < NLD; ++i) if (NCH % 512 == 0 || i < NLD - 1 || tid + 512 * i < NCH) { \
        LAS unsigned char* lp_ = lds + (buf) * STAGE + srow[i] * KSTR + sch[i] * 16; *(LAS u32x4*)lp_ = kreg[i]; if (VSEP) *(LAS u32x4*)(lp_ + 64 * KSTR) = vreg[i]; } } while (0)
    if (MODE == 1) { ATT_DMA(0, 0); asm volatile("s_waitcnt vmcnt(0)" ::: "memory"); } else { ATT_LOAD(0); ATT_STORE(0); }
    __syncthreads();
    const int q4 = (lane & 15) >> 2, p4 = lane & 3, blk = (lane >> 4) & 1;
    for (int t = 0; t < ntile; ++t) {
        const int buf = t & 1;
        if (t + 1 < ntile) { if (MODE == 1) ATT_DMA(t + 1, (t + 1) & 1); else ATT_LOAD(t + 1); }
        float rpv = 0.f;
        if (MODE == 1 && t >= 4) rpv = rpb[(head * 15 + (aux1 + (t - 4) - aux0 + 7)) * 31 + min(lane, 30)];
        LAS const unsigned char* Kb = lds + buf * STAGE;
        LAS const unsigned char* Vb = VSEP ? Kb + 64 * KSTR : Kb;
        f32x16 s0, s1;
#pragma unroll
        for (int r = 0; r < 16; ++r) { s0[r] = 0.f; s1[r] = 0.f; }
        {
            LAS const unsigned char* kp = Kb + l32 * KSTR + (kcolw + 8 * hi) * 2;
            bf16x8 ka0 = *(LAS const bf16x8*)(kp), ka1 = *(LAS const bf16x8*)(kp + 32 * KSTR);
#pragma unroll
            for (int ks = 0; ks < NKS; ++ks) {
                bf16x8 kb0 = ka0, kb1 = ka1;
                if (ks + 1 < NKS) { kb0 = *(LAS const bf16x8*)(kp + (ks + 1) * 32); kb1 = *(LAS const bf16x8*)(kp + (ks + 1) * 32 + 32 * KSTR); }
                s0 = __builtin_amdgcn_mfma_f32_32x32x16_bf16(ka0, qf[ks], s0, 0, 0, 0);
                s1 = __builtin_amdgcn_mfma_f32_32x32x16_bf16(ka1, qf[ks], s1, 0, 0, 0);
                __builtin_amdgcn_sched_barrier(0);
                ka0 = kb0; ka1 = kb1;
            }
        }
        if (MODE == 1 && t >= 4) {
            const int c = qtok, c0 = min(max(c - 8, 0), 48);
            const int rpi = (int)__float_as_uint(rpv);
#pragma unroll
            for (int r = 0; r < 16; ++r) {
                const int kc0 = crow(r, hi), kc1 = kc0 + 32;
                const bool v0 = (kc0 >= c0) && (kc0 < c0 + 16), v1 = (kc1 >= c0) && (kc1 < c0 + 16);
                const float b0 = __uint_as_float((unsigned)__builtin_amdgcn_ds_bpermute(min(max(kc0 - c + 15, 0), 30) << 2, rpi));
                const float b1 = __uint_as_float((unsigned)__builtin_amdgcn_ds_bpermute(min(max(kc1 - c + 15, 0), 30) << 2, rpi));
                s0[r] = v0 ? s0[r] + b0 * LOG2E : -INFINITY; s1[r] = v1 ? s1[r] + b1 * LOG2E : -INFINITY;
            }
        }
        if (MODE == 2 && t >= 4) {
            const int qpos = aux0 + qtok, kb0 = aux1 + 64 * (t - 4);
#pragma unroll
            for (int r = 0; r < 16; ++r) {
                const int d0 = kb0 + crow(r, hi) - qpos, d1 = d0 + 32;
                if (d0 > 128 || d0 < -128) s0[r] = -INFINITY;
                if (d1 > 128 || d1 < -128) s1[r] = -INFINITY;
            }
        }
        float mx = fmaxf(s0[0], s1[0]);
#pragma unroll
        for (int r = 1; r < 16; ++r) mx = fmaxf(mx, fmaxf(s0[r], s1[r]));
        mx = xhalf_max(mx);
        const float mnew = fmaxf(mrun, mx), alpha = fexp2(mrun - mnew);
        mrun = mnew;
        float rs = 0.f;
#pragma unroll
        for (int r = 0; r < 16; ++r) { s0[r] = fexp2(s0[r] - mnew); s1[r] = fexp2(s1[r] - mnew); rs += s0[r] + s1[r]; }
        lrun = lrun * alpha + rs;
#pragma unroll
        for (int c = 0; c < NDB; ++c)
#pragma unroll
            for (int r = 0; r < 16; ++r) o[c][r] *= alpha;
        u32x4 pw[2][2];
#pragma unroll
        for (int s = 0; s < 2; ++s) {
            pw[0][s] = (u32x4){cvtpk(s0[8 * s], s0[8 * s + 1]), cvtpk(s0[8 * s + 2], s0[8 * s + 3]), cvtpk(s0[8 * s + 4], s0[8 * s + 5]), cvtpk(s0[8 * s + 6], s0[8 * s + 7])};
            pw[1][s] = (u32x4){cvtpk(s1[8 * s], s1[8 * s + 1]), cvtpk(s1[8 * s + 2], s1[8 * s + 3]), cvtpk(s1[8 * s + 4], s1[8 * s + 5]), cvtpk(s1[8 * s + 6], s1[8 * s + 7])};
        }
        {
            LAS const unsigned char* vp = Vb + (4 * hi + q4) * KSTR + (kcolw + 16 * blk) * 2 + 8 * p4;
            s16x4 la = vtr(vp), ha = vtr(vp + 8 * KSTR);
#pragma unroll
            for (int it = 0; it < NDB * 4; ++it) {
                const int c = it >> 2, kb = (it >> 1) & 1, s = it & 1;
                s16x4 lb = la, hb = ha;
                if (it + 1 < NDB * 4) { const int c2 = (it + 1) >> 2, kb2 = ((it + 1) >> 1) & 1, s2 = (it + 1) & 1;
                    lb = vtr(vp + (32 * kb2 + 16 * s2) * KSTR + c2 * 64); hb = vtr(vp + (32 * kb2 + 16 * s2 + 8) * KSTR + c2 * 64); }
                const bf16x8 vf = (bf16x8){la[0], la[1], la[2], la[3], ha[0], ha[1], ha[2], ha[3]};
                o[c] = __builtin_amdgcn_mfma_f32_32x32x16_bf16(vf, __builtin_bit_cast(bf16x8, pw[kb][s]), o[c], 0, 0, 0);
                __builtin_amdgcn_sched_barrier(0);
                la = lb; ha = hb;
            }
        }
        if (MODE == 1) asm volatile("s_waitcnt vmcnt(0)" ::: "memory"); else if (t + 1 < ntile) ATT_STORE((t + 1) & 1);
        __syncthreads();
    }
    lrun = xhalf_sum(lrun);
    if (MODE == 2) lrun += fexp2(sink[head] * LOG2E - mrun);
    const float inv = 1.f / lrun;
    bf16_t* yp = y + (size_t)(qrow0 + qtok) * YW + ycol + 4 * hi;
#pragma unroll
    for (int c = 0; c < NDB; ++c)
#pragma unroll
        for (int g = 0; g < 4; ++g) { u32x2 w; w.x = cvtpk(o[c][4 * g] * inv, o[c][4 * g + 1] * inv); w.y = cvtpk(o[c][4 * g + 2] * inv, o[c][4 * g + 3] * inv); *(u32x2*)(yp + 32 * c + 8 * g) = w; }
#undef ATT_TROW
#undef ATT_DMA
#undef ATT_LOAD
#undef ATT_STORE
}


__device__ __forceinline__ void mla_unit(LAS unsigned char* lds, const bf16_t* __restrict__ u, const bf16_t* __restrict__ qm, bf16_t* __restrict__ y,
                                         int qrow0, int kctx_row0, int nlocal, int loc_row0) {
    constexpr int KSTR = 320, NKS = 10, STAGE = 41 * 1024, KB1 = 32 * KSTR + 64, HALFB = 64 * KSTR + 128;
    constexpr float THR = 6.f;
    const int tid = fresh_tid(), lane = tid & 63, wid = __builtin_amdgcn_readfirstlane(tid >> 6), l32 = lane & 31, hi = lane >> 5;
    const int head = wid & 3, qtok = 32 * (wid >> 2) + l32;
    const bf16_t* qp = qm + (size_t)(qrow0 + qtok) * QW + head * 160;
    bf16x8 qf[NKS];
#pragma unroll
    for (int ks = 0; ks < NKS; ++ks) qf[ks] = *(const bf16x8*)(qp + 16 * ks + 8 * hi);
    f32x16 o[4];
#pragma unroll
    for (int c = 0; c < 4; ++c)
#pragma unroll
        for (int r = 0; r < 16; ++r) o[c][r] = 0.f;
    float mref = -1e30f, lrun = 0.f;
    const int nmac = 2 + (nlocal >> 1);
#define MLA_TROW(T) ((T) < 2 ? kctx_row0 + 128 * (T) : loc_row0 + 128 * ((T) - 2))
    unsigned dvo[6];
#pragma unroll
    for (int i = 0; i < 6; ++i) { const int sl = (wid * 6 + i) * 64 + lane, g = sl / 161, rem = sl % 161; const bool ok = sl < 2576 && rem < 160;
        const int row = ok ? 8 * g + rem / 20 : 0, ch = ok ? rem % 20 : 0; dvo[i] = (unsigned)(row * (UW * 2) + ch * 16); }
    const char* kbase = (const char*)(u + U_CKV);
#define MLA_DMA(T, buf) do { const char* tb_ = kbase + (size_t)MLA_TROW(T) * (UW * 2); _Pragma("unroll") for (int i = 0; i < 6; ++i) if (wid * 6 + i < 41) \
        __builtin_amdgcn_global_load_lds((const unsigned*)(tb_ + dvo[i]), (LAS unsigned*)(lds + (buf) * STAGE + (wid * 6 + i) * 1024), 16, 0, 0); } while (0)
    MLA_DMA(0, 0); MLA_DMA(1, 1);
    asm volatile("s_waitcnt vmcnt(0)" ::: "memory");
    __syncthreads();
    const int q4 = (lane & 15) >> 2, p4 = lane & 3, blk = (lane >> 4) & 1;
    const int koff = l32 * KSTR + (l32 >> 3) * 16 + 16 * hi;
    const int voff = (4 * hi + q4) * KSTR + 32 * blk + 8 * p4;
    f32x16 sa0, sa1, sb0, sb1;
    u32x4 pw00, pw01, pw10, pw11;
    float mxn;
#define MLA_QKEXP(SD0, SD1, PA0, PA1, KOFF, DOEXP) do { \
        _Pragma("unroll") for (int r = 0; r < 16; ++r) { SD0[r] = 0.f; SD1[r] = 0.f; } \
        float rs = 0.f; \
        LAS const unsigned char* kp = lds + (KOFF) + koff; \
        bf16x8 ka0 = *(LAS const bf16x8*)(kp), ka1 = *(LAS const bf16x8*)(kp + KB1); \
        _Pragma("unroll") for (int ks = 0; ks < NKS; ++ks) { \
            bf16x8 kb0 = ka0, kb1 = ka1; \
            if (ks + 1 < NKS) { kb0 = *(LAS const bf16x8*)(kp + (ks + 1) * 32); kb1 = *(LAS const bf16x8*)(kp + (ks + 1) * 32 + KB1); } \
            SD0 = __builtin_amdgcn_mfma_f32_32x32x16_bf16(ka0, qf[ks], SD0, 0, 0, 0); \
            SD1 = __builtin_amdgcn_mfma_f32_32x32x16_bf16(ka1, qf[ks], SD1, 0, 0, 0); \
            if (DOEXP) { \
                if (ks < 4) { _Pragma("unroll") for (int j = 0; j < 4; ++j) { const float p = fexp2(PA0[4 * ks + j] - mref); PA0[4 * ks + j] = p; rs += p; } } \
                else if (ks == 4) pw00 = (u32x4){cvtpk(PA0[0], PA0[1]), cvtpk(PA0[2], PA0[3]), cvtpk(PA0[4], PA0[5]), cvtpk(PA0[6], PA0[7])}; \
                else if (ks == 5) pw01 = (u32x4){cvtpk(PA0[8], PA0[9]), cvtpk(PA0[10], PA0[11]), cvtpk(PA0[12], PA0[13]), cvtpk(PA0[14], PA0[15])}; \
                else if (ks < 8) { _Pragma("unroll") for (int j = 0; j < 4; ++j) { const float p = fexp2(PA1[4 * (ks - 6) + j] - mref); PA1[4 * (ks - 6) + j] = p; rs += p; } } \
                else if (ks == 8) pw10 = (u32x4){cvtpk(PA1[0], PA1[1]), cvtpk(PA1[2], PA1[3]), cvtpk(PA1[4], PA1[5]), cvtpk(PA1[6], PA1[7])}; } \
            __builtin_amdgcn_sched_barrier(0); \
            ka0 = kb0; ka1 = kb1; } \
        lrun += rs; } while (0)
#define MLA_PV(VOFF, PA1, M0, M1) do { \
        LAS const unsigned char* vp = lds + (VOFF) + voff; \
        s16x4 vl[16], vh[16]; float mxa, mxb, rs2 = 0.f; \
          \
        _Pragma("unroll") for (int it = 0; it < 8; ++it) { const int c = it & 3, kb = it >> 3, s_ = (it >> 2) & 1; \
            vl[it] = vtr(vp + (32 * kb + 16 * s_) * KSTR + 16 * (4 * kb + 2 * s_) + c * 64); vh[it] = vtr(vp + (32 * kb + 16 * s_ + 8) * KSTR + 16 * (4 * kb + 2 * s_ + 1) + c * 64); } \
        _Pragma("unroll") for (int it = 0; it < 16; ++it) { const int c = it & 3, kb = it >> 3, s_ = (it >> 2) & 1; \
            if (it == 4) { __builtin_amdgcn_sched_barrier(0); \
                _Pragma("unroll") for (int i2 = 8; i2 < 16; ++i2) { const int c2 = i2 & 3, kb2 = i2 >> 3, s2 = (i2 >> 2) & 1; \
                    vl[i2] = vtr(vp + (32 * kb2 + 16 * s2) * KSTR + 16 * (4 * kb2 + 2 * s2) + c2 * 64); vh[i2] = vtr(vp + (32 * kb2 + 16 * s2 + 8) * KSTR + 16 * (4 * kb2 + 2 * s2 + 1) + c2 * 64); } } \
            if (it == 12) pw11 = (u32x4){cvtpk(PA1[8], PA1[9]), cvtpk(PA1[10], PA1[11]), cvtpk(PA1[12], PA1[13]), cvtpk(PA1[14], PA1[15])}; \
            const bf16x8 vf = (bf16x8){vl[it][0], vl[it][1], vl[it][2], vl[it][3], vh[it][0], vh[it][1], vh[it][2], vh[it][3]}; \
            const u32x4 pwv = kb == 0 ? (s_ == 0 ? pw00 : pw01) : (s_ == 0 ? pw10 : pw11); \
            o[c] = __builtin_amdgcn_mfma_f32_32x32x16_bf16(vf, __builtin_bit_cast(bf16x8, pwv), o[c], 0, 0, 0); \
            if (it < 8) { const float p = fexp2(PA1[8 + it] - mref); PA1[8 + it] = p; rs2 += p; } \
            if (it == 0) { mxa = M0[0]; mxb = M1[0]; } else { mxa = fmaxf(mxa, M0[it]); mxb = fmaxf(mxb, M1[it]); } } \
        lrun += rs2; \
        mxn = xhalf_max(fmaxf(mxa, mxb)); } while (0)
#define MLA_RESCALE() do { if (__any(mxn > mref + THR)) { const float mnew = fmaxf(mref, mxn), alpha = fexp2(mref - mnew); mref = mnew; lrun *= alpha; \
        _Pragma("unroll") for (int c = 0; c < 4; ++c) _Pragma("unroll") for (int r = 0; r < 16; ++r) o[c][r] *= alpha; } __builtin_amdgcn_sched_barrier(0); } while (0)
    MLA_QKEXP(sa0, sa1, sa0, sa1, 0, false);
    { float a_ = fmaxf(sa0[0], sa1[0]);
#pragma unroll
      for (int r = 1; r < 16; ++r) a_ = fmaxf(a_, fmaxf(sa0[r], sa1[r]));
      mxn = xhalf_max(a_); }
    int bcur = 0;
    for (int T = 0; T < nmac; ++T) {
        const int bnxt = bcur == 2 ? 0 : bcur + 1, bnn = bnxt == 2 ? 0 : bnxt + 1;
        if (T + 2 < nmac) MLA_DMA(T + 2, bnn);
        MLA_RESCALE();
        MLA_QKEXP(sb0, sb1, sa0, sa1, bcur * STAGE + HALFB, true);
        MLA_PV(bcur * STAGE, sa1, sb0, sb1);
        MLA_RESCALE();
        MLA_QKEXP(sa0, sa1, sb0, sb1, bnxt * STAGE, true);
        MLA_PV(bcur * STAGE + HALFB, sb1, sa0, sa1);
        asm volatile("s_waitcnt vmcnt(0)" ::: "memory");
        __syncthreads();
        bcur = bnxt;
    }
    lrun = xhalf_sum(lrun);
    const float inv = 1.f / lrun;
    bf16_t* yp = y + (size_t)(qrow0 + qtok) * YW + 768 + head * 128 + 4 * hi;
#pragma unroll
    for (int c = 0; c < 4; ++c)
#pragma unroll
        for (int g = 0; g < 4; ++g) { u32x2 w; w.x = cvtpk(o[c][4 * g] * inv, o[c][4 * g + 1] * inv); w.y = cvtpk(o[c][4 * g + 2] * inv, o[c][4 * g + 3] * inv); *(u32x2*)(yp + 32 * c + 8 * g) = w; }
#undef MLA_TROW
#undef MLA_DMA
#undef MLA_QKEXP
#undef MLA_PV
#undef MLA_RESCALE
}

#define XB_TMO      128
#define XB_XCNT(j)  (256  + 64 * (j))
#define XB_XSUB(j)  (1280 + 64 * (j))
#define XB_XGEN(j)  (2304 + 64 * (j))
#define XB_TOP      3328
#define XB_TOPGEN   3392
#define XCD_BAR_WORDS 3456
#define XB_SPIN_CAP (1u << 18)
__device__ __forceinline__ unsigned xb_ld(unsigned* p)              { return __hip_atomic_load(p, __ATOMIC_RELAXED, __HIP_MEMORY_SCOPE_AGENT); }
__device__ __forceinline__ unsigned xb_add(unsigned* p, unsigned v) { return __hip_atomic_fetch_add(p, v, __ATOMIC_RELAXED, __HIP_MEMORY_SCOPE_AGENT); }
__device__ __forceinline__ unsigned xb_xcc_id() { return (unsigned)__builtin_amdgcn_s_getreg((3 << 11) | 20) & 0xFu; }
#define XB_SPIN(cond, bar) do { unsigned _sp = 0; while (cond) { __builtin_amdgcn_s_sleep(1); \
    if ((++_sp & 255u) == 0u) { if (xb_ld(&(bar)[XB_TMO])) break; if (_sp > XB_SPIN_CAP) { atomicAdd(&(bar)[XB_TMO], 1u); break; } } } } while (0)
struct XcdBarrier { unsigned* bar; unsigned x; volatile LAS unsigned* st; };
__device__ __forceinline__ XcdBarrier xcd_barrier_post(unsigned* bar, volatile LAS unsigned* st) {
    XcdBarrier b; b.bar = bar; b.x = xb_xcc_id(); b.st = st;
    if (threadIdx.x == 0) (void)xb_add(&bar[XB_XCNT(b.x)], 1u);
    return b;
}
__device__ __forceinline__ void xcd_barrier_complete(unsigned* bar, unsigned x, unsigned& nloc, unsigned& nx) {
    const unsigned G = gridDim.x * gridDim.y * gridDim.z;
    unsigned sum, cnt, mine, sp = 0u;
    for (;;) {
        sum = 0u; cnt = 0u; mine = 0u;
#pragma unroll
        for (unsigned j = 0; j < 16; ++j) { const unsigned c = xb_ld(&bar[XB_XCNT(j)]); sum += c; cnt += (c > 0u) ? 1u : 0u; mine = (j == x) ? c : mine; }
        if (sum == G) break;
        __builtin_amdgcn_s_sleep(1);
        if ((++sp & 255u) == 0u) { if (xb_ld(&bar[XB_TMO])) break; if (sp > XB_SPIN_CAP) { atomicAdd(&bar[XB_TMO], 1u); break; } }
    }
    nloc = mine > 0u ? mine : 1u; nx = cnt > 0u ? cnt : 1u;
}
__device__ __forceinline__ void xcd_barrier(const XcdBarrier& b) {
    asm volatile("s_waitcnt vmcnt(0)" ::: "memory");
    __syncthreads();
    if (threadIdx.x == 0) {
        unsigned* bar = b.bar; asm volatile("" : "+s"(bar)); unsigned bxcc = b.x; asm volatile("" : "+s"(bxcc));
        __builtin_amdgcn_s_waitcnt(0);
        unsigned nloc = b.st[0], nx = b.st[1];
        if (nloc == 0u) { xcd_barrier_complete(bar, bxcc, nloc, nx); b.st[0] = nloc; b.st[1] = nx; }
        const unsigned old = xb_add(&bar[XB_XSUB(bxcc)], 1u);
        const unsigned gen = old / nloc;
        if (old + 1u == (gen + 1u) * nloc) {
            __builtin_amdgcn_fence(__ATOMIC_RELEASE, "agent");
            asm volatile("s_waitcnt vmcnt(0)" ::: "memory");
            const unsigned og = xb_add(&bar[XB_TOP], 1u);
            const unsigned tg = og / nx;
            if (og + 1u == (tg + 1u) * nx) xb_add(&bar[XB_TOPGEN], 1u);
            else XB_SPIN(xb_ld(&bar[XB_TOPGEN]) == tg, bar);
            __builtin_amdgcn_fence(__ATOMIC_ACQUIRE, "agent");
            xb_add(&bar[XB_XGEN(bxcc)], 1u);
            asm volatile("s_waitcnt vmcnt(0)" ::: "memory");
        } else {
            XB_SPIN(xb_ld(&bar[XB_XGEN(bxcc)]) == gen, bar);
            __builtin_amdgcn_fence(__ATOMIC_ACQUIRE, "agent");
            asm volatile("s_waitcnt vmcnt(0)" ::: "memory");
        }
    }
    __syncthreads();
}

struct Args { const float* in[24]; float* out; unsigned char* ws; };
typedef __attribute__((address_space(4))) const Args CArgs;
__device__ __forceinline__ int fresh_sgpr(int v) { asm volatile("" : "+s"(v)); return v; }
__device__ __forceinline__ CArgs* fresh_args() { CArgs* p = (CArgs*)__builtin_amdgcn_kernarg_segment_ptr(); asm volatile("" : "+s"(p)); return p; }
enum { I_X = 0, I_C, I_CTX, I_CCTX, I_ADAW, I_ADAB, I_N1G, I_N2G, I_WIN, I_POOLW, I_POOLS, I_RPB, I_SINK, I_QNORM, I_KVNORM, I_WUQ, I_WUK, I_WUV, I_WBR, I_WOUT, I_W1, I_W3, I_W2, I_FNG };

__device__ __forceinline__ int rowmap(int mode, int n) {
    if (mode == 0) return n;
    if (mode == 1) { const int i = n >> 10, col = n & 1023, pn = col >> 6, cc = col & 63, wc = cc >> 4, fq = (cc >> 2) & 3, j = cc & 3; return 256 * pn + 128 * (i >> 1) + 32 * wc + 16 * (i & 1) + 4 * fq + j; }
    const int r = 256 * (n >> 7) + (n & 127); return mode == 2 ? r : r + 128;
}
__device__ __forceinline__ void tr_item(const float* __restrict__ W, int ldw, bf16_t* __restrict__ WT, int ldt, int nblk, int mode, LAS float* scr, int item, int lane, bool qscale = false) {
    const int kb = item / nblk, nb = item % nblk, k0 = 64 * kb, n0 = 32 * nb;
    float tv[32];
#pragma unroll
    for (int i = 0; i < 32; ++i) tv[i] = W[(size_t)(k0 + 2 * i + (lane >> 5)) * ldw + n0 + (lane & 31)];
#pragma unroll
    for (int i = 0; i < 32; ++i) scr[(2 * i + (lane >> 5)) * 33 + (lane & 31)] = tv[i];
    asm volatile("s_waitcnt lgkmcnt(0)" ::: "memory");
    const int c = lane & 7;
#pragma unroll
    for (int j = 0; j < 4; ++j) { const int n = (lane >> 3) + 8 * j; const LAS float* s = scr + (8 * c) * 33 + n;
        const float qs = (qscale && n0 + n >= U_NAQ && n0 + n < U_CQ) ? QSC64 : 1.f;
        u32x4 o; o.x = cvtpk(s[0 * 33] * qs, s[1 * 33] * qs); o.y = cvtpk(s[2 * 33] * qs, s[3 * 33] * qs); o.z = cvtpk(s[4 * 33] * qs, s[5 * 33] * qs); o.w = cvtpk(s[6 * 33] * qs, s[7 * 33] * qs);
        *(u32x4*)(WT + (size_t)rowmap(mode, n0 + n) * ldt + k0 + 8 * c) = o; }
    asm volatile("s_waitcnt lgkmcnt(0)" ::: "memory");
}

__global__ void __launch_bounds__(NTHREADS) mk_fwd(Args args) {
    extern __shared__ __attribute__((aligned(16))) unsigned char lds_raw[];
    LAS unsigned char* lds = (LAS unsigned char*)lds_raw;
    cg::grid_group grid = cg::this_grid();
    const int wid = __builtin_amdgcn_readfirstlane(threadIdx.x >> 6);
    const int bx = blockIdx.x;
    unsigned* barw = (unsigned*)args.ws;
    volatile LAS unsigned* bst = (volatile LAS unsigned*)(lds + LDS_BYTES - 16);
    if (threadIdx.x == 0) { bst[0] = 0u; bst[1] = 0u; }
    __syncthreads();
    if (gridDim.x == 0x7fffffffu) grid.sync();
    XcdBarrier xbar = xcd_barrier_post(barw, bst);
#define PH_BEGIN { const int tid = fresh_tid(); const int lane = tid & 63; (void)tid; (void)lane; CArgs* ap = fresh_args(); const int bx = fresh_sgpr((int)blockIdx.x); const int G = fresh_sgpr((int)gridDim.x); const int gw = bx * 8 + wid, NGW = G * 8; (void)gw; (void)NGW; unsigned char* ws = ap->ws; float* out = ap->out; \
    float* mod = (float*)(ws + WS_MOD); float* xc = (float*)(ws + WS_XC); bf16_t* Hb = (bf16_t*)(ws + WS_H); bf16_t* Yb = (bf16_t*)(ws + WS_Y); bf16_t* Ub = (bf16_t*)(ws + WS_R4); \
    bf16_t* Qm = (bf16_t*)(ws + WS_QM); bf16_t* Yall = (bf16_t*)(ws + WS_R4); bf16_t* Hid = (bf16_t*)(ws + WS_R4); bf16_t* Mg = (bf16_t*)(ws + WS_Y); \
    (void)mod; (void)xc; (void)Hb; (void)Yb; (void)Ub; (void)Qm; (void)Yall; (void)Hid; (void)Mg; (void)out;
#define PH_LAYER unsigned char* wl = ws + WS_W + (size_t)l * WL; const float* modl = mod + (size_t)l * 3 * 6144; const float* xres = l == 0 ? ap->in[I_X] : out; const float* cres = l == 0 ? ap->in[I_CTX] : xc; \
    const int Mq = l == 0 ? MT : NLAT; (void)wl; (void)modl; (void)xres; (void)cres; (void)Mq;
#define PH_END   xcd_barrier(xbar); }
#define PH_END0  xcd_barrier(xbar); }
#define PH_ENDL  }

    PH_BEGIN
    {
        LAS float* scr = (LAS float*)(lds + wid * 16384);
        constexpr int T_U = 976, T_G = 2048, T_B = 128, T_O = 512, T_1 = 1408, T_2 = 1408;
        constexpr int LTOT = T_U + T_G + 2 * T_B + T_O + 2 * T_1 + T_2;
        for (int it = gw; it < DEPTH * LTOT; it += NGW) {
            const int l = it / LTOT; int r = it % LTOT;
            unsigned char* wl = ws + WS_W + (size_t)l * WL;
            const float* win = ap->in[I_WIN] + (size_t)l * D * INC;
            if (r < T_U) { tr_item(win, INC, (bf16_t*)(wl + W_U), D, 61, 0, scr, r, lane, true); continue; } r -= T_U;
            if (r < T_G) { tr_item(win + U_END, INC, (bf16_t*)(wl + W_G), D, 128, 1, scr, r, lane); continue; } r -= T_G;
            if (r < T_B) { tr_item(ap->in[I_WBR] + ((size_t)l * 4 + 1) * 256 * D, D, (bf16_t*)(wl + W_B) + (size_t)1 * 1024 * 512, 512, 32, 0, scr, r, lane); continue; } r -= T_B;
            if (r < T_B) { tr_item(ap->in[I_WBR] + ((size_t)l * 4 + 2) * 256 * D, D, (bf16_t*)(wl + W_B) + (size_t)2 * 1024 * 512, 512, 32, 0, scr, r, lane); continue; } r -= T_B;
            if (r < T_O) { tr_item(ap->in[I_WOUT] + (size_t)l * D * D, D, (bf16_t*)(wl + W_O), D, 32, 0, scr, r, lane); continue; } r -= T_O;
            if (r < T_1) { tr_item(ap->in[I_W1] + (size_t)l * D * FF, FF, (bf16_t*)(wl + W_13), D, 88, 2, scr, r, lane); continue; } r -= T_1;
            if (r < T_1) { tr_item(ap->in[I_W3] + (size_t)l * D * FF, FF, (bf16_t*)(wl + W_13), D, 88, 3, scr, r, lane); continue; } r -= T_1;
            tr_item(ap->in[I_W2] + (size_t)l * FF * D, D, (bf16_t*)(wl + W_2), FF, 32, 0, scr, r, lane);
        }
        constexpr int F_Q = 640 * 256, F_3 = 512 * 256, F_0 = 256 * 256, FTOT = F_Q + F_3 + F_0;
        for (int it = bx * NTHREADS + tid; it < DEPTH * FTOT; it += G * NTHREADS) {
            const int l = it / FTOT; int r = it % FTOT;
            unsigned char* wl = ws + WS_W + (size_t)l * WL;
            if (r < F_Q) {
                const int k = r / 640, n = r % 640, h = n / 160, c = n % 160;
                const float* uq = ap->in[I_WUQ] + (size_t)l * 256 * 384 + (size_t)k * 384 + h * 96;
                float s;
                if (c < 128) { const float* uk = ap->in[I_WUK] + (size_t)l * 128 * 256 + (size_t)c * 256 + h * 64; f32x4 a4 = {0.f, 0.f, 0.f, 0.f};
#pragma unroll
                    for (int d = 0; d < 64; d += 4) a4 += *(const f32x4*)(uq + d) * *(const f32x4*)(uk + d);
                    s = (a4[0] + a4[1]) + (a4[2] + a4[3]); }
                else s = uq[64 + (c - 128)];
                ((bf16_t*)(wl + W_QF))[(size_t)n * 256 + k] = f2bf(s * QSCMLA);
            } else if (r < F_Q + F_3) {
                r -= F_Q; const int k = r / 256, n = (r % 256) * 4, h = k / 128, c = k % 128;
                const float* uv = ap->in[I_WUV] + (size_t)l * 128 * 256 + (size_t)c * 256 + h * 64;
                const float* wb = ap->in[I_WBR] + ((size_t)l * 4 + 3) * 256 * D + (size_t)(h * 64) * D + n;
                f32x4 a4 = {0.f, 0.f, 0.f, 0.f};
#pragma unroll 16
                for (int d = 0; d < 64; ++d) a4 += *(const f32x4*)(wb + (size_t)d * D) * uv[d];
                bf16_t* dst = (bf16_t*)(wl + W_B) + (size_t)3 * 1024 * 512 + (size_t)n * 512 + k;
                dst[0] = f2bf(a4[0]); dst[512] = f2bf(a4[1]); dst[1024] = f2bf(a4[2]); dst[1536] = f2bf(a4[3]);
            } else {
                r -= F_Q + F_3; const int k = r / 256, n = (r % 256) * 4, g = k / 64, c = k % 64;
                const float* pw = ap->in[I_POOLW] + (size_t)l * 4 * 64 * 64 + (size_t)g * 4096 + c * 64;
                const float* ps = ap->in[I_POOLS] + (size_t)l * 256 + g * 64;
                const float* wb = ap->in[I_WBR] + ((size_t)l * 4 + 0) * 256 * D + (size_t)(g * 64) * D + n;
                f32x4 a4 = {0.f, 0.f, 0.f, 0.f};
#pragma unroll 16
                for (int d = 0; d < 64; ++d) a4 += *(const f32x4*)(wb + (size_t)d * D) * (pw[d] * ps[d]);
                bf16_t* dst = (bf16_t*)(wl + W_B) + (size_t)n * 512 + k;
                dst[0] = f2bf(a4[0]); dst[512] = f2bf(a4[1]); dst[1024] = f2bf(a4[2]); dst[1536] = f2bf(a4[3]);
            }
        }
        __syncthreads();
        LAS float* sc = (LAS float*)lds;
        LAS float* red = sc + 3072;
        for (int i = tid; i < 3072; i += NTHREADS) { const int v = i >> 10, k = i & 1023; const float cv = v < 2 ? ap->in[I_C][v * D + k] : ap->in[I_CCTX][k]; sc[i] = cv / (1.f + expf(-cv)); }
        __syncthreads();
        for (int it = bx; it < DEPTH * 96; it += G) {
            const int l = it / 96, cgp = it % 96, col = cgp * 64 + lane;
            const float* aw = ap->in[I_ADAW] + (size_t)l * D * 6144 + col;
            float a0 = 0.f, a1 = 0.f, a2 = 0.f;
#pragma unroll 1
            for (int k0 = wid * 128; k0 < wid * 128 + 128; k0 += 32) { float wv[32];
#pragma unroll
                for (int j = 0; j < 32; ++j) wv[j] = aw[(size_t)(k0 + j) * 6144];
#pragma unroll
                for (int j = 0; j < 32; ++j) { a0 += sc[k0 + j] * wv[j]; a1 += sc[1024 + k0 + j] * wv[j]; a2 += sc[2048 + k0 + j] * wv[j]; } }
            red[(wid * 3 + 0) * 64 + lane] = a0; red[(wid * 3 + 1) * 64 + lane] = a1; red[(wid * 3 + 2) * 64 + lane] = a2;
            __syncthreads();
            if (tid < 192) { const int v = tid >> 6, ln = tid & 63; float s = 0.f;
#pragma unroll
                for (int w = 0; w < 8; ++w) s += red[(w * 3 + v) * 64 + ln];
                const int colo = cgp * 64 + ln; mod[(l * 3 + v) * 6144 + colo] = s + ap->in[I_ADAB][l * 6144 + colo]; }
            __syncthreads();
        }
    }
    PH_END0

    for (int l = 0; l < DEPTH; ++l) {

#define NORM_PHASE(XL, XC, GAMMA, SHC, SCC, LB) \
        for (int r0 = gw * 4; r0 < MT; r0 += NGW * 4) { \
            const float* src = r0 < NLAT ? (XL) + (size_t)r0 * D : (XC) + (size_t)(r0 - NLAT) * D; \
            const int v = r0 < NLAT ? r0 / SEQ : 2; const float* mv = modl + v * 6144; \
            f32x4 xv[4][4]; float ss[4]; \
            if ((LB) && r0 < NLAT) { const bf16_t* sb_ = (const bf16_t*)out + (size_t)r0 * 2048 + 1024; \
                _Pragma("unroll") for (int rr = 0; rr < 4; ++rr) _Pragma("unroll") for (int j = 0; j < 4; ++j) { const u32x2 w_ = *(const u32x2*)(sb_ + rr * 2048 + lane * 4 + 256 * j); xv[rr][j] = (f32x4){bflo(w_.x), bfhi(w_.x), bflo(w_.y), bfhi(w_.y)}; } } \
            else { _Pragma("unroll") for (int rr = 0; rr < 4; ++rr) _Pragma("unroll") for (int j = 0; j < 4; ++j) xv[rr][j] = *(const f32x4*)(src + rr * D + lane * 4 + 256 * j); } \
            _Pragma("unroll") for (int rr = 0; rr < 4; ++rr) { float a_ = 0.f; _Pragma("unroll") for (int j = 0; j < 4; ++j) a_ += xv[rr][j][0] * xv[rr][j][0] + xv[rr][j][1] * xv[rr][j][1] + xv[rr][j][2] * xv[rr][j][2] + xv[rr][j][3] * xv[rr][j][3]; ss[rr] = a_; } \
            _Pragma("unroll") for (int o_ = 1; o_ < 64; o_ <<= 1) _Pragma("unroll") for (int rr = 0; rr < 4; ++rr) ss[rr] += __uint_as_float((unsigned)__builtin_amdgcn_ds_bpermute((lane ^ o_) << 2, (int)__float_as_uint(ss[rr]))); \
            _Pragma("unroll") for (int rr = 0; rr < 4; ++rr) ss[rr] = rsqrtf(ss[rr] * (1.f / D) + EPSV); \
            _Pragma("unroll") for (int j = 0; j < 4; ++j) { const int c0 = lane * 4 + 256 * j; const f32x4 g = *(const f32x4*)((GAMMA) + c0), sh = *(const f32x4*)(mv + (SHC) * D + c0), sc = *(const f32x4*)(mv + (SCC) * D + c0); \
                const f32x4 gs = g * (sc + 1.f); \
                _Pragma("unroll") for (int rr = 0; rr < 4; ++rr) { const f32x4 yv = xv[rr][j] * ss[rr] * gs + sh; u32x2 w; w.x = cvtpk(yv[0], yv[1]); w.y = cvtpk(yv[2], yv[3]); *(u32x2*)(Hb + (size_t)(r0 + rr) * D + c0) = w; } } \
        }
        PH_BEGIN PH_LAYER
        NORM_PHASE(ap->in[I_X], cres, ap->in[I_N1G] + l * D, 0, 1, l != 0)
        PH_END

        PH_BEGIN PH_LAYER
        { pg8::SchedPlain S; S.so.init(MT, UW, G, bx); S.A = (const char*)Hb; S.B = (const char*)(wl + W_U); S.a_t = (size_t)256 * D * 2; S.b_t = (size_t)256 * D * 2; S.nt = D / 64;
          EpiStore E{Ub, UW}; pg8::gemm_phase(lds, D * 2, D * 2, S, E); }
        PH_END

        PH_BEGIN PH_LAYER
        {
            const float* qng = ap->in[I_QNORM] + l * 256; const float* kvg = ap->in[I_KVNORM] + l * 128;
            const f32x4 gq = *(const f32x4*)(qng + lane * 4); const float gk0 = kvg[lane * 2], gk1 = kvg[lane * 2 + 1];
            const int si = 2 * (lane & 15);
            const float sf0 = exp2f(-(float)(si & 15) * 0.8304820237218406f), sf1 = exp2f(-(float)((si + 1) & 15) * 0.8304820237218406f);
            const int ki = 2 * (lane & 7);
            const float kf0 = exp2f(-(float)(ki & 7) * 1.6609640474436813f), kf1 = exp2f(-(float)((ki + 1) & 7) * 1.6609640474436813f);
            const int pg = lane >> 4, pw_ = 2 << pg;
#define P2B_DECL(S) bf16_t* ur##S; int tloc##S, nseq##S, base##S; bool lat##S; u32x2 cq##S, ps##S, nb##S[16]; unsigned ckv##S, q1##S, q2##S, k1##S = 0, k2##S = 0, r1##S = 0, r2##S = 0;
#define P2B_LOAD(S, ROW) do { const int row_ = (ROW); ur##S = Ub + (size_t)row_ * UW; lat##S = row_ < NLAT; \
                if (lat##S) { tloc##S = row_ & (SEQ - 1); nseq##S = SEQ; } else { tloc##S = (row_ - NLAT) & (CTXL - 1); nseq##S = CTXL; } base##S = row_ - tloc##S; \
                cq##S = *(const u32x2*)(ur##S + U_CQ + lane * 4); ckv##S = *(const unsigned*)(ur##S + U_CKV + lane * 2); ps##S = *(const u32x2*)(ur##S + U_POOL + lane * 4); \
                q1##S = *(const unsigned*)(ur##S + U_SWQ + (lane >> 4) * 64 + si); q2##S = *(const unsigned*)(ur##S + U_SWQ + (lane >> 4) * 64 + 32 + si); \
                if (lat##S) { if (lane < 32) { k1##S = *(const unsigned*)(ur##S + U_SWK + (lane >> 4) * 64 + si); k2##S = *(const unsigned*)(ur##S + U_SWK + (lane >> 4) * 64 + 32 + si); } \
                              if (lane < 8) { r1##S = *(const unsigned*)(ur##S + U_KR + ki); r2##S = *(const unsigned*)(ur##S + U_KR + 16 + ki); } } \
                _Pragma("unroll") for (int i = 0; i < 16; ++i) { const int t_ = min(max(tloc##S - 8 + i, 0), nseq##S - 1); nb##S[i] = *(const u32x2*)(Ub + (size_t)(base##S + t_) * UW + U_POOL + lane * 4); } } while (0)
#define P2B_PROC(S, ROW) do { const int row_ = (ROW); const float prow = (float)(tloc##S >> 6), pcol = (float)(tloc##S & 63); \
                { float a = bflo(cq##S.x), b = bfhi(cq##S.x), c = bflo(cq##S.y), d = bfhi(cq##S.y); float sq = a * a + b * b + c * c + d * d; float a2 = bflo(ckv##S), b2 = bfhi(ckv##S); float sk = a2 * a2 + b2 * b2; \
                  _Pragma("unroll") for (int o_ = 1; o_ < 64; o_ <<= 1) { sq += __uint_as_float((unsigned)__builtin_amdgcn_ds_bpermute((lane ^ o_) << 2, (int)__float_as_uint(sq))); sk += __uint_as_float((unsigned)__builtin_amdgcn_ds_bpermute((lane ^ o_) << 2, (int)__float_as_uint(sk))); } \
                  const float rq = rsqrtf(sq * (1.f / 256.f) + EPSV), rk = rsqrtf(sk * (1.f / 128.f) + EPSV); u32x2 w; w.x = cvtpk(a * rq * gq[0], b * rq * gq[1]); w.y = cvtpk(c * rq * gq[2], d * rq * gq[3]); \
                  *(u32x2*)(ur##S + U_CQ + lane * 4) = w; *(unsigned*)(ur##S + U_CKV + lane * 2) = cvtpk(a2 * rk * gk0, b2 * rk * gk1); } \
                if (lat##S) { const float ps_ = si < 16 ? prow : pcol; const float a0 = ps_ * sf0, a1 = ps_ * sf1; const float c0 = __cosf(a0), s0 = __sinf(a0), c1 = __cosf(a1), s1 = __sinf(a1); \
                  { const float x1a = bflo(q1##S), x1b = bfhi(q1##S), x2a = bflo(q2##S), x2b = bfhi(q2##S); \
                    *(unsigned*)(ur##S + U_SWQ + (lane >> 4) * 64 + si) = cvtpk(x1a * c0 - x2a * s0, x1b * c1 - x2b * s1); *(unsigned*)(ur##S + U_SWQ + (lane >> 4) * 64 + 32 + si) = cvtpk(x2a * c0 + x1a * s0, x2b * c1 + x1b * s1); } \
                  if (lane < 32) { const float x1a = bflo(k1##S), x1b = bfhi(k1##S), x2a = bflo(k2##S), x2b = bfhi(k2##S); \
                    *(unsigned*)(ur##S + U_SWK + (lane >> 4) * 64 + si) = cvtpk(x1a * c0 - x2a * s0, x1b * c1 - x2b * s1); *(unsigned*)(ur##S + U_SWK + (lane >> 4) * 64 + 32 + si) = cvtpk(x2a * c0 + x1a * s0, x2b * c1 + x1b * s1); } \
                  if (lane < 8) { const float pk_ = ki < 8 ? prow : pcol; const float b0 = pk_ * kf0, b1 = pk_ * kf1; const float d0 = __cosf(b0), e0 = __sinf(b0), d1 = __cosf(b1), e1 = __sinf(b1); \
                    const float x1a = bflo(r1##S), x1b = bfhi(r1##S), x2a = bflo(r2##S), x2b = bfhi(r2##S); \
                    *(unsigned*)(ur##S + U_KR + ki) = cvtpk(x1a * d0 - x2a * e0, x1b * d1 - x2b * e1); *(unsigned*)(ur##S + U_KR + 16 + ki) = cvtpk(x2a * d0 + x1a * e0, x2b * d1 + x1b * e1); } } \
                { const int plo = max(tloc##S - (pw_ >> 1), 0), phi = min(tloc##S - (pw_ >> 1) + pw_, nseq##S); f32x4 s_ = {0.f, 0.f, 0.f, 0.f}; \
                  _Pragma("unroll") for (int i = 0; i < 16; ++i) { const int t_ = tloc##S - 8 + i; const float wt = (t_ >= plo && t_ < phi) ? 1.f : 0.f; \
                      s_[0] += wt * bflo(nb##S[i].x); s_[1] += wt * bfhi(nb##S[i].x); s_[2] += wt * bflo(nb##S[i].y); s_[3] += wt * bfhi(nb##S[i].y); } \
                  const float ic = 1.f / (float)(phi - plo); u32x2 o_; o_.x = cvtpk(s_[0] * ic - bflo(ps##S.x), s_[1] * ic - bfhi(ps##S.x)); o_.y = cvtpk(s_[2] * ic - bflo(ps##S.y), s_[3] * ic - bfhi(ps##S.y)); \
                  *(u32x2*)(Yb + (size_t)row_ * YW + lane * 4) = o_; } } while (0)
            P2B_DECL(A) P2B_DECL(B)
            for (int row = gw * 2; row < MT; row += NGW * 2) {
                P2B_LOAD(A, row); P2B_LOAD(B, row + 1);
                P2B_PROC(A, row); P2B_PROC(B, row + 1);
            }
#undef P2B_DECL
#undef P2B_LOAD
#undef P2B_PROC
        }
        PH_END

        PH_BEGIN PH_LAYER
        { pg8::SchedPlain S; S.so.init(Mq, QW, G, bx); S.A = (const char*)(Ub + U_CQ); S.B = (const char*)(wl + W_QF); S.a_t = (size_t)256 * UW * 2; S.b_t = (size_t)256 * 256 * 2; S.nt = 4;
          EpiQRope E{Qm}; pg8::gemm_phase(lds, UW * 2, 256 * 2, S, E); }
        PH_END

        PH_BEGIN PH_LAYER
        {
            const float* rpb = ap->in[I_RPB] + (size_t)l * 4 * 15 * 31; const float* snk = ap->in[I_SINK] + l * 4;
            for (int i = bx; i < 512; i += G) { const int b = i >> 8, tb = i & 255;
                mla_unit(lds, Ub, Qm, Yb, b * SEQ + tb * 64, NLAT + b * CTXL, 256, b * SEQ); }
            for (int i = bx; i < 512; i += G) { const int b = i >> 8, r = i & 255, r0 = min(max(r - 4, 0), 248);
                attn_unit<1>(lds, Ub, Qm, Yb, rpb, snk, b * SEQ + r * 64, NLAT + b * CTXL, 8, b * SEQ + r0 * 64, r, r0, 0); }
            for (int i = bx; i < 512; i += G) { const int b = i >> 8, rem = i & 255, kvh = rem >> 7, n = rem & 127;
                const int jlo = n == 0 ? 2 : 0, jhi = n == 127 ? 4 : 6, kp0 = (n - 1) * 128 + 64 * jlo;
                attn_unit<2>(lds, Ub, Qm, Yb, rpb, snk, b * SEQ + n * 128, NLAT + b * CTXL, jhi - jlo, b * SEQ + kp0, n * 128, kp0, kvh); }
            if (l == 0) {
                for (int i = bx; i < 24; i += G) { const int kind = i >> 3, j = i & 7, b = j >> 2;
                    if (kind == 0) mla_unit(lds, Ub, Qm, Yb, NLAT + b * CTXL + 64 * (j & 3), NLAT + b * CTXL, 0, 0);
                    else if (kind == 1) attn_unit<1>(lds, Ub, Qm, Yb, rpb, snk, NLAT + b * CTXL + 64 * (j & 3), NLAT + b * CTXL, 0, 0, 0, 0, 0);
                    else attn_unit<2>(lds, Ub, Qm, Yb, rpb, snk, NLAT + b * CTXL + 128 * (j & 1), NLAT + b * CTXL, 0, 0, 0, 0, (j >> 1) & 1); }
            }
        }
        PH_END

        PH_BEGIN PH_LAYER
        { pg8::SchedBranch S; S.so.init(Mq, 4096, G, bx); S.A = (const char*)Yb; S.B = (const char*)(wl + W_B); S.a_t = (size_t)256 * YW * 2;
          EpiStore E{Yall, 4096}; pg8::gemm_phase(lds, YW * 2, 512 * 2, S, E); }
        PH_END

        PH_BEGIN PH_LAYER
        { pg8::SchedPlain S; S.so.init(Mq, 4096, G, bx); S.A = (const char*)Hb; S.B = (const char*)(wl + W_G); S.a_t = (size_t)256 * D * 2; S.b_t = (size_t)256 * D * 2; S.nt = D / 64;
          EpiMerge E{Yall, Mg}; pg8::gemm_phase(lds, D * 2, D * 2, S, E); }
        PH_END

        PH_BEGIN PH_LAYER
        { pg8::SchedPlain S; S.so.init(Mq, D, G, bx); S.A = (const char*)Mg; S.B = (const char*)(wl + W_O); S.a_t = (size_t)256 * D * 2; S.b_t = (size_t)256 * D * 2; S.nt = D / 64;
          EpiResid E{l == 0 ? ap->in[I_X] : nullptr, (bf16_t*)out, cres, xc, modl + 2 * D}; pg8::gemm_phase(lds, D * 2, D * 2, S, E); }
        PH_END

        PH_BEGIN PH_LAYER
        NORM_PHASE(out, xc, ap->in[I_N2G] + l * D, 3, 4, true)
        PH_END

        PH_BEGIN PH_LAYER
        { pg8::SchedPlain S; S.so.init(Mq, 2 * FF, G, bx); S.A = (const char*)Hb; S.B = (const char*)(wl + W_13); S.a_t = (size_t)256 * D * 2; S.b_t = (size_t)256 * D * 2; S.nt = D / 64;
          EpiSwiGLU E{Hid}; pg8::gemm_phase(lds, D * 2, D * 2, S, E); }
        PH_END

        PH_BEGIN PH_LAYER
        { pg8::SchedPlain S; S.so.init(Mq, D, G, bx); S.A = (const char*)Hid; S.B = (const char*)(wl + W_2); S.a_t = (size_t)256 * FF * 2; S.b_t = (size_t)256 * FF * 2; S.nt = FF / 64;
          EpiResid E{nullptr, (bf16_t*)out, xc, xc, modl + 5 * D}; pg8::gemm_phase(lds, FF * 2, FF * 2, S, E); }
        PH_END
    }

    PH_BEGIN
    {
        const float* fg = ap->in[I_FNG];
        for (int r0 = gw * 4; r0 < NLAT; r0 += NGW * 4) {
            float* src = out + (size_t)r0 * D; f32x4 xv[4][4]; float ss[4];
            const bf16_t* sb_ = (const bf16_t*)out + (size_t)r0 * 2048 + 1024;
#pragma unroll
            for (int rr = 0; rr < 4; ++rr)
#pragma unroll
                for (int j = 0; j < 4; ++j) { const u32x2 w_ = *(const u32x2*)(sb_ + rr * 2048 + lane * 4 + 256 * j); xv[rr][j] = (f32x4){bflo(w_.x), bfhi(w_.x), bflo(w_.y), bfhi(w_.y)}; }
            asm volatile("s_waitcnt vmcnt(0)" ::: "memory");
#pragma unroll
            for (int rr = 0; rr < 4; ++rr) { float a_ = 0.f;
#pragma unroll
                for (int j = 0; j < 4; ++j) a_ += xv[rr][j][0] * xv[rr][j][0] + xv[rr][j][1] * xv[rr][j][1] + xv[rr][j][2] * xv[rr][j][2] + xv[rr][j][3] * xv[rr][j][3];
                ss[rr] = a_; }
#pragma unroll
            for (int o_ = 1; o_ < 64; o_ <<= 1)
#pragma unroll
                for (int rr = 0; rr < 4; ++rr) ss[rr] += __uint_as_float((unsigned)__builtin_amdgcn_ds_bpermute((lane ^ o_) << 2, (int)__float_as_uint(ss[rr])));
#pragma unroll
            for (int rr = 0; rr < 4; ++rr) ss[rr] = rsqrtf(ss[rr] * (1.f / D) + EPSV);
#pragma unroll
            for (int j = 0; j < 4; ++j) { const f32x4 g = *(const f32x4*)(fg + lane * 4 + 256 * j);
#pragma unroll
                for (int rr = 0; rr < 4; ++rr) *(f32x4*)(src + rr * D + lane * 4 + 256 * j) = xv[rr][j] * ss[rr] * g; }
        }
    }
    PH_ENDL
}

extern "C" void kernel_launch(void* const* d_in, const int* in_sizes, int n_in, void* d_out, int out_size, void* d_ws, size_t ws_size, hipStream_t stream) {
    static int grid = 0;
    if (grid == 0) {
        if (n_in != 24 || out_size != NLAT * D || ws_size < WS_END) { fprintf(stderr, "kernel_launch: unexpected shapes (n_in %d out %d ws %zu)\n", n_in, out_size, ws_size); grid = -1; return; }
        int dev = 0, cus = 0, per_cu = 0;
        hipGetDevice(&dev);
        hipDeviceGetAttribute(&cus, hipDeviceAttributeMultiprocessorCount, dev);
        hipFuncSetAttribute((const void*)mk_fwd, hipFuncAttributeMaxDynamicSharedMemorySize, LDS_BYTES);
        hipOccupancyMaxActiveBlocksPerMultiprocessor(&per_cu, (const void*)mk_fwd, NTHREADS, LDS_BYTES);
        if (per_cu < 1) { fprintf(stderr, "kernel_launch: occupancy query returned %d\n", per_cu); per_cu = 1; }
        (void)hipGetLastError();
        grid = cus * per_cu;
    }
    if (grid < 0) return;
    Args a{};
    for (int i = 0; i < 24; ++i) a.in[i] = (const float*)d_in[i];
    a.out = (float*)d_out; a.ws = (unsigned char*)d_ws;
    if (hipMemsetAsync(d_ws, 0, XCD_BAR_WORDS * 4, stream) != hipSuccess) { fprintf(stderr, "memset of barrier words failed\n"); return; }
    void* kargs[] = {&a};
    hipError_t e = hipLaunchCooperativeKernel((const void*)mk_fwd, dim3(grid), dim3(NTHREADS), kargs, LDS_BYTES, stream);
    if (e != hipSuccess) fprintf(stderr, "cooperative launch failed: %s (grid %d)\n", hipGetErrorString(e), grid);
}
```

```cpp
#include <hip/hip_runtime.h>
#include <hip/hip_cooperative_groups.h>
#include <cstdio>
#include <cstdint>
namespace cg = cooperative_groups;

#define LAS __attribute__((address_space(3)))
typedef unsigned short bf16_t;
typedef short bf16x8 __attribute__((ext_vector_type(8)));
typedef short s16x4 __attribute__((ext_vector_type(4)));
typedef short v4i16_t __attribute__((ext_vector_type(4)));
typedef float f32x4 __attribute__((ext_vector_type(4)));
typedef float f32x16 __attribute__((ext_vector_type(16)));
typedef unsigned u32x4 __attribute__((ext_vector_type(4)));
typedef unsigned u32x2 __attribute__((ext_vector_type(2)));
typedef float f32x2_t __attribute__((ext_vector_type(2)));
typedef __bf16 bf16x2_t __attribute__((ext_vector_type(2)));

constexpr int D = 1024, NB = 2, SEQ = 16384, NLAT = NB * SEQ, CTXL = 256, NCTX = NB * CTXL, MT = NLAT + NCTX;
constexpr int INC = 6048, FF = 2816, DEPTH = 2;
constexpr int UW = 2048, QW = 768, YW = 1280;
constexpr int U_NAK = 0, U_NAV = 256, U_SWK = 512, U_SWV = 640, U_CKV = 768, U_KR = 896, U_NAQ = 928, U_SWQ = 1184, U_CQ = 1440, U_POOL = 1696, U_END = 1952;
constexpr float EPSV = 1e-6f;
constexpr float LOG2E = 1.4426950408889634f;
constexpr float QSC64 = 0.125f * LOG2E;
constexpr float QSCMLA = 0.10206207261596577f * LOG2E;

constexpr size_t MiB = 1u << 20;
constexpr size_t WS_MOD = 1 * MiB, WS_XC = 2 * MiB, WS_W = 8 * MiB, WS_H = 80 * MiB, WS_Y = 145 * MiB, WS_R4 = 227 * MiB, WS_QM = WS_R4 + 130 * MiB, WS_END = 487 * MiB;
constexpr size_t WL = 35 * MiB;
constexpr size_t W_U = 0, W_G = 4 * MiB, W_QF = 12 * MiB, W_B = 12 * MiB + 512 * 1024, W_O = 16 * MiB + 512 * 1024, W_13 = 18 * MiB + 512 * 1024, W_2 = 29 * MiB + 512 * 1024;

constexpr int NTHREADS = 512;
constexpr int LDS_BYTES = 147456;

__device__ __forceinline__ unsigned cvtpk(float lo, float hi) { f32x2_t v = {lo, hi}; bf16x2_t b = __builtin_convertvector(v, bf16x2_t); return __builtin_bit_cast(unsigned, b); }
__device__ __forceinline__ float bflo(unsigned w) { return __uint_as_float(w << 16); }
__device__ __forceinline__ float bfhi(unsigned w) { return __uint_as_float(w & 0xffff0000u); }
__device__ __forceinline__ float bf2f(bf16_t h) { return __uint_as_float(((unsigned)h) << 16); }
__device__ __forceinline__ bf16_t f2bf(float f) { return (bf16_t)(cvtpk(f, 0.f) & 0xffffu); }
__device__ __forceinline__ float wave_sum_l(float v, int lane) {
#pragma unroll
    for (int o = 1; o < 64; o <<= 1) v += __uint_as_float((unsigned)__builtin_amdgcn_ds_bpermute((lane ^ o) << 2, (int)__float_as_uint(v)));
    return v;
}
__device__ __forceinline__ float xhalf_max(float m) { auto rr = __builtin_amdgcn_permlane32_swap(__float_as_uint(m), __float_as_uint(m), false, false); return fmaxf(__uint_as_float(rr[0]), __uint_as_float(rr[1])); }
__device__ __forceinline__ float xhalf_sum(float m) { auto rr = __builtin_amdgcn_permlane32_swap(__float_as_uint(m), __float_as_uint(m), false, false); return __uint_as_float(rr[0]) + __uint_as_float(rr[1]); }
__device__ __forceinline__ int fresh_tid() { int t = threadIdx.x; asm volatile("" : "+v"(t)); return t; }
__device__ __forceinline__ float fexp2(float x) { return __builtin_amdgcn_exp2f(x); }
__device__ __forceinline__ float frcp(float x) { return __builtin_amdgcn_rcpf(x); }
__device__ __forceinline__ float sigmoidf_(float x) { return frcp(1.f + fexp2(-x * LOG2E)); }

namespace pg8 {
constexpr int BM = 256, BK = 64, HALF = 128, HTB = HALF * BK * 2, STAGE_BYTES = 8 * HTB, NXCD = 8, WGM = 8;
__device__ __forceinline__ int lds_byte(int r, int c) { const int st = (r >> 4) * 2 + (c >> 5), rr = r & 15, cc = c & 31, ob = rr * 64 + cc * 2; return st * 1024 + (ob ^ (((ob >> 9) & 1) << 5)); }
__device__ __forceinline__ void stage_rc(int b, int& R, int& C) { const int st = b / 1024, sb = b % 1024, swz = sb ^ (((sb >> 9) & 1) << 5); R = (st >> 1) * 16 + swz / 64; C = (st & 1) * 32 + (swz % 64) / 2; }

struct Unit { const char* A; const char* B; int pm, pn, nt; };

struct StaticOrder {
    int nM, nN, nwg, G, c; bool rev;
    __device__ void init(int M, int N, int G_, int c_, bool rev_ = false) { nM = M / BM; nN = N / BM; nwg = nM * nN; G = G_; c = c_; rev = rev_; }
    __device__ bool next(int i, int& pm, int& pn) const {
        const long L = (long)i * G + c; if (L >= nwg) return false;
        int wgid = rev ? nwg - 1 - (int)L : (int)L; { const int q = nwg / NXCD, r = nwg % NXCD, xcd = wgid % NXCD, off = wgid / NXCD; wgid = (xcd < r ? xcd * (q + 1) : r * (q + 1) + (xcd - r) * q) + off; }
        const int nig = WGM * nN, gid = wgid / nig, fm = gid * WGM, gsz = (nM - fm) < WGM ? (nM - fm) : WGM;
        pm = fm + ((wgid % nig) % gsz); pn = (wgid % nig) / gsz; return true;
    }
};
struct SchedPlain {
    StaticOrder so; const char* A; const char* B; size_t a_t, b_t; int nt;
    __device__ bool next(int i, Unit& u) const { int pm, pn; if (!so.next(i, pm, pn)) return false; u.pm = pm; u.pn = pn; u.A = A + (size_t)pm * a_t; u.B = B + (size_t)pn * b_t; u.nt = nt; return true; }
};
struct SchedBranch {
    StaticOrder so; const char* A; const char* B; size_t a_t;
    __device__ bool next(int i, Unit& u) const { int pm, pn; if (!so.next(i, pm, pn)) return false; u.pm = pm; u.pn = pn; const int br = pn >> 2;
        u.A = A + (size_t)pm * a_t + (size_t)br * 512; u.B = B + (size_t)br * (1024 * 512 * 2) + (size_t)(pn & 3) * (256 * 512 * 2); u.nt = br == 3 ? 8 : 4; return true; }
};

template <class Epi, class Sched>
__device__ __forceinline__ void gemm_phase(LAS unsigned char* lds, const int lda, const int ldb, const Sched& S, Epi& E) {
    const int tid = fresh_tid(), wid = __builtin_amdgcn_readfirstlane(tid >> 6), lane = tid & 63, wr = wid >> 2, wc = wid & 3, fr = lane & 15, fq = lane >> 4;
    unsigned voffA[2], voffB[2];
#pragma unroll
    for (int i = 0; i < 2; ++i) { int R, C; stage_rc(tid * 16 + i * 8192, R, C); voffA[i] = (unsigned)(R * lda + C * 2); voffB[i] = (unsigned)(R * ldb + C * 2); }
    const size_t kstep = (size_t)(BK * 2);
    const size_t hstepA = (size_t)HALF * lda, hstepB = (size_t)HALF * ldb;
    const unsigned ldsw = (unsigned)wid * 1024u;
    const int aoff = lds_byte(wr * 64 + fr, fq * 8), boff = lds_byte(wc * 32 + fr, fq * 8);
#define PG8_SA(b, h) (((b) * 2 + (h)) * HTB)
#define PG8_SB(b, h) ((4 + (b) * 2 + (h)) * HTB)
#define PG8_STAGE(bufoff, gbase, voff) do { _Pragma("unroll") for (int _i = 0; _i < 2; ++_i) \
        __builtin_amdgcn_global_load_lds((const unsigned*)((const char*)(gbase) + (voff)[_i]), (LAS unsigned*)(lds + (bufoff) + ldsw + _i * 8192), 16, 0, 0); } while (0)
#define PG8_LDA(dst, b, h) do { _Pragma("unroll") for (int m = 0; m < 4; ++m) _Pragma("unroll") for (int k = 0; k < 2; ++k) dst[m][k] = *(const LAS bf16x8*)(lds + PG8_SA(b, h) + aoff + m * 2048 + k * 1024); } while (0)
#define PG8_LDB(dst, b, h) do { _Pragma("unroll") for (int n = 0; n < 2; ++n) _Pragma("unroll") for (int k = 0; k < 2; ++k) dst[n][k] = *(const LAS bf16x8*)(lds + PG8_SB(b, h) + boff + n * 2048 + k * 1024); } while (0)
#define PG8_MMA(ai, bj, At, Bt) do { __builtin_amdgcn_s_setprio(1); _Pragma("unroll") for (int m = 0; m < 4; ++m) _Pragma("unroll") for (int n = 0; n < 2; ++n) _Pragma("unroll") for (int k = 0; k < 2; ++k) \
        acc[ai][bj][m][n] = __builtin_amdgcn_mfma_f32_16x16x32_bf16(Bt[n][k], At[m][k], acc[ai][bj][m][n], 0, 0, 0); __builtin_amdgcn_s_setprio(0); } while (0)
#define PG8_WAIT_V(n) asm volatile("s_waitcnt vmcnt(" #n ")" ::: "memory")
#define PG8_WAIT_L(n) asm volatile("s_waitcnt lgkmcnt(" #n ")" ::: "memory")
#define PG8_BAR __builtin_amdgcn_s_barrier()
#define PG8_SCHED __builtin_amdgcn_sched_barrier(0)
    Unit cur, nxt; int ui = 0;
    if (!S.next(0, cur)) return;
    f32x4 acc[2][2][4][2];
#pragma unroll
    for (int a = 0; a < 2; ++a)
#pragma unroll
        for (int b = 0; b < 2; ++b)
#pragma unroll
            for (int m = 0; m < 4; ++m)
#pragma unroll
                for (int n = 0; n < 2; ++n) acc[a][b][m][n] = (f32x4){0.f, 0.f, 0.f, 0.f};
    bf16x8 At[4][2], B0[2][2], B1[2][2];
    const char* cA = cur.A; const char* cB = cur.B;
    PG8_STAGE(PG8_SB(0, 0), cB, voffB); PG8_STAGE(PG8_SB(0, 1), cB + hstepB, voffB); PG8_STAGE(PG8_SA(0, 0), cA, voffA); PG8_STAGE(PG8_SA(0, 1), cA + hstepA, voffA);
    if (wr == 1) PG8_BAR;
    PG8_WAIT_V(2); PG8_BAR;
    PG8_STAGE(PG8_SB(1, 0), cB + kstep, voffB); PG8_STAGE(PG8_SA(1, 0), cA + kstep, voffA); PG8_STAGE(PG8_SB(1, 1), cB + hstepB + kstep, voffB);
    PG8_WAIT_V(6); PG8_BAR;
    for (;;) {
        const bool has_next = S.next(ui + 1, nxt);
        const char* nA = has_next ? nxt.A : cA; const char* nB = has_next ? nxt.B : cB;
        const int nt = cur.nt;
        for (int t = 0; t < nt; t += 2) {
            const bool last = (t == nt - 2);
            const char* a1 = cA + (size_t)(t + 1) * kstep;
            const char* a2 = last ? nA : cA + (size_t)(t + 2) * kstep; const char* b2 = last ? nB : cB + (size_t)(t + 2) * kstep;
            const char* a3 = a2 + kstep; const char* b3 = b2 + kstep;
            PG8_LDB(B0, 0, 0); PG8_LDB(B1, 0, 1); PG8_SCHED; PG8_LDA(At, 0, 0); PG8_STAGE(PG8_SA(1, 1), a1 + hstepA, voffA);
            PG8_WAIT_V(8); PG8_WAIT_L(0); PG8_BAR; PG8_MMA(0, 0, At, B0); PG8_MMA(0, 1, At, B1); PG8_BAR; PG8_SCHED;
            PG8_LDA(At, 0, 1); PG8_STAGE(PG8_SB(0, 0), b2, voffB); PG8_STAGE(PG8_SB(0, 1), b2 + hstepB, voffB); PG8_STAGE(PG8_SA(0, 0), a2, voffA);
            PG8_WAIT_V(8); PG8_WAIT_L(0); PG8_BAR; PG8_MMA(1, 0, At, B0); PG8_MMA(1, 1, At, B1); PG8_BAR; PG8_SCHED;
            PG8_LDB(B0, 1, 0); PG8_LDB(B1, 1, 1); PG8_SCHED; PG8_LDA(At, 1, 0); PG8_STAGE(PG8_SA(0, 1), a2 + hstepA, voffA);
            PG8_WAIT_V(8); PG8_WAIT_L(0); PG8_BAR; PG8_MMA(0, 0, At, B0); PG8_MMA(0, 1, At, B1); PG8_BAR; PG8_SCHED;
            PG8_LDA(At, 1, 1); PG8_STAGE(PG8_SB(1, 0), b3, voffB); PG8_STAGE(PG8_SB(1, 1), b3 + hstepB, voffB); PG8_STAGE(PG8_SA(1, 0), a3, voffA);
            PG8_WAIT_V(8); PG8_WAIT_L(0); PG8_BAR; PG8_MMA(1, 0, At, B0); PG8_MMA(1, 1, At, B1); PG8_BAR; PG8_SCHED;
        }
        if (wr == 0) PG8_BAR;
        E(acc, cur, wr, wc, fr, fq);
        if (!has_next) break;
#pragma unroll
        for (int a = 0; a < 2; ++a)
#pragma unroll
            for (int b = 0; b < 2; ++b)
#pragma unroll
                for (int m = 0; m < 4; ++m)
#pragma unroll
                    for (int n = 0; n < 2; ++n) acc[a][b][m][n] = (f32x4){0.f, 0.f, 0.f, 0.f};
        cur = nxt; cA = nA; cB = nB; ++ui;
        if (wr == 1) PG8_BAR;
    }
    PG8_WAIT_V(0);
    PG8_BAR;
#undef PG8_SA
#undef PG8_SB
#undef PG8_STAGE
#undef PG8_LDA
#undef PG8_LDB
#undef PG8_MMA
#undef PG8_WAIT_V
#undef PG8_WAIT_L
#undef PG8_BAR
#undef PG8_SCHED
}
}

typedef f32x4 acc_t[2][2][4][2];

struct EpiStore {
    bf16_t* O; int ldc;
    __device__ __forceinline__ void operator()(const acc_t& acc, const pg8::Unit& u, int wr, int wc, int fr, int fq) const {
        const int row0 = u.pm * 256 + wr * 64 + fr, col0 = u.pn * 256 + wc * 32 + 4 * fq;
#pragma unroll
        for (int ai = 0; ai < 2; ++ai)
#pragma unroll
            for (int m = 0; m < 4; ++m) { bf16_t* rowp = O + (size_t)(row0 + ai * 128 + m * 16) * ldc + col0;
#pragma unroll
                for (int bj = 0; bj < 2; ++bj)
#pragma unroll
                    for (int n = 0; n < 2; ++n) { const f32x4 v = acc[ai][bj][m][n]; u32x2 w; w.x = cvtpk(v[0], v[1]); w.y = cvtpk(v[2], v[3]); *(u32x2*)(rowp + bj * 128 + n * 16) = w; } }
    }
};
struct EpiQRope {
    bf16_t* O;
    __device__ __forceinline__ void operator()(const acc_t& acc, const pg8::Unit& u, int wr, int wc, int fr, int fq) const {
        const int row0 = u.pm * 256 + wr * 64 + fr, col0 = u.pn * 256 + wc * 32 + 4 * fq;
        const bool latent = u.pm < 128;
        float inv[4];
#pragma unroll
        for (int j = 0; j < 4; ++j) inv[j] = exp2f(-(float)(4 * (fq & 1) + j) * 1.6609640474436813f);
#pragma unroll
        for (int ai = 0; ai < 2; ++ai)
#pragma unroll
            for (int m = 0; m < 4; ++m) { const int row = row0 + ai * 128 + m * 16; bf16_t* rowp = O + (size_t)row * QW + col0;
                const int t = row & (SEQ - 1); const float pos = (float)((fq < 2) ? (t >> 6) : (t & 63));
#pragma unroll
                for (int bj = 0; bj < 2; ++bj) { const int cb = u.pn * 8 + bj * 4 + wc; f32x4 v0 = acc[ai][bj][m][0], v1 = acc[ai][bj][m][1];
                    if (latent && (cb == 4 || cb == 9 || cb == 14 || cb == 19)) {
#pragma unroll
                        for (int j = 0; j < 4; ++j) { const float a = pos * inv[j]; const float cs = __cosf(a), sn = __sinf(a); const float x1 = v0[j], x2 = v1[j]; v0[j] = x1 * cs - x2 * sn; v1[j] = x2 * cs + x1 * sn; }
                    }
                    u32x2 w; w.x = cvtpk(v0[0], v0[1]); w.y = cvtpk(v0[2], v0[3]); *(u32x2*)(rowp + bj * 128) = w;
                    w.x = cvtpk(v1[0], v1[1]); w.y = cvtpk(v1[2], v1[3]); *(u32x2*)(rowp + bj * 128 + 16) = w; } }
    }
};
struct EpiMerge {
    const bf16_t* Yall; bf16_t* Mg;
    __device__ __forceinline__ void operator()(const acc_t& acc, const pg8::Unit& u, int wr, int wc, int fr, int fq) const {
        const int row0 = u.pm * 256 + wr * 64 + fr, ocol = u.pn * 64 + wc * 16 + 4 * fq;
#pragma unroll
        for (int ai = 0; ai < 2; ++ai)
#pragma unroll
            for (int m = 0; m < 4; ++m) { const int row = row0 + ai * 128 + m * 16; const bf16_t* yr = Yall + (size_t)row * 4096 + ocol; f32x4 s = {0.f, 0.f, 0.f, 0.f};
#pragma unroll
                for (int bj = 0; bj < 2; ++bj)
#pragma unroll
                    for (int n = 0; n < 2; ++n) { const u32x2 w = *(const u32x2*)(yr + (2 * bj + n) * 1024); const f32x4 g = acc[ai][bj][m][n];
                        s[0] += sigmoidf_(g[0]) * bflo(w.x); s[1] += sigmoidf_(g[1]) * bfhi(w.x); s[2] += sigmoidf_(g[2]) * bflo(w.y); s[3] += sigmoidf_(g[3]) * bfhi(w.y); }
                u32x2 o; o.x = cvtpk(s[0], s[1]); o.y = cvtpk(s[2], s[3]); *(u32x2*)(Mg + (size_t)row * D + ocol) = o; }
    }
};
struct EpiResid {
    const float* res_lat_f32;
    bf16_t* rb;
    const float* res_ctx; float* out_ctx; const float* gate;
    __device__ __forceinline__ void operator()(const acc_t& acc, const pg8::Unit& u, int wr, int wc, int fr, int fq) const {
        const int lrow0 = wr * 64 + fr, col0 = u.pn * 256 + wc * 32 + 4 * fq;
        const int v = u.pm < 128 ? (u.pm >> 6) : 2;
        const float* gp = gate + v * 6144;
        f32x4 gv[2][2];
#pragma unroll
        for (int bj = 0; bj < 2; ++bj)
#pragma unroll
            for (int n = 0; n < 2; ++n) gv[bj][n] = *(const f32x4*)(gp + col0 + bj * 128 + n * 16);
        if (u.pm < 128) {
            bf16_t* rbt = rb + (size_t)u.pm * 256 * 2048 + 1024;
            if (res_lat_f32) {
                const float* res = res_lat_f32 + (size_t)u.pm * 256 * D;
#pragma unroll
                for (int ai = 0; ai < 2; ++ai)
#pragma unroll
                    for (int m = 0; m < 4; ++m) { const int lr = lrow0 + ai * 128 + m * 16;
#pragma unroll
                        for (int bj = 0; bj < 2; ++bj)
#pragma unroll
                            for (int n = 0; n < 2; ++n) { const int c = col0 + bj * 128 + n * 16; const f32x4 r = *(const f32x4*)(res + (size_t)lr * D + c);
                                const f32x4 o = r + gv[bj][n] * acc[ai][bj][m][n];
                                u32x2 w2; w2.x = cvtpk(o[0], o[1]); w2.y = cvtpk(o[2], o[3]); *(u32x2*)(rbt + (size_t)lr * 2048 + c) = w2; } }
            } else {
#pragma unroll
                for (int ai = 0; ai < 2; ++ai)
#pragma unroll
                    for (int m = 0; m < 4; ++m) { const int lr = lrow0 + ai * 128 + m * 16;
#pragma unroll
                        for (int bj = 0; bj < 2; ++bj)
#pragma unroll
                            for (int n = 0; n < 2; ++n) { const int c = col0 + bj * 128 + n * 16; const u32x2 w = *(const u32x2*)(rbt + (size_t)lr * 2048 + c);
                                const f32x4 r = (f32x4){bflo(w.x), bfhi(w.x), bflo(w.y), bfhi(w.y)};
                                const f32x4 o = r + gv[bj][n] * acc[ai][bj][m][n];
                                u32x2 w2; w2.x = cvtpk(o[0], o[1]); w2.y = cvtpk(o[2], o[3]); *(u32x2*)(rbt + (size_t)lr * 2048 + c) = w2; } }
            }
        } else {
            const float* res = res_ctx + (size_t)(u.pm - 128) * 256 * D; float* out = out_ctx + (size_t)(u.pm - 128) * 256 * D;
#pragma unroll
            for (int ai = 0; ai < 2; ++ai)
#pragma unroll
                for (int m = 0; m < 4; ++m) { const size_t off = (size_t)(lrow0 + ai * 128 + m * 16) * D + col0;
#pragma unroll
                    for (int bj = 0; bj < 2; ++bj)
#pragma unroll
                        for (int n = 0; n < 2; ++n) { const f32x4 r = *(const f32x4*)(res + off + bj * 128 + n * 16); *(f32x4*)(out + off + bj * 128 + n * 16) = r + gv[bj][n] * acc[ai][bj][m][n]; } }
        }
    }
};
struct EpiSwiGLU {
    bf16_t* Hd;
    __device__ __forceinline__ void operator()(const acc_t& acc, const pg8::Unit& u, int wr, int wc, int fr, int fq) const {
        const int row0 = u.pm * 256 + wr * 64 + fr, hcol = u.pn * 128 + wc * 32 + 4 * fq;
#pragma unroll
        for (int ai = 0; ai < 2; ++ai)
#pragma unroll
            for (int m = 0; m < 4; ++m) { bf16_t* rowp = Hd + (size_t)(row0 + ai * 128 + m * 16) * FF + hcol;
#pragma unroll
                for (int n = 0; n < 2; ++n) { const f32x4 a = acc[ai][0][m][n], b = acc[ai][1][m][n]; f32x4 v;
#pragma unroll
                    for (int j = 0; j < 4; ++j) v[j] = a[j] * sigmoidf_(a[j]) * b[j];
                    u32x2 w; w.x = cvtpk(v[0], v[1]); w.y = cvtpk(v[2], v[3]); *(u32x2*)(rowp + n * 16) = w; } }
    }
};

__device__ __forceinline__ s16x4 vtr(LAS const unsigned char* p) { return __builtin_bit_cast(s16x4, __builtin_amdgcn_ds_read_tr16_b64_v4i16((LAS v4i16_t*)p)); }
__device__ __forceinline__ int crow(int r, int hi) { return (r & 3) + 8 * (r >> 2) + 4 * hi; }

template <int MODE>
__device__ __forceinline__ void attn_unit(LAS unsigned char* lds, const bf16_t* __restrict__ u, const bf16_t* __restrict__ qm, bf16_t* __restrict__ y,
                                          const float* __restrict__ rpb, const float* __restrict__ sink,
                                          int qrow0, int kctx_row0, int nlocal, int loc_row0, int aux0, int aux1, int kvh) {
    constexpr int KW = MODE == 0 ? 160 : (MODE == 1 ? 256 : 64);
    constexpr int KSTR = KW * 2 + 16;
    constexpr int NKS = MODE == 0 ? 10 : 4;
    constexpr int NDB = MODE == 0 ? 4 : 2;
    constexpr bool VSEP = MODE != 0;
    constexpr int CPR = KW / 8, NCH = 64 * CPR, NLD = (NCH + 511) / 512;
    constexpr int STAGE = (VSEP ? 2 : 1) * 64 * KSTR;
    const int tid = fresh_tid(), lane = tid & 63, wid = __builtin_amdgcn_readfirstlane(tid >> 6), l32 = lane & 31, hi = lane >> 5;
    int head, qtok, kcolw, kgcol, vgcol, ycol;
    if (MODE == 0) { head = wid & 3; qtok = 32 * (wid >> 2) + l32; kcolw = 0; kgcol = U_CKV; vgcol = U_CKV; ycol = 768 + head * 128; }
    else if (MODE == 1) { head = wid & 3; qtok = 32 * (wid >> 2) + l32; kcolw = head * 64; kgcol = U_NAK; vgcol = U_NAV; ycol = 256 + head * 64; }
    else { head = kvh * 2 + (wid & 1); qtok = 32 * (wid >> 1) + l32; kcolw = 0; kgcol = U_SWK + kvh * 64; vgcol = U_SWV + kvh * 64; ycol = 512 + head * 64; }
    const bf16_t* qp = MODE == 0 ? qm + (size_t)(qrow0 + qtok) * QW + head * 160 : u + (size_t)(qrow0 + qtok) * UW + (MODE == 1 ? U_NAQ : U_SWQ) + head * 64;
    bf16x8 qf[NKS];
#pragma unroll
    for (int ks = 0; ks < NKS; ++ks) qf[ks] = *(const bf16x8*)(qp + 16 * ks + 8 * hi);
    f32x16 o[NDB];
#pragma unroll
    for (int c = 0; c < NDB; ++c)
#pragma unroll
        for (int r = 0; r < 16; ++r) o[c][r] = 0.f;
    float mrun = -1e30f, lrun = 0.f;
    int srow[NLD], sch[NLD];
#pragma unroll
    for (int i = 0; i < NLD; ++i) { const int idx = tid + 512 * i; srow[i] = idx / CPR; sch[i] = idx % CPR; }
    u32x4 kreg[NLD], vreg[NLD];
    const int ntile = 4 + nlocal;
    unsigned dvo[5];
    if (MODE == 1) {
#pragma unroll
        for (int i = 0; i < 5; ++i) { const int sl = (wid + 8 * i) * 64 + lane, row = (sl / 33) & 63, ch = sl % 33; dvo[i] = (unsigned)(row * (UW * 2) + (ch < 32 ? ch : 0) * 16); }
    }
#define ATT_DMA(t, buf) do { const char* tb_ = (const char*)u + (size_t)ATT_TROW(t) * (UW * 2); _Pragma("unroll") for (int i = 0; i < 5; ++i) if (wid + 8 * i < 33) { \
        __builtin_amdgcn_global_load_lds((const unsigned*)(tb_ + kgcol * 2 + dvo[i]), (LAS unsigned*)(lds + (buf) * STAGE + (wid + 8 * i) * 1024), 16, 0, 0); \
        __builtin_amdgcn_global_load_lds((const unsigned*)(tb_ + vgcol * 2 + dvo[i]), (LAS unsigned*)(lds + (buf) * STAGE + 64 * KSTR + (wid + 8 * i) * 1024), 16, 0, 0); } } while (0)
#define ATT_TROW(t) ((t) < 4 ? kctx_row0 + 64 * (t) : loc_row0 + 64 * ((t) - 4))
#define ATT_LOAD(t) do { const int rg_ = ATT_TROW(t); _Pragma("unroll") for (int i = 0; i < NLD; ++i) if (NCH % 512 == 0 || i < NLD - 1 || tid + 512 * i < NCH) { \
        const bf16_t* gp_ = u + (size_t)(rg_ + srow[i]) * UW + sch[i] * 8; kreg[i] = *(const u32x4*)(gp_ + kgcol); if (VSEP) vreg[i] = *(const u32x4*)(gp_ + vgcol); } } while (0)
#define ATT_STORE(buf) do { _Pragma("unroll") for (int i = 0; i < NLD; ++i) if (NCH % 512 == 0 || i < NLD - 1 || tid + 512 * i < NCH) { \
        LAS unsigned char* lp_ = lds + (buf) * STAGE + srow[i] * KSTR + sch[i] * 16; *(LAS u32x4*)lp_ = kreg[i]; if (VSEP) *(LAS u32x4*)(lp_ + 64 * KSTR) = vreg[i]; } } while (0)
    if (MODE == 1) { ATT_DMA(0, 0); asm volatile("s_waitcnt vmcnt(0)" ::: "memory"); } else { ATT_LOAD(0); ATT_STORE(0); }
    __syncthreads();
    const int q4 = (lane & 15) >> 2, p4 = lane & 3, blk = (lane >> 4) & 1;
    for (int t = 0; t < ntile; ++t) {
        const int buf = t & 1;
        if (t + 1 < ntile) { if (MODE == 1) ATT_DMA(t + 1, (t + 1) & 1); else ATT_LOAD(t + 1); }
        float rpv = 0.f;
        if (MODE == 1 && t >= 4) rpv = rpb[(head * 15 + (aux1 + (t - 4) - aux0 + 7)) * 31 + min(lane, 30)];
        LAS const unsigned char* Kb = lds + buf * STAGE;
        LAS const unsigned char* Vb = VSEP ? Kb + 64 * KSTR : Kb;
        f32x16 s0, s1;
#pragma unroll
        for (int r = 0; r < 16; ++r) { s0[r] = 0.f; s1[r] = 0.f; }
        {
            LAS const unsigned char* kp = Kb + l32 * KSTR + (kcolw + 8 * hi) * 2;
            bf16x8 ka0 = *(LAS const bf16x8*)(kp), ka1 = *(LAS const bf16x8*)(kp + 32 * KSTR);
#pragma unroll
            for (int ks = 0; ks < NKS; ++ks) {
                bf16x8 kb0 = ka0, kb1 = ka1;
                if (ks + 1 < NKS) { kb0 = *(LAS const bf16x8*)(kp + (ks + 1) * 32); kb1 = *(LAS const bf16x8*)(kp + (ks + 1) * 32 + 32 * KSTR); }
                s0 = __builtin_amdgcn_mfma_f32_32x32x16_bf16(ka0, qf[ks], s0, 0, 0, 0);
                s1 = __builtin_amdgcn_mfma_f32_32x32x16_bf16(ka1, qf[ks], s1, 0, 0, 0);
                __builtin_amdgcn_sched_barrier(0);
                ka0 = kb0; ka1 = kb1;
            }
        }
        if (MODE == 1 && t >= 4) {
            const int c = qtok, c0 = min(max(c - 8, 0), 48);
            const int rpi = (int)__float_as_uint(rpv);
#pragma unroll
            for (int r = 0; r < 16; ++r) {
                const int kc0 = crow(r, hi), kc1 = kc0 + 32;
                const bool v0 = (kc0 >= c0) && (kc0 < c0 + 16), v1 = (kc1 >= c0) && (kc1 < c0 + 16);
                const float b0 = __uint_as_float((unsigned)__builtin_amdgcn_ds_bpermute(min(max(kc0 - c + 15, 0), 30) << 2, rpi));
                const float b1 = __uint_as_float((unsigned)__builtin_amdgcn_ds_bpermute(min(max(kc1 - c + 15, 0), 30) << 2, rpi));
                s0[r] = v0 ? s0[r] + b0 * LOG2E : -INFINITY; s1[r] = v1 ? s1[r] + b1 * LOG2E : -INFINITY;
            }
        }
        if (MODE == 2 && t >= 4) {
            const int qpos = aux0 + qtok, kb0 = aux1 + 64 * (t - 4);
#pragma unroll
            for (int r = 0; r < 16; ++r) {
                const int d0 = kb0 + crow(r, hi) - qpos, d1 = d0 + 32;
                if (d0 > 128 || d0 < -128) s0[r] = -INFINITY;
                if (d1 > 128 || d1 < -128) s1[r] = -INFINITY;
            }
        }
        float mx = fmaxf(s0[0], s1[0]);
#pragma unroll
        for (int r = 1; r < 16; ++r) mx = fmaxf(mx, fmaxf(s0[r], s1[r]));
        mx = xhalf_max(mx);
        const float mnew = fmaxf(mrun, mx), alpha = fexp2(mrun - mnew);
        mrun = mnew;
        float rs = 0.f;
#pragma unroll
        for (int r = 0; r < 16; ++r) { s0[r] = fexp2(s0[r] - mnew); s1[r] = fexp2(s1[r] - mnew); rs += s0[r] + s1[r]; }
        lrun = lrun * alpha + rs;
#pragma unroll
        for (int c = 0; c < NDB; ++c)
#pragma unroll
            for (int r = 0; r < 16; ++r) o[c][r] *= alpha;
        u32x4 pw[2][2];
#pragma unroll
        for (int s = 0; s < 2; ++s) {
            pw[0][s] = (u32x4){cvtpk(s0[8 * s], s0[8 * s + 1]), cvtpk(s0[8 * s + 2], s0[8 * s + 3]), cvtpk(s0[8 * s + 4], s0[8 * s + 5]), cvtpk(s0[8 * s + 6], s0[8 * s + 7])};
            pw[1][s] = (u32x4){cvtpk(s1[8 * s], s1[8 * s + 1]), cvtpk(s1[8 * s + 2], s1[8 * s + 3]), cvtpk(s1[8 * s + 4], s1[8 * s + 5]), cvtpk(s1[8 * s + 6], s1[8 * s + 7])};
        }
        {
            LAS const unsigned char* vp = Vb + (4 * hi + q4) * KSTR + (kcolw + 16 * blk) * 2 + 8 * p4;
            s16x4 la = vtr(vp), ha = vtr(vp + 8 * KSTR);
#pragma unroll
            for (int it = 0; it < NDB * 4; ++it) {
                const int c = it >> 2, kb = (it >> 1) & 1, s = it & 1;
                s16x4 lb = la, hb = ha;
                if (it + 1 < NDB * 4) { const int c2 = (it + 1) >> 2, kb2 = ((it + 1) >> 1) & 1, s2 = (it + 1) & 1;
                    lb = vtr(vp + (32 * kb2 + 16 * s2) * KSTR + c2 * 64); hb = vtr(vp + (32 * kb2 + 16 * s2 + 8) * KSTR + c2 * 64); }
                const bf16x8 vf = (bf16x8){la[0], la[1], la[2], la[3], ha[0], ha[1], ha[2], ha[3]};
                o[c] = __builtin_amdgcn_mfma_f32_32x32x16_bf16(vf, __builtin_bit_cast(bf16x8, pw[kb][s]), o[c], 0, 0, 0);
                __builtin_amdgcn_sched_barrier(0);
                la = lb; ha = hb;
            }
        }
        if (MODE == 1) asm volatile("s_waitcnt vmcnt(0)" ::: "memory"); else if (t + 1 < ntile) ATT_STORE((t + 1) & 1);
        __syncthreads();
    }
    lrun = xhalf_sum(lrun);
    if (MODE == 2) lrun += fexp2(sink[head] * LOG2E - mrun);
    const float inv = 1.f / lrun;
    bf16_t* yp = y + (size_t)(qrow0 + qtok) * YW + ycol + 4 * hi;
#pragma unroll
    for (int c = 0; c < NDB; ++c)
#pragma unroll
        for (int g = 0; g < 4; ++g) { u32x2 w; w.x = cvtpk(o[c][4 * g] * inv, o[c][4 * g + 1] * inv); w.y = cvtpk(o[c][4 * g + 2] * inv, o[c][4 * g + 3] * inv); *(u32x2*)(yp + 32 * c + 8 * g) = w; }
#undef ATT_TROW
#undef ATT_DMA
#undef ATT_LOAD
#undef ATT_STORE
}


__device__ __forceinline__ void mla_unit(LAS unsigned char* lds, const bf16_t* __restrict__ u, const bf16_t* __restrict__ qm, bf16_t* __restrict__ y,
                                         int qrow0, int kctx_row0, int nlocal, int loc_row0) {
    constexpr int KSTR = 320, NKS = 10, STAGE = 41 * 1024, KB1 = 32 * KSTR + 64, HALFB = 64 * KSTR + 128;
    constexpr float THR = 6.f;
    const int tid = fresh_tid(), lane = tid & 63, wid = __builtin_amdgcn_readfirstlane(tid >> 6), l32 = lane & 31, hi = lane >> 5;
    const int head = wid & 3, qtok = 32 * (wid >> 2) + l32;
    const bf16_t* qp = qm + (size_t)(qrow0 + qtok) * QW + head * 160;
    bf16x8 qf[NKS];
#pragma unroll
    for (int ks = 0; ks < NKS; ++ks) qf[ks] = *(const bf16x8*)(qp + 16 * ks + 8 * hi);
    f32x16 o[4];
#pragma unroll
    for (int c = 0; c < 4; ++c)
#pragma unroll
        for (int r = 0; r < 16; ++r) o[c][r] = 0.f;
    float mref = -1e30f, lrun = 0.f;
    const int nmac = 2 + (nlocal >> 1);
#define MLA_TROW(T) ((T) < 2 ? kctx_row0 + 128 * (T) : loc_row0 + 128 * ((T) - 2))
    unsigned dvo[6];
#pragma unroll
    for (int i = 0; i < 6; ++i) { const int sl = (wid * 6 + i) * 64 + lane, g = sl / 161, rem = sl % 161; const bool ok = sl < 2576 && rem < 160;
        const int row = ok ? 8 * g + rem / 20 : 0, ch = ok ? rem % 20 : 0; dvo[i] = (unsigned)(row * (UW * 2) + ch * 16); }
    const char* kbase = (const char*)(u + U_CKV);
#define MLA_DMA(T, buf) do { const char* tb_ = kbase + (size_t)MLA_TROW(T) * (UW * 2); _Pragma("unroll") for (int i = 0; i < 6; ++i) if (wid * 6 + i < 41) \
        __builtin_amdgcn_global_load_lds((const unsigned*)(tb_ + dvo[i]), (LAS unsigned*)(lds + (buf) * STAGE + (wid * 6 + i) * 1024), 16, 0, 0); } while (0)
    MLA_DMA(0, 0); MLA_DMA(1, 1);
    asm volatile("s_waitcnt vmcnt(0)" ::: "memory");
    __syncthreads();
    const int q4 = (lane & 15) >> 2, p4 = lane & 3, blk = (lane >> 4) & 1;
    const int koff = l32 * KSTR + (l32 >> 3) * 16 + 16 * hi;
    const int voff = (4 * hi + q4) * KSTR + 32 * blk + 8 * p4;
    f32x16 sa0, sa1, sb0, sb1;
    u32x4 pw00, pw01, pw10, pw11;
    float mxn;
#define MLA_QKEXP(SD0, SD1, PA0, PA1, KOFF, DOEXP) do { \
        _Pragma("unroll") for (int r = 0; r < 16; ++r) { SD0[r] = 0.f; SD1[r] = 0.f; } \
        float rs = 0.f; \
        LAS const unsigned char* kp = lds + (KOFF) + koff; \
        bf16x8 ka0 = *(LAS const bf16x8*)(kp), ka1 = *(LAS const bf16x8*)(kp + KB1); \
        _Pragma("unroll") for (int ks = 0; ks < NKS; ++ks) { \
            bf16x8 kb0 = ka0, kb1 = ka1; \
            if (ks + 1 < NKS) { kb0 = *(LAS const bf16x8*)(kp + (ks + 1) * 32); kb1 = *(LAS const bf16x8*)(kp + (ks + 1) * 32 + KB1); } \
            SD0 = __builtin_amdgcn_mfma_f32_32x32x16_bf16(ka0, qf[ks], SD0, 0, 0, 0); \
            SD1 = __builtin_amdgcn_mfma_f32_32x32x16_bf16(ka1, qf[ks], SD1, 0, 0, 0); \
            if (DOEXP) { \
                if (ks < 4) { _Pragma("unroll") for (int j = 0; j < 4; ++j) { const float p = fexp2(PA0[4 * ks + j] - mref); PA0[4 * ks + j] = p; rs += p; } } \
                else if (ks < 8) { _Pragma("unroll") for (int j = 0; j < 4; ++j) { const float p = fexp2(PA1[4 * (ks - 4) + j] - mref); PA1[4 * (ks - 4) + j] = p; rs += p; } } \
                else if (ks == 8) { pw00 = (u32x4){cvtpk(PA0[0], PA0[1]), cvtpk(PA0[2], PA0[3]), cvtpk(PA0[4], PA0[5]), cvtpk(PA0[6], PA0[7])}; \
                                    pw01 = (u32x4){cvtpk(PA0[8], PA0[9]), cvtpk(PA0[10], PA0[11]), cvtpk(PA0[12], PA0[13]), cvtpk(PA0[14], PA0[15])}; } \
                else { pw10 = (u32x4){cvtpk(PA1[0], PA1[1]), cvtpk(PA1[2], PA1[3]), cvtpk(PA1[4], PA1[5]), cvtpk(PA1[6], PA1[7])}; \
                       pw11 = (u32x4){cvtpk(PA1[8], PA1[9]), cvtpk(PA1[10], PA1[11]), cvtpk(PA1[12], PA1[13]), cvtpk(PA1[14], PA1[15])}; } } \
            __builtin_amdgcn_sched_barrier(0); \
            ka0 = kb0; ka1 = kb1; } \
        lrun += rs; } while (0)
#define MLA_PV(VOFF, M0, M1) do { \
        LAS const unsigned char* vp = lds + (VOFF) + voff; \
        s16x4 vl[16], vh[16]; float mxa, mxb; \
        _Pragma("unroll") for (int it = 0; it < 16; ++it) { const int c = it >> 2, kb = (it >> 1) & 1, s_ = it & 1; \
            vl[it] = vtr(vp + (32 * kb + 16 * s_) * KSTR + 16 * (4 * kb + 2 * s_) + c * 64); vh[it] = vtr(vp + (32 * kb + 16 * s_ + 8) * KSTR + 16 * (4 * kb + 2 * s_ + 1) + c * 64); } \
        _Pragma("unroll") for (int it = 0; it < 16; ++it) { const int c = it >> 2, kb = (it >> 1) & 1, s_ = it & 1; \
            const bf16x8 vf = (bf16x8){vl[it][0], vl[it][1], vl[it][2], vl[it][3], vh[it][0], vh[it][1], vh[it][2], vh[it][3]}; \
            const u32x4 pwv = kb == 0 ? (s_ == 0 ? pw00 : pw01) : (s_ == 0 ? pw10 : pw11); \
            o[c] = __builtin_amdgcn_mfma_f32_32x32x16_bf16(vf, __builtin_bit_cast(bf16x8, pwv), o[c], 0, 0, 0); \
            if (it == 0) { mxa = M0[0]; mxb = M1[0]; } else { mxa = fmaxf(mxa, M0[it]); mxb = fmaxf(mxb, M1[it]); } } \
        mxn = xhalf_max(fmaxf(mxa, mxb)); } while (0)
#define MLA_RESCALE() do { if (__any(mxn > mref + THR)) { const float mnew = fmaxf(mref, mxn), alpha = fexp2(mref - mnew); mref = mnew; lrun *= alpha; \
        _Pragma("unroll") for (int c = 0; c < 4; ++c) _Pragma("unroll") for (int r = 0; r < 16; ++r) o[c][r] *= alpha; } __builtin_amdgcn_sched_barrier(0); } while (0)
    MLA_QKEXP(sa0, sa1, sa0, sa1, 0, false);
    { float a_ = fmaxf(sa0[0], sa1[0]);
#pragma unroll
      for (int r = 1; r < 16; ++r) a_ = fmaxf(a_, fmaxf(sa0[r], sa1[r]));
      mxn = xhalf_max(a_); }
    int bcur = 0;
    for (int T = 0; T < nmac; ++T) {
        const int bnxt = bcur == 2 ? 0 : bcur + 1, bnn = bnxt == 2 ? 0 : bnxt + 1;
        if (T + 2 < nmac) MLA_DMA(T + 2, bnn);
        MLA_RESCALE();
        MLA_QKEXP(sb0, sb1, sa0, sa1, bcur * STAGE + HALFB, true);
        MLA_PV(bcur * STAGE, sb0, sb1);
        MLA_RESCALE();
        MLA_QKEXP(sa0, sa1, sb0, sb1, bnxt * STAGE, true);
        MLA_PV(bcur * STAGE + HALFB, sa0, sa1);
        asm volatile("s_waitcnt vmcnt(0)" ::: "memory");
        __syncthreads();
        bcur = bnxt;
    }
    lrun = xhalf_sum(lrun);
    const float inv = 1.f / lrun;
    bf16_t* yp = y + (size_t)(qrow0 + qtok) * YW + 768 + head * 128 + 4 * hi;
#pragma unroll
    for (int c = 0; c < 4; ++c)
#pragma unroll
        for (int g = 0; g < 4; ++g) { u32x2 w; w.x = cvtpk(o[c][4 * g] * inv, o[c][4 * g + 1] * inv); w.y = cvtpk(o[c][4 * g + 2] * inv, o[c][4 * g + 3] * inv); *(u32x2*)(yp + 32 * c + 8 * g) = w; }
#undef MLA_TROW
#undef MLA_DMA
#undef MLA_QKEXP
#undef MLA_PV
#undef MLA_RESCALE
}

#define XB_TMO      128
#define XB_XCNT(j)  (256  + 64 * (j))
#define XB_XSUB(j)  (1280 + 64 * (j))
#define XB_XGEN(j)  (2304 + 64 * (j))
#define XB_TOP      3328
#define XB_TOPGEN   3392
#define XCD_BAR_WORDS 3456
#define XB_SPIN_CAP (1u << 18)
__device__ __forceinline__ unsigned xb_ld(unsigned* p)              { return __hip_atomic_load(p, __ATOMIC_RELAXED, __HIP_MEMORY_SCOPE_AGENT); }
__device__ __forceinline__ unsigned xb_add(unsigned* p, unsigned v) { return __hip_atomic_fetch_add(p, v, __ATOMIC_RELAXED, __HIP_MEMORY_SCOPE_AGENT); }
__device__ __forceinline__ unsigned xb_xcc_id() { return (unsigned)__builtin_amdgcn_s_getreg((3 << 11) | 20) & 0xFu; }
#define XB_SPIN(cond, bar) do { unsigned _sp = 0; while (cond) { __builtin_amdgcn_s_sleep(1); \
    if ((++_sp & 255u) == 0u) { if (xb_ld(&(bar)[XB_TMO])) break; if (_sp > XB_SPIN_CAP) { atomicAdd(&(bar)[XB_TMO], 1u); break; } } } } while (0)
struct XcdBarrier { unsigned* bar; unsigned x; volatile LAS unsigned* st; };
__device__ __forceinline__ XcdBarrier xcd_barrier_post(unsigned* bar, volatile LAS unsigned* st) {
    XcdBarrier b; b.bar = bar; b.x = xb_xcc_id(); b.st = st;
    if (threadIdx.x == 0) (void)xb_add(&bar[XB_XCNT(b.x)], 1u);
    return b;
}
__device__ __forceinline__ void xcd_barrier_complete(unsigned* bar, unsigned x, unsigned& nloc, unsigned& nx) {
    const unsigned G = gridDim.x * gridDim.y * gridDim.z;
    unsigned sum, cnt, mine, sp = 0u;
    for (;;) {
        sum = 0u; cnt = 0u; mine = 0u;
#pragma unroll
        for (unsigned j = 0; j < 16; ++j) { const unsigned c = xb_ld(&bar[XB_XCNT(j)]); sum += c; cnt += (c > 0u) ? 1u : 0u; mine = (j == x) ? c : mine; }
        if (sum == G) break;
        __builtin_amdgcn_s_sleep(1);
        if ((++sp & 255u) == 0u) { if (xb_ld(&bar[XB_TMO])) break; if (sp > XB_SPIN_CAP) { atomicAdd(&bar[XB_TMO], 1u); break; } }
    }
    nloc = mine > 0u ? mine : 1u; nx = cnt > 0u ? cnt : 1u;
}
__device__ __forceinline__ void xcd_barrier(const XcdBarrier& b) {
    asm volatile("s_waitcnt vmcnt(0)" ::: "memory");
    __syncthreads();
    if (threadIdx.x == 0) {
        unsigned* bar = b.bar; asm volatile("" : "+s"(bar));
        __builtin_amdgcn_s_waitcnt(0);
        unsigned nloc = b.st[0], nx = b.st[1];
        if (nloc == 0u) { xcd_barrier_complete(bar, b.x, nloc, nx); b.st[0] = nloc; b.st[1] = nx; }
        const unsigned old = xb_add(&bar[XB_XSUB(b.x)], 1u);
        const unsigned gen = old / nloc;
        if (old + 1u == (gen + 1u) * nloc) {
            __builtin_amdgcn_fence(__ATOMIC_RELEASE, "agent");
            asm volatile("s_waitcnt vmcnt(0)" ::: "memory");
            const unsigned og = xb_add(&bar[XB_TOP], 1u);
            const unsigned tg = og / nx;
            if (og + 1u == (tg + 1u) * nx) xb_add(&bar[XB_TOPGEN], 1u);
            else XB_SPIN(xb_ld(&bar[XB_TOPGEN]) == tg, bar);
            __builtin_amdgcn_fence(__ATOMIC_ACQUIRE, "agent");
            xb_add(&bar[XB_XGEN(b.x)], 1u);
            asm volatile("s_waitcnt vmcnt(0)" ::: "memory");
        } else {
            XB_SPIN(xb_ld(&bar[XB_XGEN(b.x)]) == gen, bar);
            __builtin_amdgcn_fence(__ATOMIC_ACQUIRE, "agent");
            asm volatile("s_waitcnt vmcnt(0)" ::: "memory");
        }
    }
    __syncthreads();
}

struct Args { const float* in[24]; float* out; unsigned char* ws; };
typedef __attribute__((address_space(4))) const Args CArgs;
__device__ __forceinline__ int fresh_sgpr(int v) { asm volatile("" : "+s"(v)); return v; }
__device__ __forceinline__ CArgs* fresh_args() { CArgs* p = (CArgs*)__builtin_amdgcn_kernarg_segment_ptr(); asm volatile("" : "+s"(p)); return p; }
enum { I_X = 0, I_C, I_CTX, I_CCTX, I_ADAW, I_ADAB, I_N1G, I_N2G, I_WIN, I_POOLW, I_POOLS, I_RPB, I_SINK, I_QNORM, I_KVNORM, I_WUQ, I_WUK, I_WUV, I_WBR, I_WOUT, I_W1, I_W3, I_W2, I_FNG };

__device__ __forceinline__ int rowmap(int mode, int n) {
    if (mode == 0) return n;
    if (mode == 1) { const int i = n >> 10, col = n & 1023, pn = col >> 6, cc = col & 63, wc = cc >> 4, fq = (cc >> 2) & 3, j = cc & 3; return 256 * pn + 128 * (i >> 1) + 32 * wc + 16 * (i & 1) + 4 * fq + j; }
    const int r = 256 * (n >> 7) + (n & 127); return mode == 2 ? r : r + 128;
}
__device__ __forceinline__ void tr_item(const float* __restrict__ W, int ldw, bf16_t* __restrict__ WT, int ldt, int nblk, int mode, LAS float* scr, int item, int lane, bool qscale = false) {
    const int kb = item / nblk, nb = item % nblk, k0 = 64 * kb, n0 = 32 * nb;
    float tv[32];
#pragma unroll
    for (int i = 0; i < 32; ++i) tv[i] = W[(size_t)(k0 + 2 * i + (lane >> 5)) * ldw + n0 + (lane & 31)];
#pragma unroll
    for (int i = 0; i < 32; ++i) scr[(2 * i + (lane >> 5)) * 33 + (lane & 31)] = tv[i];
    asm volatile("s_waitcnt lgkmcnt(0)" ::: "memory");
    const int c = lane & 7;
#pragma unroll
    for (int j = 0; j < 4; ++j) { const int n = (lane >> 3) + 8 * j; const LAS float* s = scr + (8 * c) * 33 + n;
        const float qs = (qscale && n0 + n >= U_NAQ && n0 + n < U_CQ) ? QSC64 : 1.f;
        u32x4 o; o.x = cvtpk(s[0 * 33] * qs, s[1 * 33] * qs); o.y = cvtpk(s[2 * 33] * qs, s[3 * 33] * qs); o.z = cvtpk(s[4 * 33] * qs, s[5 * 33] * qs); o.w = cvtpk(s[6 * 33] * qs, s[7 * 33] * qs);
        *(u32x4*)(WT + (size_t)rowmap(mode, n0 + n) * ldt + k0 + 8 * c) = o; }
    asm volatile("s_waitcnt lgkmcnt(0)" ::: "memory");
}

__global__ void __launch_bounds__(NTHREADS) mk_fwd(Args args) {
    extern __shared__ __attribute__((aligned(16))) unsigned char lds_raw[];
    LAS unsigned char* lds = (LAS unsigned char*)lds_raw;
    cg::grid_group grid = cg::this_grid();
    const int wid = __builtin_amdgcn_readfirstlane(threadIdx.x >> 6);
    const int bx = blockIdx.x;
    unsigned* barw = (unsigned*)args.ws;
    volatile LAS unsigned* bst = (volatile LAS unsigned*)(lds + LDS_BYTES - 16);
    if (threadIdx.x == 0) { bst[0] = 0u; bst[1] = 0u; }
    __syncthreads();
    if (gridDim.x == 0x7fffffffu) grid.sync();
    XcdBarrier xbar = xcd_barrier_post(barw, bst);
#define PH_BEGIN { const int tid = fresh_tid(); const int lane = tid & 63; (void)tid; (void)lane; CArgs* ap = fresh_args(); const int bx = fresh_sgpr((int)blockIdx.x); const int G = fresh_sgpr((int)gridDim.x); const int gw = bx * 8 + wid, NGW = G * 8; (void)gw; (void)NGW; unsigned char* ws = ap->ws; float* out = ap->out; \
    float* mod = (float*)(ws + WS_MOD); float* xc = (float*)(ws + WS_XC); bf16_t* Hb = (bf16_t*)(ws + WS_H); bf16_t* Yb = (bf16_t*)(ws + WS_Y); bf16_t* Ub = (bf16_t*)(ws + WS_R4); \
    bf16_t* Qm = (bf16_t*)(ws + WS_QM); bf16_t* Yall = (bf16_t*)(ws + WS_R4); bf16_t* Hid = (bf16_t*)(ws + WS_R4); bf16_t* Mg = (bf16_t*)(ws + WS_Y); \
    (void)mod; (void)xc; (void)Hb; (void)Yb; (void)Ub; (void)Qm; (void)Yall; (void)Hid; (void)Mg; (void)out;
#define PH_LAYER unsigned char* wl = ws + WS_W + (size_t)l * WL; const float* modl = mod + (size_t)l * 3 * 6144; const float* xres = l == 0 ? ap->in[I_X] : out; const float* cres = l == 0 ? ap->in[I_CTX] : xc; \
    const int Mq = l == 0 ? MT : NLAT; (void)wl; (void)modl; (void)xres; (void)cres; (void)Mq;
#define PH_END   xcd_barrier(xbar); }
#define PH_END0  xcd_barrier(xbar); }
#define PH_ENDL  }

    PH_BEGIN
    {
        LAS float* scr = (LAS float*)(lds + wid * 16384);
        constexpr int T_U = 976, T_G = 2048, T_B = 128, T_O = 512, T_1 = 1408, T_2 = 1408;
        constexpr int LTOT = T_U + T_G + 2 * T_B + T_O + 2 * T_1 + T_2;
        for (int it = gw; it < DEPTH * LTOT; it += NGW) {
            const int l = it / LTOT; int r = it % LTOT;
            unsigned char* wl = ws + WS_W + (size_t)l * WL;
            const float* win = ap->in[I_WIN] + (size_t)l * D * INC;
            if (r < T_U) { tr_item(win, INC, (bf16_t*)(wl + W_U), D, 61, 0, scr, r, lane, true); continue; } r -= T_U;
            if (r < T_G) { tr_item(win + U_END, INC, (bf16_t*)(wl + W_G), D, 128, 1, scr, r, lane); continue; } r -= T_G;
            if (r < T_B) { tr_item(ap->in[I_WBR] + ((size_t)l * 4 + 1) * 256 * D, D, (bf16_t*)(wl + W_B) + (size_t)1 * 1024 * 512, 512, 32, 0, scr, r, lane); continue; } r -= T_B;
            if (r < T_B) { tr_item(ap->in[I_WBR] + ((size_t)l * 4 + 2) * 256 * D, D, (bf16_t*)(wl + W_B) + (size_t)2 * 1024 * 512, 512, 32, 0, scr, r, lane); continue; } r -= T_B;
            if (r < T_O) { tr_item(ap->in[I_WOUT] + (size_t)l * D * D, D, (bf16_t*)(wl + W_O), D, 32, 0, scr, r, lane); continue; } r -= T_O;
            if (r < T_1) { tr_item(ap->in[I_W1] + (size_t)l * D * FF, FF, (bf16_t*)(wl + W_13), D, 88, 2, scr, r, lane); continue; } r -= T_1;
            if (r < T_1) { tr_item(ap->in[I_W3] + (size_t)l * D * FF, FF, (bf16_t*)(wl + W_13), D, 88, 3, scr, r, lane); continue; } r -= T_1;
            tr_item(ap->in[I_W2] + (size_t)l * FF * D, D, (bf16_t*)(wl + W_2), FF, 32, 0, scr, r, lane);
        }
        constexpr int F_Q = 640 * 256, F_3 = 512 * 256, F_0 = 256 * 256, FTOT = F_Q + F_3 + F_0;
        for (int it = bx * NTHREADS + tid; it < DEPTH * FTOT; it += G * NTHREADS) {
            const int l = it / FTOT; int r = it % FTOT;
            unsigned char* wl = ws + WS_W + (size_t)l * WL;
            if (r < F_Q) {
                const int k = r / 640, n = r % 640, h = n / 160, c = n % 160;
                const float* uq = ap->in[I_WUQ] + (size_t)l * 256 * 384 + (size_t)k * 384 + h * 96;
                float s;
                if (c < 128) { const float* uk = ap->in[I_WUK] + (size_t)l * 128 * 256 + (size_t)c * 256 + h * 64; f32x4 a4 = {0.f, 0.f, 0.f, 0.f};
#pragma unroll
                    for (int d = 0; d < 64; d += 4) a4 += *(const f32x4*)(uq + d) * *(const f32x4*)(uk + d);
                    s = (a4[0] + a4[1]) + (a4[2] + a4[3]); }
                else s = uq[64 + (c - 128)];
                ((bf16_t*)(wl + W_QF))[(size_t)n * 256 + k] = f2bf(s * QSCMLA);
            } else if (r < F_Q + F_3) {
                r -= F_Q; const int k = r / 256, n = (r % 256) * 4, h = k / 128, c = k % 128;
                const float* uv = ap->in[I_WUV] + (size_t)l * 128 * 256 + (size_t)c * 256 + h * 64;
                const float* wb = ap->in[I_WBR] + ((size_t)l * 4 + 3) * 256 * D + (size_t)(h * 64) * D + n;
                f32x4 a4 = {0.f, 0.f, 0.f, 0.f};
#pragma unroll 16
                for (int d = 0; d < 64; ++d) a4 += *(const f32x4*)(wb + (size_t)d * D) * uv[d];
                bf16_t* dst = (bf16_t*)(wl + W_B) + (size_t)3 * 1024 * 512 + (size_t)n * 512 + k;
                dst[0] = f2bf(a4[0]); dst[512] = f2bf(a4[1]); dst[1024] = f2bf(a4[2]); dst[1536] = f2bf(a4[3]);
            } else {
                r -= F_Q + F_3; const int k = r / 256, n = (r % 256) * 4, g = k / 64, c = k % 64;
                const float* pw = ap->in[I_POOLW] + (size_t)l * 4 * 64 * 64 + (size_t)g * 4096 + c * 64;
                const float* ps = ap->in[I_POOLS] + (size_t)l * 256 + g * 64;
                const float* wb = ap->in[I_WBR] + ((size_t)l * 4 + 0) * 256 * D + (size_t)(g * 64) * D + n;
                f32x4 a4 = {0.f, 0.f, 0.f, 0.f};
#pragma unroll 16
                for (int d = 0; d < 64; ++d) a4 += *(const f32x4*)(wb + (size_t)d * D) * (pw[d] * ps[d]);
                bf16_t* dst = (bf16_t*)(wl + W_B) + (size_t)n * 512 + k;
                dst[0] = f2bf(a4[0]); dst[512] = f2bf(a4[1]); dst[1024] = f2bf(a4[2]); dst[1536] = f2bf(a4[3]);
            }
        }
        __syncthreads();
        LAS float* sc = (LAS float*)lds;
        LAS float* red = sc + 3072;
        for (int i = tid; i < 3072; i += NTHREADS) { const int v = i >> 10, k = i & 1023; const float cv = v < 2 ? ap->in[I_C][v * D + k] : ap->in[I_CCTX][k]; sc[i] = cv / (1.f + expf(-cv)); }
        __syncthreads();
        for (int it = bx; it < DEPTH * 96; it += G) {
            const int l = it / 96, cgp = it % 96, col = cgp * 64 + lane;
            const float* aw = ap->in[I_ADAW] + (size_t)l * D * 6144 + col;
            float a0 = 0.f, a1 = 0.f, a2 = 0.f;
#pragma unroll 1
            for (int k0 = wid * 128; k0 < wid * 128 + 128; k0 += 32) { float wv[32];
#pragma unroll
                for (int j = 0; j < 32; ++j) wv[j] = aw[(size_t)(k0 + j) * 6144];
#pragma unroll
                for (int j = 0; j < 32; ++j) { a0 += sc[k0 + j] * wv[j]; a1 += sc[1024 + k0 + j] * wv[j]; a2 += sc[2048 + k0 + j] * wv[j]; } }
            red[(wid * 3 + 0) * 64 + lane] = a0; red[(wid * 3 + 1) * 64 + lane] = a1; red[(wid * 3 + 2) * 64 + lane] = a2;
            __syncthreads();
            if (tid < 192) { const int v = tid >> 6, ln = tid & 63; float s = 0.f;
#pragma unroll
                for (int w = 0; w < 8; ++w) s += red[(w * 3 + v) * 64 + ln];
                const int colo = cgp * 64 + ln; mod[(l * 3 + v) * 6144 + colo] = s + ap->in[I_ADAB][l * 6144 + colo]; }
            __syncthreads();
        }
    }
    PH_END0

    for (int l = 0; l < DEPTH; ++l) {

#define NORM_PHASE(XL, XC, GAMMA, SHC, SCC, LB) \
        for (int r0 = gw * 4; r0 < MT; r0 += NGW * 4) { \
            const float* src = r0 < NLAT ? (XL) + (size_t)r0 * D : (XC) + (size_t)(r0 - NLAT) * D; \
            const int v = r0 < NLAT ? r0 / SEQ : 2; const float* mv = modl + v * 6144; \
            f32x4 xv[4][4]; float ss[4]; \
            if ((LB) && r0 < NLAT) { const bf16_t* sb_ = (const bf16_t*)out + (size_t)r0 * 2048 + 1024; \
                _Pragma("unroll") for (int rr = 0; rr < 4; ++rr) _Pragma("unroll") for (int j = 0; j < 4; ++j) { const u32x2 w_ = *(const u32x2*)(sb_ + rr * 2048 + lane * 4 + 256 * j); xv[rr][j] = (f32x4){bflo(w_.x), bfhi(w_.x), bflo(w_.y), bfhi(w_.y)}; } } \
            else { _Pragma("unroll") for (int rr = 0; rr < 4; ++rr) _Pragma("unroll") for (int j = 0; j < 4; ++j) xv[rr][j] = *(const f32x4*)(src + rr * D + lane * 4 + 256 * j); } \
            _Pragma("unroll") for (int rr = 0; rr < 4; ++rr) { float a_ = 0.f; _Pragma("unroll") for (int j = 0; j < 4; ++j) a_ += xv[rr][j][0] * xv[rr][j][0] + xv[rr][j][1] * xv[rr][j][1] + xv[rr][j][2] * xv[rr][j][2] + xv[rr][j][3] * xv[rr][j][3]; ss[rr] = a_; } \
            _Pragma("unroll") for (int o_ = 1; o_ < 64; o_ <<= 1) _Pragma("unroll") for (int rr = 0; rr < 4; ++rr) ss[rr] += __uint_as_float((unsigned)__builtin_amdgcn_ds_bpermute((lane ^ o_) << 2, (int)__float_as_uint(ss[rr]))); \
            _Pragma("unroll") for (int rr = 0; rr < 4; ++rr) ss[rr] = rsqrtf(ss[rr] * (1.f / D) + EPSV); \
            _Pragma("unroll") for (int j = 0; j < 4; ++j) { const int c0 = lane * 4 + 256 * j; const f32x4 g = *(const f32x4*)((GAMMA) + c0), sh = *(const f32x4*)(mv + (SHC) * D + c0), sc = *(const f32x4*)(mv + (SCC) * D + c0); \
                const f32x4 gs = g * (sc + 1.f); \
                _Pragma("unroll") for (int rr = 0; rr < 4; ++rr) { const f32x4 yv = xv[rr][j] * ss[rr] * gs + sh; u32x2 w; w.x = cvtpk(yv[0], yv[1]); w.y = cvtpk(yv[2], yv[3]); *(u32x2*)(Hb + (size_t)(r0 + rr) * D + c0) = w; } } \
        }
        PH_BEGIN PH_LAYER
        NORM_PHASE(ap->in[I_X], cres, ap->in[I_N1G] + l * D, 0, 1, l != 0)
        PH_END

        PH_BEGIN PH_LAYER
        { pg8::SchedPlain S; S.so.init(MT, UW, G, bx); S.A = (const char*)Hb; S.B = (const char*)(wl + W_U); S.a_t = (size_t)256 * D * 2; S.b_t = (size_t)256 * D * 2; S.nt = D / 64;
          EpiStore E{Ub, UW}; pg8::gemm_phase(lds, D * 2, D * 2, S, E); }
        PH_END

        PH_BEGIN PH_LAYER
        {
            const float* qng = ap->in[I_QNORM] + l * 256; const float* kvg = ap->in[I_KVNORM] + l * 128;
            const f32x4 gq = *(const f32x4*)(qng + lane * 4); const float gk0 = kvg[lane * 2], gk1 = kvg[lane * 2 + 1];
            const int si = 2 * (lane & 15);
            const float sf0 = exp2f(-(float)(si & 15) * 0.8304820237218406f), sf1 = exp2f(-(float)((si + 1) & 15) * 0.8304820237218406f);
            const int ki = 2 * (lane & 7);
            const float kf0 = exp2f(-(float)(ki & 7) * 1.6609640474436813f), kf1 = exp2f(-(float)((ki + 1) & 7) * 1.6609640474436813f);
            const int pg = lane >> 4, pw_ = 2 << pg;
#define P2B_DECL(S) bf16_t* ur##S; int tloc##S, nseq##S, base##S; bool lat##S; u32x2 cq##S, ps##S, nb##S[16]; unsigned ckv##S, q1##S, q2##S, k1##S = 0, k2##S = 0, r1##S = 0, r2##S = 0;
#define P2B_LOAD(S, ROW) do { const int row_ = (ROW); ur##S = Ub + (size_t)row_ * UW; lat##S = row_ < NLAT; \
                if (lat##S) { tloc##S = row_ & (SEQ - 1); nseq##S = SEQ; } else { tloc##S = (row_ - NLAT) & (CTXL - 1); nseq##S = CTXL; } base##S = row_ - tloc##S; \
                cq##S = *(const u32x2*)(ur##S + U_CQ + lane * 4); ckv##S = *(const unsigned*)(ur##S + U_CKV + lane * 2); ps##S = *(const u32x2*)(ur##S + U_POOL + lane * 4); \
                q1##S = *(const unsigned*)(ur##S + U_SWQ + (lane >> 4) * 64 + si); q2##S = *(const unsigned*)(ur##S + U_SWQ + (lane >> 4) * 64 + 32 + si); \
                if (lat##S) { if (lane < 32) { k1##S = *(const unsigned*)(ur##S + U_SWK + (lane >> 4) * 64 + si); k2##S = *(const unsigned*)(ur##S + U_SWK + (lane >> 4) * 64 + 32 + si); } \
                              if (lane < 8) { r1##S = *(const unsigned*)(ur##S + U_KR + ki); r2##S = *(const unsigned*)(ur##S + U_KR + 16 + ki); } } \
                _Pragma("unroll") for (int i = 0; i < 16; ++i) { const int t_ = min(max(tloc##S - 8 + i, 0), nseq##S - 1); nb##S[i] = *(const u32x2*)(Ub + (size_t)(base##S + t_) * UW + U_POOL + lane * 4); } } while (0)
#define P2B_PROC(S, ROW) do { const int row_ = (ROW); const float prow = (float)(tloc##S >> 6), pcol = (float)(tloc##S & 63); \
                { float a = bflo(cq##S.x), b = bfhi(cq##S.x), c = bflo(cq##S.y), d = bfhi(cq##S.y); float sq = a * a + b * b + c * c + d * d; float a2 = bflo(ckv##S), b2 = bfhi(ckv##S); float sk = a2 * a2 + b2 * b2; \
                  _Pragma("unroll") for (int o_ = 1; o_ < 64; o_ <<= 1) { sq += __uint_as_float((unsigned)__builtin_amdgcn_ds_bpermute((lane ^ o_) << 2, (int)__float_as_uint(sq))); sk += __uint_as_float((unsigned)__builtin_amdgcn_ds_bpermute((lane ^ o_) << 2, (int)__float_as_uint(sk))); } \
                  const float rq = rsqrtf(sq * (1.f / 256.f) + EPSV), rk = rsqrtf(sk * (1.f / 128.f) + EPSV); u32x2 w; w.x = cvtpk(a * rq * gq[0], b * rq * gq[1]); w.y = cvtpk(c * rq * gq[2], d * rq * gq[3]); \
                  *(u32x2*)(ur##S + U_CQ + lane * 4) = w; *(unsigned*)(ur##S + U_CKV + lane * 2) = cvtpk(a2 * rk * gk0, b2 * rk * gk1); } \
                if (lat##S) { const float ps_ = si < 16 ? prow : pcol; const float a0 = ps_ * sf0, a1 = ps_ * sf1; const float c0 = __cosf(a0), s0 = __sinf(a0), c1 = __cosf(a1), s1 = __sinf(a1); \
                  { const float x1a = bflo(q1##S), x1b = bfhi(q1##S), x2a = bflo(q2##S), x2b = bfhi(q2##S); \
                    *(unsigned*)(ur##S + U_SWQ + (lane >> 4) * 64 + si) = cvtpk(x1a * c0 - x2a * s0, x1b * c1 - x2b * s1); *(unsigned*)(ur##S + U_SWQ + (lane >> 4) * 64 + 32 + si) = cvtpk(x2a * c0 + x1a * s0, x2b * c1 + x1b * s1); } \
                  if (lane < 32) { const float x1a = bflo(k1##S), x1b = bfhi(k1##S), x2a = bflo(k2##S), x2b = bfhi(k2##S); \
                    *(unsigned*)(ur##S + U_SWK + (lane >> 4) * 64 + si) = cvtpk(x1a * c0 - x2a * s0, x1b * c1 - x2b * s1); *(unsigned*)(ur##S + U_SWK + (lane >> 4) * 64 + 32 + si) = cvtpk(x2a * c0 + x1a * s0, x2b * c1 + x1b * s1); } \
                  if (lane < 8) { const float pk_ = ki < 8 ? prow : pcol; const float b0 = pk_ * kf0, b1 = pk_ * kf1; const float d0 = __cosf(b0), e0 = __sinf(b0), d1 = __cosf(b1), e1 = __sinf(b1); \
                    const float x1a = bflo(r1##S), x1b = bfhi(r1##S), x2a = bflo(r2##S), x2b = bfhi(r2##S); \
                    *(unsigned*)(ur##S + U_KR + ki) = cvtpk(x1a * d0 - x2a * e0, x1b * d1 - x2b * e1); *(unsigned*)(ur##S + U_KR + 16 + ki) = cvtpk(x2a * d0 + x1a * e0, x2b * d1 + x1b * e1); } } \
                { const int plo = max(tloc##S - (pw_ >> 1), 0), phi = min(tloc##S - (pw_ >> 1) + pw_, nseq##S); f32x4 s_ = {0.f, 0.f, 0.f, 0.f}; \
                  _Pragma("unroll") for (int i = 0; i < 16; ++i) { const int t_ = tloc##S - 8 + i; const float wt = (t_ >= plo && t_ < phi) ? 1.f : 0.f; \
                      s_[0] += wt * bflo(nb##S[i].x); s_[1] += wt * bfhi(nb##S[i].x); s_[2] += wt * bflo(nb##S[i].y); s_[3] += wt * bfhi(nb##S[i].y); } \
                  const float ic = 1.f / (float)(phi - plo); u32x2 o_; o_.x = cvtpk(s_[0] * ic - bflo(ps##S.x), s_[1] * ic - bfhi(ps##S.x)); o_.y = cvtpk(s_[2] * ic - bflo(ps##S.y), s_[3] * ic - bfhi(ps##S.y)); \
                  *(u32x2*)(Yb + (size_t)row_ * YW + lane * 4) = o_; } } while (0)
            P2B_DECL(A) P2B_DECL(B)
            for (int row = gw * 2; row < MT; row += NGW * 2) {
                P2B_LOAD(A, row); P2B_LOAD(B, row + 1);
                P2B_PROC(A, row); P2B_PROC(B, row + 1);
            }
#undef P2B_DECL
#undef P2B_LOAD
#undef P2B_PROC
        }
        PH_END

        PH_BEGIN PH_LAYER
        { pg8::SchedPlain S; S.so.init(Mq, QW, G, bx); S.A = (const char*)(Ub + U_CQ); S.B = (const char*)(wl + W_QF); S.a_t = (size_t)256 * UW * 2; S.b_t = (size_t)256 * 256 * 2; S.nt = 4;
          EpiQRope E{Qm}; pg8::gemm_phase(lds, UW * 2, 256 * 2, S, E); }
        PH_END

        PH_BEGIN PH_LAYER
        {
            const float* rpb = ap->in[I_RPB] + (size_t)l * 4 * 15 * 31; const float* snk = ap->in[I_SINK] + l * 4;
            for (int i = bx; i < 512; i += G) { const int b = i >> 8, tb = i & 255;
                mla_unit(lds, Ub, Qm, Yb, b * SEQ + tb * 64, NLAT + b * CTXL, 256, b * SEQ); }
            for (int i = bx; i < 512; i += G) { const int b = i >> 8, r = i & 255, r0 = min(max(r - 4, 0), 248);
                attn_unit<1>(lds, Ub, Qm, Yb, rpb, snk, b * SEQ + r * 64, NLAT + b * CTXL, 8, b * SEQ + r0 * 64, r, r0, 0); }
            for (int i = bx; i < 512; i += G) { const int b = i >> 8, rem = i & 255, kvh = rem >> 7, n = rem & 127;
                const int jlo = n == 0 ? 2 : 0, jhi = n == 127 ? 4 : 6, kp0 = (n - 1) * 128 + 64 * jlo;
                attn_unit<2>(lds, Ub, Qm, Yb, rpb, snk, b * SEQ + n * 128, NLAT + b * CTXL, jhi - jlo, b * SEQ + kp0, n * 128, kp0, kvh); }
            if (l == 0) {
                for (int i = bx; i < 24; i += G) { const int kind = i >> 3, j = i & 7, b = j >> 2;
                    if (kind == 0) mla_unit(lds, Ub, Qm, Yb, NLAT + b * CTXL + 64 * (j & 3), NLAT + b * CTXL, 0, 0);
                    else if (kind == 1) attn_unit<1>(lds, Ub, Qm, Yb, rpb, snk, NLAT + b * CTXL + 64 * (j & 3), NLAT + b * CTXL, 0, 0, 0, 0, 0);
                    else attn_unit<2>(lds, Ub, Qm, Yb, rpb, snk, NLAT + b * CTXL + 128 * (j & 1), NLAT + b * CTXL, 0, 0, 0, 0, (j >> 1) & 1); }
            }
        }
        PH_END

        PH_BEGIN PH_LAYER
        { pg8::SchedBranch S; S.so.init(Mq, 4096, G, bx); S.A = (const char*)Yb; S.B = (const char*)(wl + W_B); S.a_t = (size_t)256 * YW * 2;
          EpiStore E{Yall, 4096}; pg8::gemm_phase(lds, YW * 2, 512 * 2, S, E); }
        PH_END

        PH_BEGIN PH_LAYER
        { pg8::SchedPlain S; S.so.init(Mq, 4096, G, bx, true); S.A = (const char*)Hb; S.B = (const char*)(wl + W_G); S.a_t = (size_t)256 * D * 2; S.b_t = (size_t)256 * D * 2; S.nt = D / 64;
          EpiMerge E{Yall, Mg}; pg8::gemm_phase(lds, D * 2, D * 2, S, E); }
        PH_END

        PH_BEGIN PH_LAYER
        { pg8::SchedPlain S; S.so.init(Mq, D, G, bx); S.A = (const char*)Mg; S.B = (const char*)(wl + W_O); S.a_t = (size_t)256 * D * 2; S.b_t = (size_t)256 * D * 2; S.nt = D / 64;
          EpiResid E{l == 0 ? ap->in[I_X] : nullptr, (bf16_t*)out, cres, xc, modl + 2 * D}; pg8::gemm_phase(lds, D * 2, D * 2, S, E); }
        PH_END

        PH_BEGIN PH_LAYER
        NORM_PHASE(out, xc, ap->in[I_N2G] + l * D, 3, 4, true)
        PH_END

        PH_BEGIN PH_LAYER
        { pg8::SchedPlain S; S.so.init(Mq, 2 * FF, G, bx); S.A = (const char*)Hb; S.B = (const char*)(wl + W_13); S.a_t = (size_t)256 * D * 2; S.b_t = (size_t)256 * D * 2; S.nt = D / 64;
          EpiSwiGLU E{Hid}; pg8::gemm_phase(lds, D * 2, D * 2, S, E); }
        PH_END

        PH_BEGIN PH_LAYER
        { pg8::SchedPlain S; S.so.init(Mq, D, G, bx, true); S.A = (const char*)Hid; S.B = (const char*)(wl + W_2); S.a_t = (size_t)256 * FF * 2; S.b_t = (size_t)256 * FF * 2; S.nt = FF / 64;
          EpiResid E{nullptr, (bf16_t*)out, xc, xc, modl + 5 * D}; pg8::gemm_phase(lds, FF * 2, FF * 2, S, E); }
        PH_END
    }

    PH_BEGIN
    {
        const float* fg = ap->in[I_FNG];
        for (int r0 = gw * 4; r0 < NLAT; r0 += NGW * 4) {
            float* src = out + (size_t)r0 * D; f32x4 xv[4][4]; float ss[4];
            const bf16_t* sb_ = (const bf16_t*)out + (size_t)r0 * 2048 + 1024;
#pragma unroll
            for (int rr = 0; rr < 4; ++rr)
#pragma unroll
                for (int j = 0; j < 4; ++j) { const u32x2 w_ = *(const u32x2*)(sb_ + rr * 2048 + lane * 4 + 256 * j); xv[rr][j] = (f32x4){bflo(w_.x), bfhi(w_.x), bflo(w_.y), bfhi(w_.y)}; }
            asm volatile("s_waitcnt vmcnt(0)" ::: "memory");
#pragma unroll
            for (int rr = 0; rr < 4; ++rr) { float a_ = 0.f;
#pragma unroll
                for (int j = 0; j < 4; ++j) a_ += xv[rr][j][0] * xv[rr][j][0] + xv[rr][j][1] * xv[rr][j][1] + xv[rr][j][2] * xv[rr][j][2] + xv[rr][j][3] * xv[rr][j][3];
                ss[rr] = a_; }
#pragma unroll
            for (int o_ = 1; o_ < 64; o_ <<= 1)
#pragma unroll
                for (int rr = 0; rr < 4; ++rr) ss[rr] += __uint_as_float((unsigned)__builtin_amdgcn_ds_bpermute((lane ^ o_) << 2, (int)__float_as_uint(ss[rr])));
#pragma unroll
            for (int rr = 0; rr < 4; ++rr) ss[rr] = rsqrtf(ss[rr] * (1.f / D) + EPSV);
#pragma unroll
            for (int j = 0; j < 4; ++j) { const f32x4 g = *(const f32x4*)(fg + lane * 4 + 256 * j);
#pragma unroll
                for (int rr = 0; rr < 4; ++rr) *(f32x4*)(src + rr * D + lane * 4 + 256 * j) = xv[rr][j] * ss[rr] * g; }
        }
    }
    PH_ENDL
}

extern "C" void kernel_launch(void* const* d_in, const int* in_sizes, int n_in, void* d_out, int out_size, void* d_ws, size_t ws_size, hipStream_t stream) {
    static int grid = 0;
    if (grid == 0) {
        if (n_in != 24 || out_size != NLAT * D || ws_size < WS_END) { fprintf(stderr, "kernel_launch: unexpected shapes (n_in %d out %d ws %zu)\n", n_in, out_size, ws_size); grid = -1; return; }
        int dev = 0, cus = 0, per_cu = 0;
        hipGetDevice(&dev);
        hipDeviceGetAttribute(&cus, hipDeviceAttributeMultiprocessorCount, dev);
        hipFuncSetAttribute((const void*)mk_fwd, hipFuncAttributeMaxDynamicSharedMemorySize, LDS_BYTES);
        hipOccupancyMaxActiveBlocksPerMultiprocessor(&per_cu, (const void*)mk_fwd, NTHREADS, LDS_BYTES);
        if (per_cu < 1) { fprintf(stderr, "kernel_launch: occupancy query returned %d\n", per_cu); per_cu = 1; }
        (void)hipGetLastError();
        grid = cus * per_cu;
    }
    if (grid < 0) return;
    Args a{};
    for (int i = 0; i < 24; ++i) a.in[i] = (const float*)d_in[i];
    a.out = (float*)d_out; a.ws = (unsigned char*)d_ws;
    if (hipMemsetAsync(d_ws, 0, XCD_BAR_WORDS * 4, stream) != hipSuccess) { fprintf(stderr, "memset of barrier words failed\n"); return; }
    void* kargs[] = {&a};
    hipError_t e = hipLaunchCooperativeKernel((const void*)mk_fwd, dim3(grid), dim3(NTHREADS), kargs, LDS_BYTES, stream);
    if (e != hipSuccess) fprintf(stderr, "cooperative launch failed: %s (grid %d)\n", hipGetErrorString(e), grid);
}
```

```cpp
#include <hip/hip_runtime.h>
#include <hip/hip_cooperative_groups.h>
#include <cstdio>
#include <cstdint>
namespace cg = cooperative_groups;

#define LAS __attribute__((address_space(3)))
typedef unsigned short bf16_t;
typedef short bf16x8 __attribute__((ext_vector_type(8)));
typedef short s16x4 __attribute__((ext_vector_type(4)));
typedef short v4i16_t __attribute__((ext_vector_type(4)));
typedef float f32x4 __attribute__((ext_vector_type(4)));
typedef float f32x16 __attribute__((ext_vector_type(16)));
typedef unsigned u32x4 __attribute__((ext_vector_type(4)));
typedef unsigned u32x2 __attribute__((ext_vector_type(2)));
typedef float f32x2_t __attribute__((ext_vector_type(2)));
typedef __bf16 bf16x2_t __attribute__((ext_vector_type(2)));

constexpr int D = 1024, NB = 2, SEQ = 16384, NLAT = NB * SEQ, CTXL = 256, NCTX = NB * CTXL, MT = NLAT + NCTX;
constexpr int INC = 6048, FF = 2816, DEPTH = 2;
constexpr int UW = 2048, QW = 768, YW = 1280;
constexpr int U_NAK = 0, U_NAV = 256, U_SWK = 512, U_SWV = 640, U_CKV = 768, U_KR = 896, U_NAQ = 928, U_SWQ = 1184, U_CQ = 1440, U_POOL = 1696, U_END = 1952;
constexpr float EPSV = 1e-6f;
constexpr float LOG2E = 1.4426950408889634f;
constexpr float QSC64 = 0.125f * LOG2E;
constexpr float QSCMLA = 0.10206207261596577f * LOG2E;

constexpr size_t MiB = 1u << 20;
constexpr size_t WS_MOD = 1 * MiB, WS_XC = 2 * MiB, WS_W = 8 * MiB, WS_H = 80 * MiB, WS_Y = 145 * MiB, WS_R4 = 227 * MiB, WS_QM = WS_R4 + 130 * MiB, WS_END = 487 * MiB;
constexpr size_t WL = 35 * MiB;
constexpr size_t W_U = 0, W_G = 4 * MiB, W_QF = 12 * MiB, W_B = 12 * MiB + 512 * 1024, W_O = 16 * MiB + 512 * 1024, W_13 = 18 * MiB + 512 * 1024, W_2 = 29 * MiB + 512 * 1024;

constexpr int NTHREADS = 512;
constexpr int LDS_BYTES = 147456;

__device__ __forceinline__ unsigned cvtpk(float lo, float hi) { f32x2_t v = {lo, hi}; bf16x2_t b = __builtin_convertvector(v, bf16x2_t); return __builtin_bit_cast(unsigned, b); }
__device__ __forceinline__ float bflo(unsigned w) { return __uint_as_float(w << 16); }
__device__ __forceinline__ float bfhi(unsigned w) { return __uint_as_float(w & 0xffff0000u); }
__device__ __forceinline__ float bf2f(bf16_t h) { return __uint_as_float(((unsigned)h) << 16); }
__device__ __forceinline__ bf16_t f2bf(float f) { return (bf16_t)(cvtpk(f, 0.f) & 0xffffu); }
__device__ __forceinline__ float wave_sum_l(float v, int lane) {
#pragma unroll
    for (int o = 1; o < 64; o <<= 1) v += __uint_as_float((unsigned)__builtin_amdgcn_ds_bpermute((lane ^ o) << 2, (int)__float_as_uint(v)));
    return v;
}
__device__ __forceinline__ float xhalf_max(float m) { auto rr = __builtin_amdgcn_permlane32_swap(__float_as_uint(m), __float_as_uint(m), false, false); return fmaxf(__uint_as_float(rr[0]), __uint_as_float(rr[1])); }
__device__ __forceinline__ float xhalf_sum(float m) { auto rr = __builtin_amdgcn_permlane32_swap(__float_as_uint(m), __float_as_uint(m), false, false); return __uint_as_float(rr[0]) + __uint_as_float(rr[1]); }
__device__ __forceinline__ int fresh_tid() { int t = threadIdx.x; asm volatile("" : "+v"(t)); return t; }
__device__ __forceinline__ float fexp2(float x) { return __builtin_amdgcn_exp2f(x); }
__device__ __forceinline__ float frcp(float x) { return __builtin_amdgcn_rcpf(x); }
__device__ __forceinline__ float sigmoidf_(float x) { return frcp(1.f + fexp2(-x * LOG2E)); }

namespace pg8 {
constexpr int BM = 256, BK = 64, HALF = 128, HTB = HALF * BK * 2, STAGE_BYTES = 8 * HTB, NXCD = 8, WGM = 8;
__device__ __forceinline__ int lds_byte(int r, int c) { const int st = (r >> 4) * 2 + (c >> 5), rr = r & 15, cc = c & 31, ob = rr * 64 + cc * 2; return st * 1024 + (ob ^ (((ob >> 9) & 1) << 5)); }
__device__ __forceinline__ int perm32(int rho) { const int n = rho >> 4, i = rho & 15; return 8 * (i >> 2) + 4 * n + (i & 3); }
__device__ __forceinline__ void stage_rc(int b, int& R, int& C) { const int st = b / 1024, sb = b % 1024, swz = sb ^ (((sb >> 9) & 1) << 5); R = (st >> 1) * 16 + swz / 64; C = (st & 1) * 32 + (swz % 64) / 2; }

struct Unit { const char* A; const char* B; int pm, pn, nt; };

struct StaticOrder {
    int nM, nN, nwg, G, c;
    __device__ void init(int M, int N, int G_, int c_) { nM = M / BM; nN = N / BM; nwg = nM * nN; G = G_; c = c_; }
    __device__ bool next(int i, int& pm, int& pn) const {
        const long L = (long)i * G + c; if (L >= nwg) return false;
        int wgid = (int)L; { const int q = nwg / NXCD, r = nwg % NXCD, xcd = wgid % NXCD, off = wgid / NXCD; wgid = (xcd < r ? xcd * (q + 1) : r * (q + 1) + (xcd - r) * q) + off; }
        const int nig = WGM * nN, gid = wgid / nig, fm = gid * WGM, gsz = (nM - fm) < WGM ? (nM - fm) : WGM;
        pm = fm + ((wgid % nig) % gsz); pn = (wgid % nig) / gsz; return true;
    }
};
struct SchedPlain {
    StaticOrder so; const char* A; const char* B; size_t a_t, b_t; int nt;
    __device__ bool next(int i, Unit& u) const { int pm, pn; if (!so.next(i, pm, pn)) return false; u.pm = pm; u.pn = pn; u.A = A + (size_t)pm * a_t; u.B = B + (size_t)pn * b_t; u.nt = nt; return true; }
};
struct SchedBranch {
    StaticOrder so; const char* A; const char* B; size_t a_t;
    __device__ bool next(int i, Unit& u) const { int pm, pn; if (!so.next(i, pm, pn)) return false; u.pm = pm; u.pn = pn; const int br = pn >> 2;
        u.A = A + (size_t)pm * a_t + (size_t)br * 512; u.B = B + (size_t)br * (1024 * 512 * 2) + (size_t)(pn & 3) * (256 * 512 * 2); u.nt = br == 3 ? 8 : 4; return true; }
};

template <class Epi, class Sched>
__device__ __forceinline__ void gemm_phase(LAS unsigned char* lds, const int lda, const int ldb, const Sched& S, Epi& E) {
    const int tid = fresh_tid(), wid = __builtin_amdgcn_readfirstlane(tid >> 6), lane = tid & 63, wr = wid >> 2, wc = wid & 3, fr = lane & 15, fq = lane >> 4;
    unsigned voffA[2], voffB[2];
#pragma unroll
    for (int i = 0; i < 2; ++i) { int R, C; stage_rc(tid * 16 + i * 8192, R, C); const int Rb = Epi::PERM ? ((R & ~31) + perm32(R & 31)) : R;
        voffA[i] = (unsigned)(R * lda + C * 2); voffB[i] = (unsigned)(Rb * ldb + C * 2); }
    const size_t kstep = (size_t)(BK * 2);
    const size_t hstepA = (size_t)HALF * lda, hstepB = (size_t)HALF * ldb;
    const unsigned ldsw = (unsigned)wid * 1024u;
    const int aoff = lds_byte(wr * 64 + fr, fq * 8), boff = lds_byte(wc * 32 + fr, fq * 8);
#define PG8_SA(b, h) (((b) * 2 + (h)) * HTB)
#define PG8_SB(b, h) ((4 + (b) * 2 + (h)) * HTB)
#define PG8_STAGE(bufoff, gbase, voff) do { _Pragma("unroll") for (int _i = 0; _i < 2; ++_i) \
        __builtin_amdgcn_global_load_lds((const unsigned*)((const char*)(gbase) + (voff)[_i]), (LAS unsigned*)(lds + (bufoff) + ldsw + _i * 8192), 16, 0, 0); } while (0)
#define PG8_LDA(dst, b, h) do { _Pragma("unroll") for (int m = 0; m < 4; ++m) _Pragma("unroll") for (int k = 0; k < 2; ++k) dst[m][k] = *(const LAS bf16x8*)(lds + PG8_SA(b, h) + aoff + m * 2048 + k * 1024); } while (0)
#define PG8_LDB(dst, b, h) do { _Pragma("unroll") for (int n = 0; n < 2; ++n) _Pragma("unroll") for (int k = 0; k < 2; ++k) dst[n][k] = *(const LAS bf16x8*)(lds + PG8_SB(b, h) + boff + n * 2048 + k * 1024); } while (0)
#define PG8_MMA(ai, bj, At, Bt) do { __builtin_amdgcn_s_setprio(1); _Pragma("unroll") for (int m = 0; m < 4; ++m) _Pragma("unroll") for (int n = 0; n < 2; ++n) _Pragma("unroll") for (int k = 0; k < 2; ++k) \
        acc[ai][bj][m][n] = __builtin_amdgcn_mfma_f32_16x16x32_bf16(Bt[n][k], At[m][k], acc[ai][bj][m][n], 0, 0, 0); __builtin_amdgcn_s_setprio(0); } while (0)
#define PG8_WAIT_V(n) asm volatile("s_waitcnt vmcnt(" #n ")" ::: "memory")
#define PG8_WAIT_L(n) asm volatile("s_waitcnt lgkmcnt(" #n ")" ::: "memory")
#define PG8_BAR __builtin_amdgcn_s_barrier()
#define PG8_SCHED __builtin_amdgcn_sched_barrier(0)
    Unit cur, nxt; int ui = 0;
    if (!S.next(0, cur)) return;
    f32x4 acc[2][2][4][2];
#pragma unroll
    for (int a = 0; a < 2; ++a)
#pragma unroll
        for (int b = 0; b < 2; ++b)
#pragma unroll
            for (int m = 0; m < 4; ++m)
#pragma unroll
                for (int n = 0; n < 2; ++n) acc[a][b][m][n] = (f32x4){0.f, 0.f, 0.f, 0.f};
    bf16x8 At[4][2], B0[2][2], B1[2][2];
    const char* cA = cur.A; const char* cB = cur.B;
    PG8_STAGE(PG8_SB(0, 0), cB, voffB); PG8_STAGE(PG8_SB(0, 1), cB + hstepB, voffB); PG8_STAGE(PG8_SA(0, 0), cA, voffA); PG8_STAGE(PG8_SA(0, 1), cA + hstepA, voffA);
    if (wr == 1) PG8_BAR;
    PG8_WAIT_V(2); PG8_BAR;
    PG8_STAGE(PG8_SB(1, 0), cB + kstep, voffB); PG8_STAGE(PG8_SA(1, 0), cA + kstep, voffA); PG8_STAGE(PG8_SB(1, 1), cB + hstepB + kstep, voffB);
    PG8_WAIT_V(6); PG8_BAR;
    for (;;) {
        const bool has_next = S.next(ui + 1, nxt);
        const char* nA = has_next ? nxt.A : cA; const char* nB = has_next ? nxt.B : cB;
        const int nt = cur.nt;
        for (int t = 0; t < nt; t += 2) {
            const bool last = (t == nt - 2);
            const char* a1 = cA + (size_t)(t + 1) * kstep;
            const char* a2 = last ? nA : cA + (size_t)(t + 2) * kstep; const char* b2 = last ? nB : cB + (size_t)(t + 2) * kstep;
            const char* a3 = a2 + kstep; const char* b3 = b2 + kstep;
            PG8_LDB(B0, 0, 0); PG8_LDB(B1, 0, 1); PG8_SCHED; PG8_LDA(At, 0, 0); PG8_STAGE(PG8_SA(1, 1), a1 + hstepA, voffA);
            PG8_WAIT_V(8); PG8_WAIT_L(0); PG8_BAR; PG8_MMA(0, 0, At, B0); PG8_MMA(0, 1, At, B1); PG8_BAR; PG8_SCHED;
            PG8_LDA(At, 0, 1); PG8_STAGE(PG8_SB(0, 0), b2, voffB); PG8_STAGE(PG8_SB(0, 1), b2 + hstepB, voffB); PG8_STAGE(PG8_SA(0, 0), a2, voffA);
            PG8_WAIT_V(8); PG8_WAIT_L(0); PG8_BAR; PG8_MMA(1, 0, At, B0); PG8_MMA(1, 1, At, B1); PG8_BAR; PG8_SCHED;
            PG8_LDB(B0, 1, 0); PG8_LDB(B1, 1, 1); PG8_SCHED; PG8_LDA(At, 1, 0); PG8_STAGE(PG8_SA(0, 1), a2 + hstepA, voffA);
            PG8_WAIT_V(8); PG8_WAIT_L(0); PG8_BAR; PG8_MMA(0, 0, At, B0); PG8_MMA(0, 1, At, B1); PG8_BAR; PG8_SCHED;
            PG8_LDA(At, 1, 1); PG8_STAGE(PG8_SB(1, 0), b3, voffB); PG8_STAGE(PG8_SB(1, 1), b3 + hstepB, voffB); PG8_STAGE(PG8_SA(1, 0), a3, voffA);
            PG8_WAIT_V(8); PG8_WAIT_L(0); PG8_BAR; PG8_MMA(1, 0, At, B0); PG8_MMA(1, 1, At, B1); PG8_BAR; PG8_SCHED;
        }
        if (wr == 0) PG8_BAR;
        E(acc, cur, wr, wc, fr, fq);
        if (!has_next) break;
#pragma unroll
        for (int a = 0; a < 2; ++a)
#pragma unroll
            for (int b = 0; b < 2; ++b)
#pragma unroll
                for (int m = 0; m < 4; ++m)
#pragma unroll
                    for (int n = 0; n < 2; ++n) acc[a][b][m][n] = (f32x4){0.f, 0.f, 0.f, 0.f};
        cur = nxt; cA = nA; cB = nB; ++ui;
        if (wr == 1) PG8_BAR;
    }
    PG8_WAIT_V(0);
    PG8_BAR;
#undef PG8_SA
#undef PG8_SB
#undef PG8_STAGE
#undef PG8_LDA
#undef PG8_LDB
#undef PG8_MMA
#undef PG8_WAIT_V
#undef PG8_WAIT_L
#undef PG8_BAR
#undef PG8_SCHED
}
}

typedef f32x4 acc_t[2][2][4][2];

struct EpiStore {
    static constexpr bool PERM = true;
    bf16_t* O; int ldc;
    __device__ __forceinline__ void operator()(const acc_t& acc, const pg8::Unit& u, int wr, int wc, int fr, int fq) const {
        const int row0 = u.pm * 256 + wr * 64 + fr, col0 = u.pn * 256 + wc * 32 + 8 * fq;
#pragma unroll
        for (int ai = 0; ai < 2; ++ai)
#pragma unroll
            for (int m = 0; m < 4; ++m) { bf16_t* rowp = O + (size_t)(row0 + ai * 128 + m * 16) * ldc + col0;
#pragma unroll
                for (int bj = 0; bj < 2; ++bj) { const f32x4 v0 = acc[ai][bj][m][0], v1 = acc[ai][bj][m][1];
                    u32x4 w; w.x = cvtpk(v0[0], v0[1]); w.y = cvtpk(v0[2], v0[3]); w.z = cvtpk(v1[0], v1[1]); w.w = cvtpk(v1[2], v1[3]); *(u32x4*)(rowp + bj * 128) = w; } }
    }
};
struct EpiQRope {
    static constexpr bool PERM = false;
    bf16_t* O;
    __device__ __forceinline__ void operator()(const acc_t& acc, const pg8::Unit& u, int wr, int wc, int fr, int fq) const {
        const int row0 = u.pm * 256 + wr * 64 + fr, col0 = u.pn * 256 + wc * 32 + 4 * fq;
        const bool latent = u.pm < 128;
        float inv[4];
#pragma unroll
        for (int j = 0; j < 4; ++j) inv[j] = exp2f(-(float)(4 * (fq & 1) + j) * 1.6609640474436813f);
#pragma unroll
        for (int ai = 0; ai < 2; ++ai)
#pragma unroll
            for (int m = 0; m < 4; ++m) { const int row = row0 + ai * 128 + m * 16; bf16_t* rowp = O + (size_t)row * QW + col0;
                const int t = row & (SEQ - 1); const float pos = (float)((fq < 2) ? (t >> 6) : (t & 63));
#pragma unroll
                for (int bj = 0; bj < 2; ++bj) { const int cb = u.pn * 8 + bj * 4 + wc; f32x4 v0 = acc[ai][bj][m][0], v1 = acc[ai][bj][m][1];
                    if (latent && (cb == 4 || cb == 9 || cb == 14 || cb == 19)) {
#pragma unroll
                        for (int j = 0; j < 4; ++j) { const float a = pos * inv[j]; const float cs = __cosf(a), sn = __sinf(a); const float x1 = v0[j], x2 = v1[j]; v0[j] = x1 * cs - x2 * sn; v1[j] = x2 * cs + x1 * sn; }
                    }
                    u32x2 w; w.x = cvtpk(v0[0], v0[1]); w.y = cvtpk(v0[2], v0[3]); *(u32x2*)(rowp + bj * 128) = w;
                    w.x = cvtpk(v1[0], v1[1]); w.y = cvtpk(v1[2], v1[3]); *(u32x2*)(rowp + bj * 128 + 16) = w; } }
    }
};
struct EpiMerge {
    static constexpr bool PERM = false;
    const bf16_t* Yall; bf16_t* Mg;
    __device__ __forceinline__ void operator()(const acc_t& acc, const pg8::Unit& u, int wr, int wc, int fr, int fq) const {
        const int row0 = u.pm * 256 + wr * 64 + fr, ocol = u.pn * 64 + wc * 16 + 4 * fq;
#pragma unroll
        for (int ai = 0; ai < 2; ++ai)
#pragma unroll
            for (int m = 0; m < 4; ++m) { const int row = row0 + ai * 128 + m * 16; const bf16_t* yr = Yall + (size_t)row * 4096 + ocol; f32x4 s = {0.f, 0.f, 0.f, 0.f};
#pragma unroll
                for (int bj = 0; bj < 2; ++bj)
#pragma unroll
                    for (int n = 0; n < 2; ++n) { const u32x2 w = *(const u32x2*)(yr + (2 * bj + n) * 1024); const f32x4 g = acc[ai][bj][m][n];
                        s[0] += sigmoidf_(g[0]) * bflo(w.x); s[1] += sigmoidf_(g[1]) * bfhi(w.x); s[2] += sigmoidf_(g[2]) * bflo(w.y); s[3] += sigmoidf_(g[3]) * bfhi(w.y); }
                u32x2 o; o.x = cvtpk(s[0], s[1]); o.y = cvtpk(s[2], s[3]); *(u32x2*)(Mg + (size_t)row * D + ocol) = o; }
    }
};
struct EpiResid {
    static constexpr bool PERM = false;
    const float* res_lat_f32;
    bf16_t* rb;
    const float* res_ctx; float* out_ctx; const float* gate;
    __device__ __forceinline__ void operator()(const acc_t& acc, const pg8::Unit& u, int wr, int wc, int fr, int fq) const {
        const int lrow0 = wr * 64 + fr, col0 = u.pn * 256 + wc * 32 + 4 * fq;
        const int v = u.pm < 128 ? (u.pm >> 6) : 2;
        const float* gp = gate + v * 6144;
        f32x4 gv[2][2];
#pragma unroll
        for (int bj = 0; bj < 2; ++bj)
#pragma unroll
            for (int n = 0; n < 2; ++n) gv[bj][n] = *(const f32x4*)(gp + col0 + bj * 128 + n * 16);
        if (u.pm < 128) {
            bf16_t* rbt = rb + (size_t)u.pm * 256 * 2048 + 1024;
            if (res_lat_f32) {
                const float* res = res_lat_f32 + (size_t)u.pm * 256 * D;
#pragma unroll
                for (int ai = 0; ai < 2; ++ai)
#pragma unroll
                    for (int m = 0; m < 4; ++m) { const int lr = lrow0 + ai * 128 + m * 16;
#pragma unroll
                        for (int bj = 0; bj < 2; ++bj)
#pragma unroll
                            for (int n = 0; n < 2; ++n) { const int c = col0 + bj * 128 + n * 16; const f32x4 r = *(const f32x4*)(res + (size_t)lr * D + c);
                                const f32x4 o = r + gv[bj][n] * acc[ai][bj][m][n];
                                u32x2 w2; w2.x = cvtpk(o[0], o[1]); w2.y = cvtpk(o[2], o[3]); *(u32x2*)(rbt + (size_t)lr * 2048 + c) = w2; } }
            } else {
#pragma unroll
                for (int ai = 0; ai < 2; ++ai)
#pragma unroll
                    for (int m = 0; m < 4; ++m) { const int lr = lrow0 + ai * 128 + m * 16;
#pragma unroll
                        for (int bj = 0; bj < 2; ++bj)
#pragma unroll
                            for (int n = 0; n < 2; ++n) { const int c = col0 + bj * 128 + n * 16; const u32x2 w = *(const u32x2*)(rbt + (size_t)lr * 2048 + c);
                                const f32x4 r = (f32x4){bflo(w.x), bfhi(w.x), bflo(w.y), bfhi(w.y)};
                                const f32x4 o = r + gv[bj][n] * acc[ai][bj][m][n];
                                u32x2 w2; w2.x = cvtpk(o[0], o[1]); w2.y = cvtpk(o[2], o[3]); *(u32x2*)(rbt + (size_t)lr * 2048 + c) = w2; } }
            }
        } else {
            const float* res = res_ctx + (size_t)(u.pm - 128) * 256 * D; float* out = out_ctx + (size_t)(u.pm - 128) * 256 * D;
#pragma unroll
            for (int ai = 0; ai < 2; ++ai)
#pragma unroll
                for (int m = 0; m < 4; ++m) { const size_t off = (size_t)(lrow0 + ai * 128 + m * 16) * D + col0;
#pragma unroll
                    for (int bj = 0; bj < 2; ++bj)
#pragma unroll
                        for (int n = 0; n < 2; ++n) { const f32x4 r = *(const f32x4*)(res + off + bj * 128 + n * 16); *(f32x4*)(out + off + bj * 128 + n * 16) = r + gv[bj][n] * acc[ai][bj][m][n]; } }
        }
    }
};
struct EpiSwiGLU {
    static constexpr bool PERM = true;
    bf16_t* Hd;
    __device__ __forceinline__ void operator()(const acc_t& acc, const pg8::Unit& u, int wr, int wc, int fr, int fq) const {
        const int row0 = u.pm * 256 + wr * 64 + fr, hcol = u.pn * 128 + wc * 32 + 8 * fq;
#pragma unroll
        for (int ai = 0; ai < 2; ++ai)
#pragma unroll
            for (int m = 0; m < 4; ++m) { bf16_t* rowp = Hd + (size_t)(row0 + ai * 128 + m * 16) * FF + hcol; f32x4 v[2];
#pragma unroll
                for (int n = 0; n < 2; ++n) { const f32x4 a = acc[ai][0][m][n], b = acc[ai][1][m][n];
#pragma unroll
                    for (int j = 0; j < 4; ++j) v[n][j] = a[j] * sigmoidf_(a[j]) * b[j]; }
                u32x4 w; w.x = cvtpk(v[0][0], v[0][1]); w.y = cvtpk(v[0][2], v[0][3]); w.z = cvtpk(v[1][0], v[1][1]); w.w = cvtpk(v[1][2], v[1][3]); *(u32x4*)rowp = w; }
    }
};

__device__ __forceinline__ s16x4 vtr(LAS const unsigned char* p) { return __builtin_bit_cast(s16x4, __builtin_amdgcn_ds_read_tr16_b64_v4i16((LAS v4i16_t*)p)); }
__device__ __forceinline__ int crow(int r, int hi) { return (r & 3) + 8 * (r >> 2) + 4 * hi; }

template <int MODE>
__device__ __forceinline__ void attn_unit(LAS unsigned char* lds, const bf16_t* __restrict__ u, const bf16_t* __restrict__ qm, bf16_t* __restrict__ y,
                                          const float* __restrict__ rpb, const float* __restrict__ sink,
                                          int qrow0, int kctx_row0, int nlocal, int loc_row0, int aux0, int aux1, int kvh) {
    constexpr int KW = MODE == 0 ? 160 : (MODE == 1 ? 256 : 64);
    constexpr int KSTR = KW * 2 + 16;
    constexpr int NKS = MODE == 0 ? 10 : 4;
    constexpr int NDB = MODE == 0 ? 4 : 2;
    constexpr bool VSEP = MODE != 0;
    constexpr int CPR = KW / 8, NCH = 64 * CPR, NLD = (NCH + 511) / 512;
    constexpr int STAGE = (VSEP ? 2 : 1) * 64 * KSTR;
    const int tid = fresh_tid(), lane = tid & 63, wid = __builtin_amdgcn_readfirstlane(tid >> 6), l32 = lane & 31, hi = lane >> 5;
    int head, qtok, kcolw, kgcol, vgcol, ycol;
    if (MODE == 0) { head = wid & 3; qtok = 32 * (wid >> 2) + l32; kcolw = 0; kgcol = U_CKV; vgcol = U_CKV; ycol = 768 + head * 128; }
    else if (MODE == 1) { head = wid & 3; qtok = 32 * (wid >> 2) + l32; kcolw = head * 64; kgcol = U_NAK; vgcol = U_NAV; ycol = 256 + head * 64; }
    else { head = kvh * 2 + (wid & 1); qtok = 32 * (wid >> 1) + l32; kcolw = 0; kgcol = U_SWK + kvh * 64; vgcol = U_SWV + kvh * 64; ycol = 512 + head * 64; }
    const bf16_t* qp = MODE == 0 ? qm + (size_t)(qrow0 + qtok) * QW + head * 160 : u + (size_t)(qrow0 + qtok) * UW + (MODE == 1 ? U_NAQ : U_SWQ) + head * 64;
    bf16x8 qf[NKS];
#pragma unroll
    for (int ks = 0; ks < NKS; ++ks) qf[ks] = *(const bf16x8*)(qp + 16 * ks + 8 * hi);
    f32x16 o[NDB];
#pragma unroll
    for (int c = 0; c < NDB; ++c)
#pragma unroll
        for (int r = 0; r < 16; ++r) o[c][r] = 0.f;
    float mrun = -1e30f, lrun = 0.f;
    int srow[NLD], sch[NLD];
#pragma unroll
    for (int i = 0; i < NLD; ++i) { const int idx = tid + 512 * i; srow[i] = idx / CPR; sch[i] = idx % CPR; }
    u32x4 kreg[NLD], vreg[NLD];
    const int ntile = 4 + nlocal;
    unsigned dvo[5];
    if (MODE == 1) {
#pragma unroll
        for (int i = 0; i < 5; ++i) { const int sl = (wid + 8 * i) * 64 + lane, row = (sl / 33) & 63, ch = sl % 33; dvo[i] = (unsigned)(row * (UW * 2) + (ch < 32 ? ch : 0) * 16); }
    }
#define ATT_DMA(t, buf) do { const char* tb_ = (const char*)u + (size_t)ATT_TROW(t) * (UW * 2); _Pragma("unroll") for (int i = 0; i < 5; ++i) if (wid + 8 * i < 33) { \
        __builtin_amdgcn_global_load_lds((const unsigned*)(tb_ + kgcol * 2 + dvo[i]), (LAS unsigned*)(lds + (buf) * STAGE + (wid + 8 * i) * 1024), 16, 0, 0); \
        __builtin_amdgcn_global_load_lds((const unsigned*)(tb_ + vgcol * 2 + dvo[i]), (LAS unsigned*)(lds + (buf) * STAGE + 64 * KSTR + (wid + 8 * i) * 1024), 16, 0, 0); } } while (0)
#define ATT_TROW(t) ((t) < 4 ? kctx_row0 + 64 * (t) : loc_row0 + 64 * ((t) - 4))
#define ATT_LOAD(t) do { const int rg_ = ATT_TROW(t); _Pragma("unroll") for (int i = 0; i < NLD; ++i) if (NCH % 512 == 0 || i < NLD - 1 || tid + 512 * i < NCH) { \
        const bf16_t* gp_ = u + (size_t)(rg_ + srow[i]) * UW + sch[i] * 8; kreg[i] = *(const u32x4*)(gp_ + kgcol); if (VSEP) vreg[i] = *(const u32x4*)(gp_ + vgcol); } } while (0)
#define ATT_STORE(buf) do { _Pragma("unroll") for (int i = 0; i < NLD; ++i) if (NCH % 512 == 0 || i < NLD - 1 || tid + 512 * i < NCH) { \
        LAS unsigned char* lp_ = lds + (buf) * STAGE + srow[i] * KSTR + sch[i] * 16; *(LAS u32x4*)lp_ = kreg[i]; if (VSEP) *(LAS u32x4*)(lp_ + 64 * KSTR) = vreg[i]; } } while (0)
    if (MODE == 1) { ATT_DMA(0, 0); asm volatile("s_waitcnt vmcnt(0)" ::: "memory"); } else { ATT_LOAD(0); ATT_STORE(0); }
    __syncthreads();
    const int q4 = (lane & 15) >> 2, p4 = lane & 3, blk = (lane >> 4) & 1;
    for (int t = 0; t < ntile; ++t) {
        const int buf = t & 1;
        if (t + 1 < ntile) { if (MODE == 1) ATT_DMA(t + 1, (t + 1) & 1); else ATT_LOAD(t + 1); }
        float rpv = 0.f;
        if (MODE == 1 && t >= 4) rpv = rpb[(head * 15 + (aux1 + (t - 4) - aux0 + 7)) * 31 + min(lane, 30)];
        LAS const unsigned char* Kb = lds + buf * STAGE;
        LAS const unsigned char* Vb = VSEP ? Kb + 64 * KSTR : Kb;
        f32x16 s0, s1;
#pragma unroll
        for (int r = 0; r < 16; ++r) { s0[r] = 0.f; s1[r] = 0.f; }
        {
            LAS const unsigned char* kp = Kb + l32 * KSTR + (kcolw + 8 * hi) * 2;
            bf16x8 ka0 = *(LAS const bf16x8*)(kp), ka1 = *(LAS const bf16x8*)(kp + 32 * KSTR);
#pragma unroll
            for (int ks = 0; ks < NKS; ++ks) {
                bf16x8 kb0 = ka0, kb1 = ka1;
                if (ks + 1 < NKS) { kb0 = *(LAS const bf16x8*)(kp + (ks + 1) * 32); kb1 = *(LAS const bf16x8*)(kp + (ks + 1) * 32 + 32 * KSTR); }
                s0 = __builtin_amdgcn_mfma_f32_32x32x16_bf16(ka0, qf[ks], s0, 0, 0, 0);
                s1 = __builtin_amdgcn_mfma_f32_32x32x16_bf16(ka1, qf[ks], s1, 0, 0, 0);
                __builtin_amdgcn_sched_barrier(0);
                ka0 = kb0; ka1 = kb1;
            }
        }
        if (MODE == 1 && t >= 4) {
            const int c = qtok, c0 = min(max(c - 8, 0), 48);
            const int rpi = (int)__float_as_uint(rpv);
#pragma unroll
            for (int r = 0; r < 16; ++r) {
                const int kc0 = crow(r, hi), kc1 = kc0 + 32;
                const bool v0 = (kc0 >= c0) && (kc0 < c0 + 16), v1 = (kc1 >= c0) && (kc1 < c0 + 16);
                const float b0 = __uint_as_float((unsigned)__builtin_amdgcn_ds_bpermute(min(max(kc0 - c + 15, 0), 30) << 2, rpi));
                const float b1 = __uint_as_float((unsigned)__builtin_amdgcn_ds_bpermute(min(max(kc1 - c + 15, 0), 30) << 2, rpi));
                s0[r] = v0 ? s0[r] + b0 * LOG2E : -INFINITY; s1[r] = v1 ? s1[r] + b1 * LOG2E : -INFINITY;
            }
        }
        if (MODE == 2 && t >= 4) {
            const int qpos = aux0 + qtok, kb0 = aux1 + 64 * (t - 4);
#pragma unroll
            for (int r = 0; r < 16; ++r) {
                const int d0 = kb0 + crow(r, hi) - qpos, d1 = d0 + 32;
                if (d0 > 128 || d0 < -128) s0[r] = -INFINITY;
                if (d1 > 128 || d1 < -128) s1[r] = -INFINITY;
            }
        }
        float mx = fmaxf(s0[0], s1[0]);
#pragma unroll
        for (int r = 1; r < 16; ++r) mx = fmaxf(mx, fmaxf(s0[r], s1[r]));
        mx = xhalf_max(mx);
        const float mnew = fmaxf(mrun, mx), alpha = fexp2(mrun - mnew);
        mrun = mnew;
        float rs = 0.f;
#pragma unroll
        for (int r = 0; r < 16; ++r) { s0[r] = fexp2(s0[r] - mnew); s1[r] = fexp2(s1[r] - mnew); rs += s0[r] + s1[r]; }
        lrun = lrun * alpha + rs;
#pragma unroll
        for (int c = 0; c < NDB; ++c)
#pragma unroll
            for (int r = 0; r < 16; ++r) o[c][r] *= alpha;
        u32x4 pw[2][2];
#pragma unroll
        for (int s = 0; s < 2; ++s) {
            pw[0][s] = (u32x4){cvtpk(s0[8 * s], s0[8 * s + 1]), cvtpk(s0[8 * s + 2], s0[8 * s + 3]), cvtpk(s0[8 * s + 4], s0[8 * s + 5]), cvtpk(s0[8 * s + 6], s0[8 * s + 7])};
            pw[1][s] = (u32x4){cvtpk(s1[8 * s], s1[8 * s + 1]), cvtpk(s1[8 * s + 2], s1[8 * s + 3]), cvtpk(s1[8 * s + 4], s1[8 * s + 5]), cvtpk(s1[8 * s + 6], s1[8 * s + 7])};
        }
        {
            LAS const unsigned char* vp = Vb + (4 * hi + q4) * KSTR + (kcolw + 16 * blk) * 2 + 8 * p4;
            s16x4 la = vtr(vp), ha = vtr(vp + 8 * KSTR);
#pragma unroll
            for (int it = 0; it < NDB * 4; ++it) {
                const int c = it >> 2, kb = (it >> 1) & 1, s = it & 1;
                s16x4 lb = la, hb = ha;
                if (it + 1 < NDB * 4) { const int c2 = (it + 1) >> 2, kb2 = ((it + 1) >> 1) & 1, s2 = (it + 1) & 1;
                    lb = vtr(vp + (32 * kb2 + 16 * s2) * KSTR + c2 * 64); hb = vtr(vp + (32 * kb2 + 16 * s2 + 8) * KSTR + c2 * 64); }
                const bf16x8 vf = (bf16x8){la[0], la[1], la[2], la[3], ha[0], ha[1], ha[2], ha[3]};
                o[c] = __builtin_amdgcn_mfma_f32_32x32x16_bf16(vf, __builtin_bit_cast(bf16x8, pw[kb][s]), o[c], 0, 0, 0);
                __builtin_amdgcn_sched_barrier(0);
                la = lb; ha = hb;
            }
        }
        if (MODE == 1) asm volatile("s_waitcnt vmcnt(0)" ::: "memory"); else if (t + 1 < ntile) ATT_STORE((t + 1) & 1);
        __syncthreads();
    }
    lrun = xhalf_sum(lrun);
    if (MODE == 2) lrun += fexp2(sink[head] * LOG2E - mrun);
    const float inv = 1.f / lrun;
    bf16_t* yp = y + (size_t)(qrow0 + qtok) * YW + ycol + 4 * hi;
#pragma unroll
    for (int c = 0; c < NDB; ++c)
#pragma unroll
        for (int g = 0; g < 4; ++g) { u32x2 w; w.x = cvtpk(o[c][4 * g] * inv, o[c][4 * g + 1] * inv); w.y = cvtpk(o[c][4 * g + 2] * inv, o[c][4 * g + 3] * inv); *(u32x2*)(yp + 32 * c + 8 * g) = w; }
#undef ATT_TROW
#undef ATT_DMA
#undef ATT_LOAD
#undef ATT_STORE
}


__device__ __forceinline__ void mla_unit(LAS unsigned char* lds, const bf16_t* __restrict__ u, const bf16_t* __restrict__ qm, bf16_t* __restrict__ y,
                                         int qrow0, int kctx_row0, int nlocal, int loc_row0) {
    constexpr int KSTR = 320, NKS = 10, STAGE = 41 * 1024, KB1 = 32 * KSTR + 64, HALFB = 64 * KSTR + 128;
    constexpr float THR = 6.f;
    const int tid = fresh_tid(), lane = tid & 63, wid = __builtin_amdgcn_readfirstlane(tid >> 6), l32 = lane & 31, hi = lane >> 5;
    const int head = wid & 3, qtok = 32 * (wid >> 2) + l32;
    const bf16_t* qp = qm + (size_t)(qrow0 + qtok) * QW + head * 160;
    bf16x8 qf[NKS];
#pragma unroll
    for (int ks = 0; ks < NKS; ++ks) qf[ks] = *(const bf16x8*)(qp + 16 * ks + 8 * hi);
    f32x16 o[4];
#pragma unroll
    for (int c = 0; c < 4; ++c)
#pragma unroll
        for (int r = 0; r < 16; ++r) o[c][r] = 0.f;
    float mref = -1e30f, lrun = 0.f;
    const int nmac = 2 + (nlocal >> 1);
#define MLA_TROW(T) ((T) < 2 ? kctx_row0 + 128 * (T) : loc_row0 + 128 * ((T) - 2))
    unsigned dvo[6];
#pragma unroll
    for (int i = 0; i < 6; ++i) { const int sl = (wid * 6 + i) * 64 + lane, g = sl / 161, rem = sl % 161; const bool ok = sl < 2576 && rem < 160;
        const int row = ok ? 8 * g + rem / 20 : 0, ch = ok ? rem % 20 : 0; dvo[i] = (unsigned)(row * (UW * 2) + ch * 16); }
    const char* kbase = (const char*)(u + U_CKV);
#define MLA_DMA(T, buf) do { const char* tb_ = kbase + (size_t)MLA_TROW(T) * (UW * 2); _Pragma("unroll") for (int i = 0; i < 6; ++i) if (wid * 6 + i < 41) \
        __builtin_amdgcn_global_load_lds((const unsigned*)(tb_ + dvo[i]), (LAS unsigned*)(lds + (buf) * STAGE + (wid * 6 + i) * 1024), 16, 0, 0); } while (0)
    MLA_DMA(0, 0); MLA_DMA(1, 1);
    asm volatile("s_waitcnt vmcnt(0)" ::: "memory");
    __syncthreads();
    const int q4 = (lane & 15) >> 2, p4 = lane & 3, blk = (lane >> 4) & 1;
    const int koff = l32 * KSTR + (l32 >> 3) * 16 + 16 * hi;
    const int voff = (4 * hi + q4) * KSTR + 32 * blk + 8 * p4;
    f32x16 sa0, sa1, sb0, sb1;
    u32x4 pw00, pw01, pw10, pw11;
    float mxn;
#define MLA_QKEXP(SD0, SD1, PA0, PA1, KOFF, DOEXP) do { \
        _Pragma("unroll") for (int r = 0; r < 16; ++r) { SD0[r] = 0.f; SD1[r] = 0.f; } \
        float rs = 0.f; \
        LAS const unsigned char* kp = lds + (KOFF) + koff; \
        bf16x8 ka0 = *(LAS const bf16x8*)(kp), ka1 = *(LAS const bf16x8*)(kp + KB1); \
        _Pragma("unroll") for (int ks = 0; ks < NKS; ++ks) { \
            bf16x8 kb0 = ka0, kb1 = ka1; \
            if (ks + 1 < NKS) { kb0 = *(LAS const bf16x8*)(kp + (ks + 1) * 32); kb1 = *(LAS const bf16x8*)(kp + (ks + 1) * 32 + KB1); } \
            SD0 = __builtin_amdgcn_mfma_f32_32x32x16_bf16(ka0, qf[ks], SD0, 0, 0, 0); \
            SD1 = __builtin_amdgcn_mfma_f32_32x32x16_bf16(ka1, qf[ks], SD1, 0, 0, 0); \
            if (DOEXP) { \
                if (ks < 4) { _Pragma("unroll") for (int j = 0; j < 4; ++j) { const float p = fexp2(PA0[4 * ks + j] - mref); PA0[4 * ks + j] = p; rs += p; } } \
                else if (ks < 8) { _Pragma("unroll") for (int j = 0; j < 4; ++j) { const float p = fexp2(PA1[4 * (ks - 4) + j] - mref); PA1[4 * (ks - 4) + j] = p; rs += p; } } \
                else if (ks == 8) { pw00 = (u32x4){cvtpk(PA0[0], PA0[1]), cvtpk(PA0[2], PA0[3]), cvtpk(PA0[4], PA0[5]), cvtpk(PA0[6], PA0[7])}; \
                                    pw01 = (u32x4){cvtpk(PA0[8], PA0[9]), cvtpk(PA0[10], PA0[11]), cvtpk(PA0[12], PA0[13]), cvtpk(PA0[14], PA0[15])}; } \
                else { pw10 = (u32x4){cvtpk(PA1[0], PA1[1]), cvtpk(PA1[2], PA1[3]), cvtpk(PA1[4], PA1[5]), cvtpk(PA1[6], PA1[7])}; \
                       pw11 = (u32x4){cvtpk(PA1[8], PA1[9]), cvtpk(PA1[10], PA1[11]), cvtpk(PA1[12], PA1[13]), cvtpk(PA1[14], PA1[15])}; } } \
            __builtin_amdgcn_sched_barrier(0); \
            ka0 = kb0; ka1 = kb1; } \
        lrun += rs; } while (0)
#define MLA_PV(VOFF, M0, M1) do { \
        LAS const unsigned char* vp = lds + (VOFF) + voff; \
        s16x4 vl[16], vh[16]; float mxa, mxb; \
        _Pragma("unroll") for (int it = 0; it < 16; ++it) { const int c = it >> 2, kb = (it >> 1) & 1, s_ = it & 1; \
            vl[it] = vtr(vp + (32 * kb + 16 * s_) * KSTR + 16 * (4 * kb + 2 * s_) + c * 64); vh[it] = vtr(vp + (32 * kb + 16 * s_ + 8) * KSTR + 16 * (4 * kb + 2 * s_ + 1) + c * 64); } \
        _Pragma("unroll") for (int it = 0; it < 16; ++it) { const int c = it >> 2, kb = (it >> 1) & 1, s_ = it & 1; \
            const bf16x8 vf = (bf16x8){vl[it][0], vl[it][1], vl[it][2], vl[it][3], vh[it][0], vh[it][1], vh[it][2], vh[it][3]}; \
            const u32x4 pwv = kb == 0 ? (s_ == 0 ? pw00 : pw01) : (s_ == 0 ? pw10 : pw11); \
            o[c] = __builtin_amdgcn_mfma_f32_32x32x16_bf16(vf, __builtin_bit_cast(bf16x8, pwv), o[c], 0, 0, 0); \
            if (it == 0) { mxa = M0[0]; mxb = M1[0]; } else { mxa = fmaxf(mxa, M0[it]); mxb = fmaxf(mxb, M1[it]); } } \
        mxn = xhalf_max(fmaxf(mxa, mxb)); } while (0)
#define MLA_RESCALE() do { if (__any(mxn > mref + THR)) { const float mnew = fmaxf(mref, mxn), alpha = fexp2(mref - mnew); mref = mnew; lrun *= alpha; \
        _Pragma("unroll") for (int c = 0; c < 4; ++c) _Pragma("unroll") for (int r = 0; r < 16; ++r) o[c][r] *= alpha; } __builtin_amdgcn_sched_barrier(0); } while (0)
    MLA_QKEXP(sa0, sa1, sa0, sa1, 0, false);
    { float a_ = fmaxf(sa0[0], sa1[0]);
#pragma unroll
      for (int r = 1; r < 16; ++r) a_ = fmaxf(a_, fmaxf(sa0[r], sa1[r]));
      mxn = xhalf_max(a_); }
    int bcur = 0;
    for (int T = 0; T < nmac; ++T) {
        const int bnxt = bcur == 2 ? 0 : bcur + 1, bnn = bnxt == 2 ? 0 : bnxt + 1;
        if (T + 2 < nmac) MLA_DMA(T + 2, bnn);
        MLA_RESCALE();
        MLA_QKEXP(sb0, sb1, sa0, sa1, bcur * STAGE + HALFB, true);
        MLA_PV(bcur * STAGE, sb0, sb1);
        MLA_RESCALE();
        MLA_QKEXP(sa0, sa1, sb0, sb1, bnxt * STAGE, true);
        MLA_PV(bcur * STAGE + HALFB, sa0, sa1);
        asm volatile("s_waitcnt vmcnt(0)" ::: "memory");
        __syncthreads();
        bcur = bnxt;
    }
    lrun = xhalf_sum(lrun);
    const float inv = 1.f / lrun;
    bf16_t* yp = y + (size_t)(qrow0 + qtok) * YW + 768 + head * 128 + 4 * hi;
#pragma unroll
    for (int c = 0; c < 4; ++c)
#pragma unroll
        for (int g = 0; g < 4; ++g) { u32x2 w; w.x = cvtpk(o[c][4 * g] * inv, o[c][4 * g + 1] * inv); w.y = cvtpk(o[c][4 * g + 2] * inv, o[c][4 * g + 3] * inv); *(u32x2*)(yp + 32 * c + 8 * g) = w; }
#undef MLA_TROW
#undef MLA_DMA
#undef MLA_QKEXP
#undef MLA_PV
#undef MLA_RESCALE
}

#define XB_TMO      128
#define XB_XCNT(j)  (256  + 64 * (j))
#define XB_XSUB(j)  (1280 + 64 * (j))
#define XB_XGEN(j)  (2304 + 64 * (j))
#define XB_TOP      3328
#define XB_TOPGEN   3392
#define XCD_BAR_WORDS 3456
#define XB_SPIN_CAP (1u << 18)
__device__ __forceinline__ unsigned xb_ld(unsigned* p)              { return __hip_atomic_load(p, __ATOMIC_RELAXED, __HIP_MEMORY_SCOPE_AGENT); }
__device__ __forceinline__ unsigned xb_add(unsigned* p, unsigned v) { return __hip_atomic_fetch_add(p, v, __ATOMIC_RELAXED, __HIP_MEMORY_SCOPE_AGENT); }
__device__ __forceinline__ unsigned xb_xcc_id() { return (unsigned)__builtin_amdgcn_s_getreg((3 << 11) | 20) & 0xFu; }
#define XB_SPIN(cond, bar) do { unsigned _sp = 0; while (cond) { __builtin_amdgcn_s_sleep(1); \
    if ((++_sp & 255u) == 0u) { if (xb_ld(&(bar)[XB_TMO])) break; if (_sp > XB_SPIN_CAP) { atomicAdd(&(bar)[XB_TMO], 1u); break; } } } } while (0)
struct XcdBarrier { unsigned* bar; unsigned x; volatile LAS unsigned* st; };
__device__ __forceinline__ XcdBarrier xcd_barrier_post(unsigned* bar, volatile LAS unsigned* st) {
    XcdBarrier b; b.bar = bar; b.x = xb_xcc_id(); b.st = st;
    if (threadIdx.x == 0) (void)xb_add(&bar[XB_XCNT(b.x)], 1u);
    return b;
}
__device__ __forceinline__ void xcd_barrier_complete(unsigned* bar, unsigned x, unsigned& nloc, unsigned& nx) {
    const unsigned G = gridDim.x * gridDim.y * gridDim.z;
    unsigned sum, cnt, mine, sp = 0u;
    for (;;) {
        sum = 0u; cnt = 0u; mine = 0u;
#pragma unroll
        for (unsigned j = 0; j < 16; ++j) { const unsigned c = xb_ld(&bar[XB_XCNT(j)]); sum += c; cnt += (c > 0u) ? 1u : 0u; mine = (j == x) ? c : mine; }
        if (sum == G) break;
        __builtin_amdgcn_s_sleep(1);
        if ((++sp & 255u) == 0u) { if (xb_ld(&bar[XB_TMO])) break; if (sp > XB_SPIN_CAP) { atomicAdd(&bar[XB_TMO], 1u); break; } }
    }
    nloc = mine > 0u ? mine : 1u; nx = cnt > 0u ? cnt : 1u;
}
__device__ __forceinline__ void xcd_barrier(const XcdBarrier& b) {
    asm volatile("s_waitcnt vmcnt(0)" ::: "memory");
    __syncthreads();
    if (threadIdx.x == 0) {
        unsigned* bar = b.bar; asm volatile("" : "+s"(bar));
        __builtin_amdgcn_s_waitcnt(0);
        unsigned nloc = b.st[0], nx = b.st[1];
        if (nloc == 0u) { xcd_barrier_complete(bar, b.x, nloc, nx); b.st[0] = nloc; b.st[1] = nx; }
        const unsigned old = xb_add(&bar[XB_XSUB(b.x)], 1u);
        const unsigned gen = old / nloc;
        if (old + 1u == (gen + 1u) * nloc) {
            __builtin_amdgcn_fence(__ATOMIC_RELEASE, "agent");
            asm volatile("s_waitcnt vmcnt(0)" ::: "memory");
            const unsigned og = xb_add(&bar[XB_TOP], 1u);
            const unsigned tg = og / nx;
            if (og + 1u == (tg + 1u) * nx) xb_add(&bar[XB_TOPGEN], 1u);
            else XB_SPIN(xb_ld(&bar[XB_TOPGEN]) == tg, bar);
            __builtin_amdgcn_fence(__ATOMIC_ACQUIRE, "agent");
            xb_add(&bar[XB_XGEN(b.x)], 1u);
            asm volatile("s_waitcnt vmcnt(0)" ::: "memory");
        } else {
            XB_SPIN(xb_ld(&bar[XB_XGEN(b.x)]) == gen, bar);
            __builtin_amdgcn_fence(__ATOMIC_ACQUIRE, "agent");
            asm volatile("s_waitcnt vmcnt(0)" ::: "memory");
        }
    }
    __syncthreads();
}

struct Args { const float* in[24]; float* out; unsigned char* ws; };
typedef __attribute__((address_space(4))) const Args CArgs;
__device__ __forceinline__ int fresh_sgpr(int v) { asm volatile("" : "+s"(v)); return v; }
__device__ __forceinline__ CArgs* fresh_args() { CArgs* p = (CArgs*)__builtin_amdgcn_kernarg_segment_ptr(); asm volatile("" : "+s"(p)); return p; }
enum { I_X = 0, I_C, I_CTX, I_CCTX, I_ADAW, I_ADAB, I_N1G, I_N2G, I_WIN, I_POOLW, I_POOLS, I_RPB, I_SINK, I_QNORM, I_KVNORM, I_WUQ, I_WUK, I_WUV, I_WBR, I_WOUT, I_W1, I_W3, I_W2, I_FNG };

__device__ __forceinline__ int rowmap(int mode, int n) {
    if (mode == 0) return n;
    if (mode == 1) { const int i = n >> 10, col = n & 1023, pn = col >> 6, cc = col & 63, wc = cc >> 4, fq = (cc >> 2) & 3, j = cc & 3; return 256 * pn + 128 * (i >> 1) + 32 * wc + 16 * (i & 1) + 4 * fq + j; }
    const int r = 256 * (n >> 7) + (n & 127); return mode == 2 ? r : r + 128;
}
__device__ __forceinline__ void tr_item(const float* __restrict__ W, int ldw, bf16_t* __restrict__ WT, int ldt, int nblk, int mode, LAS float* scr, int item, int lane, bool qscale = false) {
    const int kb = item / nblk, nb = item % nblk, k0 = 64 * kb, n0 = 32 * nb;
    float tv[32];
#pragma unroll
    for (int i = 0; i < 32; ++i) tv[i] = W[(size_t)(k0 + 2 * i + (lane >> 5)) * ldw + n0 + (lane & 31)];
#pragma unroll
    for (int i = 0; i < 32; ++i) scr[(2 * i + (lane >> 5)) * 33 + (lane & 31)] = tv[i];
    asm volatile("s_waitcnt lgkmcnt(0)" ::: "memory");
    const int c = lane & 7;
#pragma unroll
    for (int j = 0; j < 4; ++j) { const int n = (lane >> 3) + 8 * j; const LAS float* s = scr + (8 * c) * 33 + n;
        const float qs = (qscale && n0 + n >= U_NAQ && n0 + n < U_CQ) ? QSC64 : 1.f;
        u32x4 o; o.x = cvtpk(s[0 * 33] * qs, s[1 * 33] * qs); o.y = cvtpk(s[2 * 33] * qs, s[3 * 33] * qs); o.z = cvtpk(s[4 * 33] * qs, s[5 * 33] * qs); o.w = cvtpk(s[6 * 33] * qs, s[7 * 33] * qs);
        *(u32x4*)(WT + (size_t)rowmap(mode, n0 + n) * ldt + k0 + 8 * c) = o; }
    asm volatile("s_waitcnt lgkmcnt(0)" ::: "memory");
}

__global__ void __launch_bounds__(NTHREADS) mk_fwd(Args args) {
    extern __shared__ __attribute__((aligned(16))) unsigned char lds_raw[];
    LAS unsigned char* lds = (LAS unsigned char*)lds_raw;
    cg::grid_group grid = cg::this_grid();
    const int wid = __builtin_amdgcn_readfirstlane(threadIdx.x >> 6);
    const int bx = blockIdx.x;
    unsigned* barw = (unsigned*)args.ws;
    volatile LAS unsigned* bst = (volatile LAS unsigned*)(lds + LDS_BYTES - 16);
    if (threadIdx.x == 0) { bst[0] = 0u; bst[1] = 0u; }
    __syncthreads();
    if (gridDim.x == 0x7fffffffu) grid.sync();
    XcdBarrier xbar = xcd_barrier_post(barw, bst);
#define PH_BEGIN { const int tid = fresh_tid(); const int lane = tid & 63; (void)tid; (void)lane; CArgs* ap = fresh_args(); const int bx = fresh_sgpr((int)blockIdx.x); const int G = fresh_sgpr((int)gridDim.x); const int gw = bx * 8 + wid, NGW = G * 8; (void)gw; (void)NGW; unsigned char* ws = ap->ws; float* out = ap->out; \
    float* mod = (float*)(ws + WS_MOD); float* xc = (float*)(ws + WS_XC); bf16_t* Hb = (bf16_t*)(ws + WS_H); bf16_t* Yb = (bf16_t*)(ws + WS_Y); bf16_t* Ub = (bf16_t*)(ws + WS_R4); \
    bf16_t* Qm = (bf16_t*)(ws + WS_QM); bf16_t* Yall = (bf16_t*)(ws + WS_R4); bf16_t* Hid = (bf16_t*)(ws + WS_R4); bf16_t* Mg = (bf16_t*)(ws + WS_Y); \
    (void)mod; (void)xc; (void)Hb; (void)Yb; (void)Ub; (void)Qm; (void)Yall; (void)Hid; (void)Mg; (void)out;
#define PH_LAYER unsigned char* wl = ws + WS_W + (size_t)l * WL; const float* modl = mod + (size_t)l * 3 * 6144; const float* xres = l == 0 ? ap->in[I_X] : out; const float* cres = l == 0 ? ap->in[I_CTX] : xc; \
    const int Mq = l == 0 ? MT : NLAT; (void)wl; (void)modl; (void)xres; (void)cres; (void)Mq;
#define PH_END   xcd_barrier(xbar); }
#define PH_END0  xcd_barrier(xbar); }
#define PH_ENDL  }

    PH_BEGIN
    {
        LAS float* scr = (LAS float*)(lds + wid * 16384);
        constexpr int T_U = 976, T_G = 2048, T_B = 128, T_O = 512, T_1 = 1408, T_2 = 1408;
        constexpr int LTOT = T_U + T_G + 2 * T_B + T_O + 2 * T_1 + T_2;
        for (int it = gw; it < DEPTH * LTOT; it += NGW) {
            const int l = it / LTOT; int r = it % LTOT;
            unsigned char* wl = ws + WS_W + (size_t)l * WL;
            const float* win = ap->in[I_WIN] + (size_t)l * D * INC;
            if (r < T_U) { tr_item(win, INC, (bf16_t*)(wl + W_U), D, 61, 0, scr, r, lane, true); continue; } r -= T_U;
            if (r < T_G) { tr_item(win + U_END, INC, (bf16_t*)(wl + W_G), D, 128, 1, scr, r, lane); continue; } r -= T_G;
            if (r < T_B) { tr_item(ap->in[I_WBR] + ((size_t)l * 4 + 1) * 256 * D, D, (bf16_t*)(wl + W_B) + (size_t)1 * 1024 * 512, 512, 32, 0, scr, r, lane); continue; } r -= T_B;
            if (r < T_B) { tr_item(ap->in[I_WBR] + ((size_t)l * 4 + 2) * 256 * D, D, (bf16_t*)(wl + W_B) + (size_t)2 * 1024 * 512, 512, 32, 0, scr, r, lane); continue; } r -= T_B;
            if (r < T_O) { tr_item(ap->in[I_WOUT] + (size_t)l * D * D, D, (bf16_t*)(wl + W_O), D, 32, 0, scr, r, lane); continue; } r -= T_O;
            if (r < T_1) { tr_item(ap->in[I_W1] + (size_t)l * D * FF, FF, (bf16_t*)(wl + W_13), D, 88, 2, scr, r, lane); continue; } r -= T_1;
            if (r < T_1) { tr_item(ap->in[I_W3] + (size_t)l * D * FF, FF, (bf16_t*)(wl + W_13), D, 88, 3, scr, r, lane); continue; } r -= T_1;
            tr_item(ap->in[I_W2] + (size_t)l * FF * D, D, (bf16_t*)(wl + W_2), FF, 32, 0, scr, r, lane);
        }
        constexpr int F_Q = 640 * 256, F_3 = 512 * 256, F_0 = 256 * 256, FTOT = F_Q + F_3 + F_0;
        for (int it = bx * NTHREADS + tid; it < DEPTH * FTOT; it += G * NTHREADS) {
            const int l = it / FTOT; int r = it % FTOT;
            unsigned char* wl = ws + WS_W + (size_t)l * WL;
            if (r < F_Q) {
                const int k = r / 640, n = r % 640, h = n / 160, c = n % 160;
                const float* uq = ap->in[I_WUQ] + (size_t)l * 256 * 384 + (size_t)k * 384 + h * 96;
                float s;
                if (c < 128) { const float* uk = ap->in[I_WUK] + (size_t)l * 128 * 256 + (size_t)c * 256 + h * 64; f32x4 a4 = {0.f, 0.f, 0.f, 0.f};
#pragma unroll
                    for (int d = 0; d < 64; d += 4) a4 += *(const f32x4*)(uq + d) * *(const f32x4*)(uk + d);
                    s = (a4[0] + a4[1]) + (a4[2] + a4[3]); }
                else s = uq[64 + (c - 128)];
                ((bf16_t*)(wl + W_QF))[(size_t)n * 256 + k] = f2bf(s * QSCMLA);
            } else if (r < F_Q + F_3) {
                r -= F_Q; const int k = r / 256, n = (r % 256) * 4, h = k / 128, c = k % 128;
                const float* uv = ap->in[I_WUV] + (size_t)l * 128 * 256 + (size_t)c * 256 + h * 64;
                const float* wb = ap->in[I_WBR] + ((size_t)l * 4 + 3) * 256 * D + (size_t)(h * 64) * D + n;
                f32x4 a4 = {0.f, 0.f, 0.f, 0.f};
#pragma unroll 16
                for (int d = 0; d < 64; ++d) a4 += *(const f32x4*)(wb + (size_t)d * D) * uv[d];
                bf16_t* dst = (bf16_t*)(wl + W_B) + (size_t)3 * 1024 * 512 + (size_t)n * 512 + k;
                dst[0] = f2bf(a4[0]); dst[512] = f2bf(a4[1]); dst[1024] = f2bf(a4[2]); dst[1536] = f2bf(a4[3]);
            } else {
                r -= F_Q + F_3; const int k = r / 256, n = (r % 256) * 4, g = k / 64, c = k % 64;
                const float* pw = ap->in[I_POOLW] + (size_t)l * 4 * 64 * 64 + (size_t)g * 4096 + c * 64;
                const float* ps = ap->in[I_POOLS] + (size_t)l * 256 + g * 64;
                const float* wb = ap->in[I_WBR] + ((size_t)l * 4 + 0) * 256 * D + (size_t)(g * 64) * D + n;
                f32x4 a4 = {0.f, 0.f, 0.f, 0.f};
#pragma unroll 16
                for (int d = 0; d < 64; ++d) a4 += *(const f32x4*)(wb + (size_t)d * D) * (pw[d] * ps[d]);
                bf16_t* dst = (bf16_t*)(wl + W_B) + (size_t)n * 512 + k;
                dst[0] = f2bf(a4[0]); dst[512] = f2bf(a4[1]); dst[1024] = f2bf(a4[2]); dst[1536] = f2bf(a4[3]);
            }
        }
        __syncthreads();
        LAS float* sc = (LAS float*)lds;
        LAS float* red = sc + 3072;
        for (int i = tid; i < 3072; i += NTHREADS) { const int v = i >> 10, k = i & 1023; const float cv = v < 2 ? ap->in[I_C][v * D + k] : ap->in[I_CCTX][k]; sc[i] = cv / (1.f + expf(-cv)); }
        __syncthreads();
        for (int it = bx; it < DEPTH * 96; it += G) {
            const int l = it / 96, cgp = it % 96, col = cgp * 64 + lane;
            const float* aw = ap->in[I_ADAW] + (size_t)l * D * 6144 + col;
            float a0 = 0.f, a1 = 0.f, a2 = 0.f;
#pragma unroll 1
            for (int k0 = wid * 128; k0 < wid * 128 + 128; k0 += 32) { float wv[32];
#pragma unroll
                for (int j = 0; j < 32; ++j) wv[j] = aw[(size_t)(k0 + j) * 6144];
#pragma unroll
                for (int j = 0; j < 32; ++j) { a0 += sc[k0 + j] * wv[j]; a1 += sc[1024 + k0 + j] * wv[j]; a2 += sc[2048 + k0 + j] * wv[j]; } }
            red[(wid * 3 + 0) * 64 + lane] = a0; red[(wid * 3 + 1) * 64 + lane] = a1; red[(wid * 3 + 2) * 64 + lane] = a2;
            __syncthreads();
            if (tid < 192) { const int v = tid >> 6, ln = tid & 63; float s = 0.f;
#pragma unroll
                for (int w = 0; w < 8; ++w) s += red[(w * 3 + v) * 64 + ln];
                const int colo = cgp * 64 + ln; mod[(l * 3 + v) * 6144 + colo] = s + ap->in[I_ADAB][l * 6144 + colo]; }
            __syncthreads();
        }
    }
    PH_END0

    for (int l = 0; l < DEPTH; ++l) {

#define NORM_PHASE(XL, XC, GAMMA, SHC, SCC, LB) \
        for (int r0 = gw * 4; r0 < MT; r0 += NGW * 4) { \
            const float* src = r0 < NLAT ? (XL) + (size_t)r0 * D : (XC) + (size_t)(r0 - NLAT) * D; \
            const int v = r0 < NLAT ? r0 / SEQ : 2; const float* mv = modl + v * 6144; \
            f32x4 xv[4][4]; float ss[4]; \
            if ((LB) && r0 < NLAT) { const bf16_t* sb_ = (const bf16_t*)out + (size_t)r0 * 2048 + 1024; \
                _Pragma("unroll") for (int rr = 0; rr < 4; ++rr) _Pragma("unroll") for (int j = 0; j < 4; ++j) { const u32x2 w_ = *(const u32x2*)(sb_ + rr * 2048 + lane * 4 + 256 * j); xv[rr][j] = (f32x4){bflo(w_.x), bfhi(w_.x), bflo(w_.y), bfhi(w_.y)}; } } \
            else { _Pragma("unroll") for (int rr = 0; rr < 4; ++rr) _Pragma("unroll") for (int j = 0; j < 4; ++j) xv[rr][j] = *(const f32x4*)(src + rr * D + lane * 4 + 256 * j); } \
            _Pragma("unroll") for (int rr = 0; rr < 4; ++rr) { float a_ = 0.f; _Pragma("unroll") for (int j = 0; j < 4; ++j) a_ += xv[rr][j][0] * xv[rr][j][0] + xv[rr][j][1] * xv[rr][j][1] + xv[rr][j][2] * xv[rr][j][2] + xv[rr][j][3] * xv[rr][j][3]; ss[rr] = a_; } \
            _Pragma("unroll") for (int o_ = 1; o_ < 64; o_ <<= 1) _Pragma("unroll") for (int rr = 0; rr < 4; ++rr) ss[rr] += __uint_as_float((unsigned)__builtin_amdgcn_ds_bpermute((lane ^ o_) << 2, (int)__float_as_uint(ss[rr]))); \
            _Pragma("unroll") for (int rr = 0; rr < 4; ++rr) ss[rr] = rsqrtf(ss[rr] * (1.f / D) + EPSV); \
            _Pragma("unroll") for (int j = 0; j < 4; ++j) { const int c0 = lane * 4 + 256 * j; const f32x4 g = *(const f32x4*)((GAMMA) + c0), sh = *(const f32x4*)(mv + (SHC) * D + c0), sc = *(const f32x4*)(mv + (SCC) * D + c0); \
                const f32x4 gs = g * (sc + 1.f); \
                _Pragma("unroll") for (int rr = 0; rr < 4; ++rr) { const f32x4 yv = xv[rr][j] * ss[rr] * gs + sh; u32x2 w; w.x = cvtpk(yv[0], yv[1]); w.y = cvtpk(yv[2], yv[3]); *(u32x2*)(Hb + (size_t)(r0 + rr) * D + c0) = w; } } \
        }
        PH_BEGIN PH_LAYER
        NORM_PHASE(ap->in[I_X], cres, ap->in[I_N1G] + l * D, 0, 1, l != 0)
        PH_END

        PH_BEGIN PH_LAYER
        { pg8::SchedPlain S; S.so.init(MT, UW, G, bx); S.A = (const char*)Hb; S.B = (const char*)(wl + W_U); S.a_t = (size_t)256 * D * 2; S.b_t = (size_t)256 * D * 2; S.nt = D / 64;
          EpiStore E{Ub, UW}; pg8::gemm_phase(lds, D * 2, D * 2, S, E); }
        PH_END

        PH_BEGIN PH_LAYER
        {
            const float* qng = ap->in[I_QNORM] + l * 256; const float* kvg = ap->in[I_KVNORM] + l * 128;
            const f32x4 gq = *(const f32x4*)(qng + lane * 4); const float gk0 = kvg[lane * 2], gk1 = kvg[lane * 2 + 1];
            const int si = 2 * (lane & 15);
            const float sf0 = exp2f(-(float)(si & 15) * 0.8304820237218406f), sf1 = exp2f(-(float)((si + 1) & 15) * 0.8304820237218406f);
            const int ki = 2 * (lane & 7);
            const float kf0 = exp2f(-(float)(ki & 7) * 1.6609640474436813f), kf1 = exp2f(-(float)((ki + 1) & 7) * 1.6609640474436813f);
            const int pg = lane >> 4, pw_ = 2 << pg;
#define P2B_DECL(S) bf16_t* ur##S; int tloc##S, nseq##S, base##S; bool lat##S; u32x2 cq##S, ps##S, nb##S[16]; unsigned ckv##S, q1##S, q2##S, k1##S = 0, k2##S = 0, r1##S = 0, r2##S = 0;
#define P2B_LOAD(S, ROW) do { const int row_ = (ROW); ur##S = Ub + (size_t)row_ * UW; lat##S = row_ < NLAT; \
                if (lat##S) { tloc##S = row_ & (SEQ - 1); nseq##S = SEQ; } else { tloc##S = (row_ - NLAT) & (CTXL - 1); nseq##S = CTXL; } base##S = row_ - tloc##S; \
                cq##S = *(const u32x2*)(ur##S + U_CQ + lane * 4); ckv##S = *(const unsigned*)(ur##S + U_CKV + lane * 2); ps##S = *(const u32x2*)(ur##S + U_POOL + lane * 4); \
                q1##S = *(const unsigned*)(ur##S + U_SWQ + (lane >> 4) * 64 + si); q2##S = *(const unsigned*)(ur##S + U_SWQ + (lane >> 4) * 64 + 32 + si); \
                if (lat##S) { if (lane < 32) { k1##S = *(const unsigned*)(ur##S + U_SWK + (lane >> 4) * 64 + si); k2##S = *(const unsigned*)(ur##S + U_SWK + (lane >> 4) * 64 + 32 + si); } \
                              if (lane < 8) { r1##S = *(const unsigned*)(ur##S + U_KR + ki); r2##S = *(const unsigned*)(ur##S + U_KR + 16 + ki); } } \
                _Pragma("unroll") for (int i = 0; i < 16; ++i) { const int t_ = min(max(tloc##S - 8 + i, 0), nseq##S - 1); nb##S[i] = *(const u32x2*)(Ub + (size_t)(base##S + t_) * UW + U_POOL + lane * 4); } } while (0)
#define P2B_PROC(S, ROW) do { const int row_ = (ROW); const float prow = (float)(tloc##S >> 6), pcol = (float)(tloc##S & 63); \
                { float a = bflo(cq##S.x), b = bfhi(cq##S.x), c = bflo(cq##S.y), d = bfhi(cq##S.y); float sq = a * a + b * b + c * c + d * d; float a2 = bflo(ckv##S), b2 = bfhi(ckv##S); float sk = a2 * a2 + b2 * b2; \
                  _Pragma("unroll") for (int o_ = 1; o_ < 64; o_ <<= 1) { sq += __uint_as_float((unsigned)__builtin_amdgcn_ds_bpermute((lane ^ o_) << 2, (int)__float_as_uint(sq))); sk += __uint_as_float((unsigned)__builtin_amdgcn_ds_bpermute((lane ^ o_) << 2, (int)__float_as_uint(sk))); } \
                  const float rq = rsqrtf(sq * (1.f / 256.f) + EPSV), rk = rsqrtf(sk * (1.f / 128.f) + EPSV); u32x2 w; w.x = cvtpk(a * rq * gq[0], b * rq * gq[1]); w.y = cvtpk(c * rq * gq[2], d * rq * gq[3]); \
                  *(u32x2*)(ur##S + U_CQ + lane * 4) = w; *(unsigned*)(ur##S + U_CKV + lane * 2) = cvtpk(a2 * rk * gk0, b2 * rk * gk1); } \
                if (lat##S) { const float ps_ = si < 16 ? prow : pcol; const float a0 = ps_ * sf0, a1 = ps_ * sf1; const float c0 = __cosf(a0), s0 = __sinf(a0), c1 = __cosf(a1), s1 = __sinf(a1); \
                  { const float x1a = bflo(q1##S), x1b = bfhi(q1##S), x2a = bflo(q2##S), x2b = bfhi(q2##S); \
                    *(unsigned*)(ur##S + U_SWQ + (lane >> 4) * 64 + si) = cvtpk(x1a * c0 - x2a * s0, x1b * c1 - x2b * s1); *(unsigned*)(ur##S + U_SWQ + (lane >> 4) * 64 + 32 + si) = cvtpk(x2a * c0 + x1a * s0, x2b * c1 + x1b * s1); } \
                  if (lane < 32) { const float x1a = bflo(k1##S), x1b = bfhi(k1##S), x2a = bflo(k2##S), x2b = bfhi(k2##S); \
                    *(unsigned*)(ur##S + U_SWK + (lane >> 4) * 64 + si) = cvtpk(x1a * c0 - x2a * s0, x1b * c1 - x2b * s1); *(unsigned*)(ur##S + U_SWK + (lane >> 4) * 64 + 32 + si) = cvtpk(x2a * c0 + x1a * s0, x2b * c1 + x1b * s1); } \
                  if (lane < 8) { const float pk_ = ki < 8 ? prow : pcol; const float b0 = pk_ * kf0, b1 = pk_ * kf1; const float d0 = __cosf(b0), e0 = __sinf(b0), d1 = __cosf(b1), e1 = __sinf(b1); \
                    const float x1a = bflo(r1##S), x1b = bfhi(r1##S), x2a = bflo(r2##S), x2b = bfhi(r2##S); \
                    *(unsigned*)(ur##S + U_KR + ki) = cvtpk(x1a * d0 - x2a * e0, x1b * d1 - x2b * e1); *(unsigned*)(ur##S + U_KR + 16 + ki) = cvtpk(x2a * d0 + x1a * e0, x2b * d1 + x1b * e1); } } \
                { const int plo = max(tloc##S - (pw_ >> 1), 0), phi = min(tloc##S - (pw_ >> 1) + pw_, nseq##S); f32x4 s_ = {0.f, 0.f, 0.f, 0.f}; \
                  _Pragma("unroll") for (int i = 0; i < 16; ++i) { const int t_ = tloc##S - 8 + i; const float wt = (t_ >= plo && t_ < phi) ? 1.f : 0.f; \
                      s_[0] += wt * bflo(nb##S[i].x); s_[1] += wt * bfhi(nb##S[i].x); s_[2] += wt * bflo(nb##S[i].y); s_[3] += wt * bfhi(nb##S[i].y); } \
                  const float ic = 1.f / (float)(phi - plo); u32x2 o_; o_.x = cvtpk(s_[0] * ic - bflo(ps##S.x), s_[1] * ic - bfhi(ps##S.x)); o_.y = cvtpk(s_[2] * ic - bflo(ps##S.y), s_[3] * ic - bfhi(ps##S.y)); \
                  *(u32x2*)(Yb + (size_t)row_ * YW + lane * 4) = o_; } } while (0)
            P2B_DECL(A) P2B_DECL(B)
            for (int row = gw * 2; row < MT; row += NGW * 2) {
                P2B_LOAD(A, row); P2B_LOAD(B, row + 1);
                P2B_PROC(A, row); P2B_PROC(B, row + 1);
            }
#undef P2B_DECL
#undef P2B_LOAD
#undef P2B_PROC
        }
        PH_END

        PH_BEGIN PH_LAYER
        { pg8::SchedPlain S; S.so.init(Mq, QW, G, bx); S.A = (const char*)(Ub + U_CQ); S.B = (const char*)(wl + W_QF); S.a_t = (size_t)256 * UW * 2; S.b_t = (size_t)256 * 256 * 2; S.nt = 4;
          EpiQRope E{Qm}; pg8::gemm_phase(lds, UW * 2, 256 * 2, S, E); }
        PH_END

        PH_BEGIN PH_LAYER
        {
            const float* rpb = ap->in[I_RPB] + (size_t)l * 4 * 15 * 31; const float* snk = ap->in[I_SINK] + l * 4;
            for (int i = bx; i < 512; i += G) { const int b = i >> 8, tb = i & 255;
                mla_unit(lds, Ub, Qm, Yb, b * SEQ + tb * 64, NLAT + b * CTXL, 256, b * SEQ); }
            for (int i = bx; i < 512; i += G) { const int b = i >> 8, r = i & 255, r0 = min(max(r - 4, 0), 248);
                attn_unit<1>(lds, Ub, Qm, Yb, rpb, snk, b * SEQ + r * 64, NLAT + b * CTXL, 8, b * SEQ + r0 * 64, r, r0, 0); }
            for (int i = bx; i < 512; i += G) { const int b = i >> 8, rem = i & 255, kvh = rem >> 7, n = rem & 127;
                const int jlo = n == 0 ? 2 : 0, jhi = n == 127 ? 4 : 6, kp0 = (n - 1) * 128 + 64 * jlo;
                attn_unit<2>(lds, Ub, Qm, Yb, rpb, snk, b * SEQ + n * 128, NLAT + b * CTXL, jhi - jlo, b * SEQ + kp0, n * 128, kp0, kvh); }
            if (l == 0) {
                for (int i = bx; i < 24; i += G) { const int kind = i >> 3, j = i & 7, b = j >> 2;
                    if (kind == 0) mla_unit(lds, Ub, Qm, Yb, NLAT + b * CTXL + 64 * (j & 3), NLAT + b * CTXL, 0, 0);
                    else if (kind == 1) attn_unit<1>(lds, Ub, Qm, Yb, rpb, snk, NLAT + b * CTXL + 64 * (j & 3), NLAT + b * CTXL, 0, 0, 0, 0, 0);
                    else attn_unit<2>(lds, Ub, Qm, Yb, rpb, snk, NLAT + b * CTXL + 128 * (j & 1), NLAT + b * CTXL, 0, 0, 0, 0, (j >> 1) & 1); }
            }
        }
        PH_END

        PH_BEGIN PH_LAYER
        { pg8::SchedBranch S; S.so.init(Mq, 4096, G, bx); S.A = (const char*)Yb; S.B = (const char*)(wl + W_B); S.a_t = (size_t)256 * YW * 2;
          EpiStore E{Yall, 4096}; pg8::gemm_phase(lds, YW * 2, 512 * 2, S, E); }
        PH_END

        PH_BEGIN PH_LAYER
        { pg8::SchedPlain S; S.so.init(Mq, 4096, G, bx); S.A = (const char*)Hb; S.B = (const char*)(wl + W_G); S.a_t = (size_t)256 * D * 2; S.b_t = (size_t)256 * D * 2; S.nt = D / 64;
          EpiMerge E{Yall, Mg}; pg8::gemm_phase(lds, D * 2, D * 2, S, E); }
        PH_END

        PH_BEGIN PH_LAYER
        { pg8::SchedPlain S; S.so.init(Mq, D, G, bx); S.A = (const char*)Mg; S.B = (const char*)(wl + W_O); S.a_t = (size_t)256 * D * 2; S.b_t = (size_t)256 * D * 2; S.nt = D / 64;
          EpiResid E{l == 0 ? ap->in[I_X] : nullptr, (bf16_t*)out, cres, xc, modl + 2 * D}; pg8::gemm_phase(lds, D * 2, D * 2, S, E); }
        PH_END

        PH_BEGIN PH_LAYER
        NORM_PHASE(out, xc, ap->in[I_N2G] + l * D, 3, 4, true)
        PH_END

        PH_BEGIN PH_LAYER
        { pg8::SchedPlain S; S.so.init(Mq, 2 * FF, G, bx); S.A = (const char*)Hb; S.B = (const char*)(wl + W_13); S.a_t = (size_t)256 * D * 2; S.b_t = (size_t)256 * D * 2; S.nt = D / 64;
          EpiSwiGLU E{Hid}; pg8::gemm_phase(lds, D * 2, D * 2, S, E); }
        PH_END

        PH_BEGIN PH_LAYER
        { pg8::SchedPlain S; S.so.init(Mq, D, G, bx); S.A = (const char*)Hid; S.B = (const char*)(wl + W_2); S.a_t = (size_t)256 * FF * 2; S.b_t = (size_t)256 * FF * 2; S.nt = FF / 64;
          EpiResid E{nullptr, (bf16_t*)out, xc, xc, modl + 5 * D}; pg8::gemm_phase(lds, FF * 2, FF * 2, S, E); }
        PH_END
    }

    PH_BEGIN
    {
        const float* fg = ap->in[I_FNG];
        for (int r0 = gw * 4; r0 < NLAT; r0 += NGW * 4) {
            float* src = out + (size_t)r0 * D; f32x4 xv[4][4]; float ss[4];
            const bf16_t* sb_ = (const bf16_t*)out + (size_t)r0 * 2048 + 1024;
#pragma unroll
            for (int rr = 0; rr < 4; ++rr)
#pragma unroll
                for (int j = 0; j < 4; ++j) { const u32x2 w_ = *(const u32x2*)(sb_ + rr * 2048 + lane * 4 + 256 * j); xv[rr][j] = (f32x4){bflo(w_.x), bfhi(w_.x), bflo(w_.y), bfhi(w_.y)}; }
            asm volatile("s_waitcnt vmcnt(0)" ::: "memory");
#pragma unroll
            for (int rr = 0; rr < 4; ++rr) { float a_ = 0.f;
#pragma unroll
                for (int j = 0; j < 4; ++j) a_ += xv[rr][j][0] * xv[rr][j][0] + xv[rr][j][1] * xv[rr][j][1] + xv[rr][j][2] * xv[rr][j][2] + xv[rr][j][3] * xv[rr][j][3];
                ss[rr] = a_; }
#pragma unroll
            for (int o_ = 1; o_ < 64; o_ <<= 1)
#pragma unroll
                for (int rr = 0; rr < 4; ++rr) ss[rr] += __uint_as_float((unsigned)__builtin_amdgcn_ds_bpermute((lane ^ o_) << 2, (int)__float_as_uint(ss[rr])));
#pragma unroll
            for (int rr = 0; rr < 4; ++rr) ss[rr] = rsqrtf(ss[rr] * (1.f / D) + EPSV);
#pragma unroll
            for (int j = 0; j < 4; ++j) { const f32x4 g = *(const f32x4*)(fg + lane * 4 + 256 * j);
#pragma unroll
                for (int rr = 0; rr < 4; ++rr) *(f32x4*)(src + rr * D + lane * 4 + 256 * j) = xv[rr][j] * ss[rr] * g; }
        }
    }
    PH_ENDL
}

extern "C" void kernel_launch(void* const* d_in, const int* in_sizes, int n_in, void* d_out, int out_size, void* d_ws, size_t ws_size, hipStream_t stream) {
    static int grid = 0;
    if (grid == 0) {
        if (n_in != 24 || out_size != NLAT * D || ws_size < WS_END) { fprintf(stderr, "kernel_launch: unexpected shapes (n_in %d out %d ws %zu)\n", n_in, out_size, ws_size); grid = -1; return; }
        int dev = 0, cus = 0, per_cu = 0;
        hipGetDevice(&dev);
        hipDeviceGetAttribute(&cus, hipDeviceAttributeMultiprocessorCount, dev);
        hipFuncSetAttribute((const void*)mk_fwd, hipFuncAttributeMaxDynamicSharedMemorySize, LDS_BYTES);
        hipOccupancyMaxActiveBlocksPerMultiprocessor(&per_cu, (const void*)mk_fwd, NTHREADS, LDS_BYTES);
        if (per_cu < 1) { fprintf(stderr, "kernel_launch: occupancy query returned %d\n", per_cu); per_cu = 1; }
        (void)hipGetLastError();
        grid = cus * per_cu;
    }
    if (grid < 0) return;
    Args a{};
    for (int i = 0; i < 24; ++i) a.in[i] = (const float*)d_in[i];
    a.out = (float*)d_out; a.ws = (unsigned char*)d_ws;
    if (hipMemsetAsync(d_ws, 0, XCD_BAR_WORDS * 4, stream) != hipSuccess) { fprintf(stderr, "memset of barrier words failed\n"); return; }
    void* kargs[] = {&a};
    hipError_t e = hipLaunchCooperativeKernel((const void*)mk_fwd, dim3(grid), dim3(NTHREADS), kargs, LDS_BYTES, stream);
    if (e != hipSuccess) fprintf(stderr, "cooperative launch failed: %s (grid %d)\n", hipGetErrorString(e), grid);
}
```

```cpp
#include <hip/hip_runtime.h>
#include <hip/hip_cooperative_groups.h>
#include <cstdio>
#include <cstdint>
namespace cg = cooperative_groups;

#define LAS __attribute__((address_space(3)))
typedef unsigned short bf16_t;
typedef short bf16x8 __attribute__((ext_vector_type(8)));
typedef short s16x4 __attribute__((ext_vector_type(4)));
typedef short v4i16_t __attribute__((ext_vector_type(4)));
typedef float f32x4 __attribute__((ext_vector_type(4)));
typedef float f32x16 __attribute__((ext_vector_type(16)));
typedef unsigned u32x4 __attribute__((ext_vector_type(4)));
typedef unsigned u32x2 __attribute__((ext_vector_type(2)));
typedef float f32x2_t __attribute__((ext_vector_type(2)));
typedef __bf16 bf16x2_t __attribute__((ext_vector_type(2)));

constexpr int D = 1024, NB = 2, SEQ = 16384, NLAT = NB * SEQ, CTXL = 256, NCTX = NB * CTXL, MT = NLAT + NCTX;
constexpr int INC = 6048, FF = 2816, DEPTH = 2;
constexpr int UW = 2048, QW = 768, YW = 1280;
constexpr int U_NAK = 0, U_NAV = 256, U_SWK = 512, U_SWV = 640, U_CKV = 768, U_KR = 896, U_NAQ = 928, U_SWQ = 1184, U_CQ = 1440, U_POOL = 1696, U_END = 1952;
constexpr float EPSV = 1e-6f;
constexpr float LOG2E = 1.4426950408889634f;
constexpr float QSC64 = 0.125f * LOG2E;
constexpr float QSCMLA = 0.10206207261596577f * LOG2E;

constexpr size_t MiB = 1u << 20;
constexpr size_t WS_MOD = 1 * MiB, WS_XC = 2 * MiB, WS_W = 8 * MiB, WS_H = 80 * MiB, WS_Y = 145 * MiB, WS_R4 = 227 * MiB, WS_QM = WS_R4 + 130 * MiB, WS_END = 487 * MiB;
constexpr size_t WL = 35 * MiB;
constexpr size_t W_U = 0, W_G = 4 * MiB, W_QF = 12 * MiB, W_B = 12 * MiB + 512 * 1024, W_O = 16 * MiB + 512 * 1024, W_13 = 18 * MiB + 512 * 1024, W_2 = 29 * MiB + 512 * 1024;

constexpr int NTHREADS = 512;
constexpr int LDS_BYTES = 147456;

__device__ __forceinline__ unsigned cvtpk(float lo, float hi) { f32x2_t v = {lo, hi}; bf16x2_t b = __builtin_convertvector(v, bf16x2_t); return __builtin_bit_cast(unsigned, b); }
__device__ __forceinline__ float bflo(unsigned w) { return __uint_as_float(w << 16); }
__device__ __forceinline__ float bfhi(unsigned w) { return __uint_as_float(w & 0xffff0000u); }
__device__ __forceinline__ float bf2f(bf16_t h) { return __uint_as_float(((unsigned)h) << 16); }
__device__ __forceinline__ bf16_t f2bf(float f) { return (bf16_t)(cvtpk(f, 0.f) & 0xffffu); }
__device__ __forceinline__ float wave_sum_l(float v, int lane) {
#pragma unroll
    for (int o = 1; o < 64; o <<= 1) v += __uint_as_float((unsigned)__builtin_amdgcn_ds_bpermute((lane ^ o) << 2, (int)__float_as_uint(v)));
    return v;
}
__device__ __forceinline__ float xhalf_max(float m) { auto rr = __builtin_amdgcn_permlane32_swap(__float_as_uint(m), __float_as_uint(m), false, false); return fmaxf(__uint_as_float(rr[0]), __uint_as_float(rr[1])); }
__device__ __forceinline__ float xhalf_sum(float m) { auto rr = __builtin_amdgcn_permlane32_swap(__float_as_uint(m), __float_as_uint(m), false, false); return __uint_as_float(rr[0]) + __uint_as_float(rr[1]); }
__device__ __forceinline__ int fresh_tid() { int t = threadIdx.x; asm volatile("" : "+v"(t)); return t; }
__device__ __forceinline__ float fexp2(float x) { return __builtin_amdgcn_exp2f(x); }
__device__ __forceinline__ float frcp(float x) { return __builtin_amdgcn_rcpf(x); }
__device__ __forceinline__ float sigmoidf_(float x) { return frcp(1.f + fexp2(-x * LOG2E)); }

namespace pg8 {
constexpr int BM = 256, BK = 64, HALF = 128, HTB = HALF * BK * 2, STAGE_BYTES = 8 * HTB, NXCD = 8, WGM = 8;
__device__ __forceinline__ int lds_byte(int r, int c) { const int st = (r >> 4) * 2 + (c >> 5), rr = r & 15, cc = c & 31, ob = rr * 64 + cc * 2; return st * 1024 + (ob ^ (((ob >> 9) & 1) << 5)); }
__device__ __forceinline__ int perm32(int rho) { const int n = rho >> 4, i = rho & 15; return 8 * (i >> 2) + 4 * n + (i & 3); }
__device__ __forceinline__ void stage_rc(int b, int& R, int& C) { const int st = b / 1024, sb = b % 1024, swz = sb ^ (((sb >> 9) & 1) << 5); R = (st >> 1) * 16 + swz / 64; C = (st & 1) * 32 + (swz % 64) / 2; }

struct Unit { const char* A; const char* B; int pm, pn, nt; };

struct StaticOrder {
    int nM, nN, nwg, G, c;
    __device__ void init(int M, int N, int G_, int c_) { nM = M / BM; nN = N / BM; nwg = nM * nN; G = G_; c = c_; }
    __device__ bool next(int i, int& pm, int& pn) const {
        const long L = (long)i * G + c; if (L >= nwg) return false;
        int wgid = (int)L; { const int q = nwg / NXCD, r = nwg % NXCD, xcd = wgid % NXCD, off = wgid / NXCD; wgid = (xcd < r ? xcd * (q + 1) : r * (q + 1) + (xcd - r) * q) + off; }
        const int nig = WGM * nN, gid = wgid / nig, fm = gid * WGM, gsz = (nM - fm) < WGM ? (nM - fm) : WGM;
        pm = fm + ((wgid % nig) % gsz); pn = (wgid % nig) / gsz; return true;
    }
};
struct SchedPlain {
    StaticOrder so; const char* A; const char* B; size_t a_t, b_t; int nt;
    __device__ bool next(int i, Unit& u) const { int pm, pn; if (!so.next(i, pm, pn)) return false; u.pm = pm; u.pn = pn; u.A = A + (size_t)pm * a_t; u.B = B + (size_t)pn * b_t; u.nt = nt; return true; }
};
struct SchedBranch {
    StaticOrder so; const char* A; const char* B; size_t a_t;
    __device__ bool next(int i, Unit& u) const { int pm, pn; if (!so.next(i, pm, pn)) return false; u.pm = pm; u.pn = pn; const int br = pn >> 2;
        u.A = A + (size_t)pm * a_t + (size_t)br * 512; u.B = B + (size_t)br * (1024 * 512 * 2) + (size_t)(pn & 3) * (256 * 512 * 2); u.nt = br == 3 ? 8 : 4; return true; }
};

template <class Epi, class Sched>
__device__ __forceinline__ void gemm_phase(LAS unsigned char* lds, const int lda, const int ldb, const Sched& S, Epi& E) {
    const int tid = fresh_tid(), wid = __builtin_amdgcn_readfirstlane(tid >> 6), lane = tid & 63, wr = wid >> 2, wc = wid & 3, fr = lane & 15, fq = lane >> 4;
    unsigned voffA[2], voffB[2];
#pragma unroll
    for (int i = 0; i < 2; ++i) { int R, C; stage_rc(tid * 16 + i * 8192, R, C); const int Rb = Epi::PERM ? ((R & ~31) + perm32(R & 31)) : R;
        voffA[i] = (unsigned)(R * lda + C * 2); voffB[i] = (unsigned)(Rb * ldb + C * 2); }
    const size_t kstep = (size_t)(BK * 2);
    const size_t hstepA = (size_t)HALF * lda, hstepB = (size_t)HALF * ldb;
    const unsigned ldsw = (unsigned)wid * 1024u;
    const int aoff = lds_byte(wr * 64 + fr, fq * 8), boff = lds_byte(wc * 32 + fr, fq * 8);
#define PG8_SA(b, h) (((b) * 2 + (h)) * HTB)
#define PG8_SB(b, h) ((4 + (b) * 2 + (h)) * HTB)
#define PG8_STAGE(bufoff, gbase, voff) do { _Pragma("unroll") for (int _i = 0; _i < 2; ++_i) \
        __builtin_amdgcn_global_load_lds((const unsigned*)((const char*)(gbase) + (voff)[_i]), (LAS unsigned*)(lds + (bufoff) + ldsw + _i * 8192), 16, 0, 0); } while (0)
#define PG8_LDA(dst, b, h) do { _Pragma("unroll") for (int m = 0; m < 4; ++m) _Pragma("unroll") for (int k = 0; k < 2; ++k) dst[m][k] = *(const LAS bf16x8*)(lds + PG8_SA(b, h) + aoff + m * 2048 + k * 1024); } while (0)
#define PG8_LDB(dst, b, h) do { _Pragma("unroll") for (int n = 0; n < 2; ++n) _Pragma("unroll") for (int k = 0; k < 2; ++k) dst[n][k] = *(const LAS bf16x8*)(lds + PG8_SB(b, h) + boff + n * 2048 + k * 1024); } while (0)
#define PG8_MMA(ai, bj, At, Bt) do { __builtin_amdgcn_s_setprio(1); _Pragma("unroll") for (int m = 0; m < 4; ++m) _Pragma("unroll") for (int n = 0; n < 2; ++n) _Pragma("unroll") for (int k = 0; k < 2; ++k) \
        acc[ai][bj][m][n] = __builtin_amdgcn_mfma_f32_16x16x32_bf16(Bt[n][k], At[m][k], acc[ai][bj][m][n], 0, 0, 0); __builtin_amdgcn_s_setprio(0); } while (0)
#define PG8_WAIT_V(n) asm volatile("s_waitcnt vmcnt(" #n ")" ::: "memory")
#define PG8_WAIT_L(n) asm volatile("s_waitcnt lgkmcnt(" #n ")" ::: "memory")
#define PG8_BAR __builtin_amdgcn_s_barrier()
#define PG8_SCHED __builtin_amdgcn_sched_barrier(0)
    Unit cur, nxt; int ui = 0;
    if (!S.next(0, cur)) return;
    f32x4 acc[2][2][4][2];
#pragma unroll
    for (int a = 0; a < 2; ++a)
#pragma unroll
        for (int b = 0; b < 2; ++b)
#pragma unroll
            for (int m = 0; m < 4; ++m)
#pragma unroll
                for (int n = 0; n < 2; ++n) acc[a][b][m][n] = (f32x4){0.f, 0.f, 0.f, 0.f};
    bf16x8 At[4][2], B0[2][2], B1[2][2];
    const char* cA = cur.A; const char* cB = cur.B;
    PG8_STAGE(PG8_SB(0, 0), cB, voffB); PG8_STAGE(PG8_SB(0, 1), cB + hstepB, voffB); PG8_STAGE(PG8_SA(0, 0), cA, voffA); PG8_STAGE(PG8_SA(0, 1), cA + hstepA, voffA);
    if (wr == 1) PG8_BAR;
    PG8_WAIT_V(2); PG8_BAR;
    PG8_STAGE(PG8_SB(1, 0), cB + kstep, voffB); PG8_STAGE(PG8_SA(1, 0), cA + kstep, voffA); PG8_STAGE(PG8_SB(1, 1), cB + hstepB + kstep, voffB);
    PG8_WAIT_V(6); PG8_BAR;
    for (;;) {
        const bool has_next = S.next(ui + 1, nxt);
        const char* nA = has_next ? nxt.A : cA; const char* nB = has_next ? nxt.B : cB;
        const int nt = cur.nt;
        for (int t = 0; t < nt; t += 2) {
            const bool last = (t == nt - 2);
            const char* a1 = cA + (size_t)(t + 1) * kstep;
            const char* a2 = last ? nA : cA + (size_t)(t + 2) * kstep; const char* b2 = last ? nB : cB + (size_t)(t + 2) * kstep;
            const char* a3 = a2 + kstep; const char* b3 = b2 + kstep;
            PG8_LDB(B0, 0, 0); PG8_LDB(B1, 0, 1); PG8_SCHED; PG8_LDA(At, 0, 0); PG8_STAGE(PG8_SA(1, 1), a1 + hstepA, voffA);
            PG8_WAIT_V(8); PG8_WAIT_L(0); PG8_BAR; PG8_MMA(0, 0, At, B0); PG8_MMA(0, 1, At, B1); PG8_BAR; PG8_SCHED;
            PG8_LDA(At, 0, 1); PG8_STAGE(PG8_SB(0, 0), b2, voffB); PG8_STAGE(PG8_SB(0, 1), b2 + hstepB, voffB); PG8_STAGE(PG8_SA(0, 0), a2, voffA);
            PG8_WAIT_V(8); PG8_WAIT_L(0); PG8_BAR; PG8_MMA(1, 0, At, B0); PG8_MMA(1, 1, At, B1); PG8_BAR; PG8_SCHED;
            PG8_LDB(B0, 1, 0); PG8_LDB(B1, 1, 1); PG8_SCHED; PG8_LDA(At, 1, 0); PG8_STAGE(PG8_SA(0, 1), a2 + hstepA, voffA);
            PG8_WAIT_V(8); PG8_WAIT_L(0); PG8_BAR; PG8_MMA(0, 0, At, B0); PG8_MMA(0, 1, At, B1); PG8_BAR; PG8_SCHED;
            PG8_LDA(At, 1, 1); PG8_STAGE(PG8_SB(1, 0), b3, voffB); PG8_STAGE(PG8_SB(1, 1), b3 + hstepB, voffB); PG8_STAGE(PG8_SA(1, 0), a3, voffA);
            PG8_WAIT_V(8); PG8_WAIT_L(0); PG8_BAR; PG8_MMA(1, 0, At, B0); PG8_MMA(1, 1, At, B1); PG8_BAR; PG8_SCHED;
        }
        if (wr == 0) PG8_BAR;
        E(acc, cur, wr, wc, fr, fq);
        if (!has_next) break;
#pragma unroll
        for (int a = 0; a < 2; ++a)
#pragma unroll
            for (int b = 0; b < 2; ++b)
#pragma unroll
                for (int m = 0; m < 4; ++m)
#pragma unroll
                    for (int n = 0; n < 2; ++n) acc[a][b][m][n] = (f32x4){0.f, 0.f, 0.f, 0.f};
        cur = nxt; cA = nA; cB = nB; ++ui;
        if (wr == 1) PG8_BAR;
    }
    PG8_WAIT_V(0);
    PG8_BAR;
#undef PG8_SA
#undef PG8_SB
#undef PG8_STAGE
#undef PG8_LDA
#undef PG8_LDB
#undef PG8_MMA
#undef PG8_WAIT_V
#undef PG8_WAIT_L
#undef PG8_BAR
#undef PG8_SCHED
}
}

typedef f32x4 acc_t[2][2][4][2];

struct EpiStore {
    static constexpr bool PERM = true;
    bf16_t* O; int ldc;
    __device__ __forceinline__ void operator()(const acc_t& acc, const pg8::Unit& u, int wr, int wc, int fr, int fq) const {
        const int row0 = u.pm * 256 + wr * 64 + fr, col0 = u.pn * 256 + wc * 32 + 8 * fq;
#pragma unroll
        for (int ai = 0; ai < 2; ++ai)
#pragma unroll
            for (int m = 0; m < 4; ++m) { bf16_t* rowp = O + (size_t)(row0 + ai * 128 + m * 16) * ldc + col0;
#pragma unroll
                for (int bj = 0; bj < 2; ++bj) { const f32x4 v0 = acc[ai][bj][m][0], v1 = acc[ai][bj][m][1];
                    u32x4 w; w.x = cvtpk(v0[0], v0[1]); w.y = cvtpk(v0[2], v0[3]); w.z = cvtpk(v1[0], v1[1]); w.w = cvtpk(v1[2], v1[3]); *(u32x4*)(rowp + bj * 128) = w; } }
    }
};
struct EpiQRope {
    static constexpr bool PERM = false;
    bf16_t* O;
    __device__ __forceinline__ void operator()(const acc_t& acc, const pg8::Unit& u, int wr, int wc, int fr, int fq) const {
        const int row0 = u.pm * 256 + wr * 64 + fr, col0 = u.pn * 256 + wc * 32 + 4 * fq;
        const bool latent = u.pm < 128;
        float inv[4];
#pragma unroll
        for (int j = 0; j < 4; ++j) inv[j] = exp2f(-(float)(4 * (fq & 1) + j) * 1.6609640474436813f);
#pragma unroll
        for (int ai = 0; ai < 2; ++ai)
#pragma unroll
            for (int m = 0; m < 4; ++m) { const int row = row0 + ai * 128 + m * 16; bf16_t* rowp = O + (size_t)row * QW + col0;
                const int t = row & (SEQ - 1); const float pos = (float)((fq < 2) ? (t >> 6) : (t & 63));
#pragma unroll
                for (int bj = 0; bj < 2; ++bj) { const int cb = u.pn * 8 + bj * 4 + wc; f32x4 v0 = acc[ai][bj][m][0], v1 = acc[ai][bj][m][1];
                    if (latent && (cb == 4 || cb == 9 || cb == 14 || cb == 19)) {
#pragma unroll
                        for (int j = 0; j < 4; ++j) { const float a = pos * inv[j]; const float cs = __cosf(a), sn = __sinf(a); const float x1 = v0[j], x2 = v1[j]; v0[j] = x1 * cs - x2 * sn; v1[j] = x2 * cs + x1 * sn; }
                    }
                    u32x2 w; w.x = cvtpk(v0[0], v0[1]); w.y = cvtpk(v0[2], v0[3]); *(u32x2*)(rowp + bj * 128) = w;
                    w.x = cvtpk(v1[0], v1[1]); w.y = cvtpk(v1[2], v1[3]); *(u32x2*)(rowp + bj * 128 + 16) = w; } }
    }
};
struct EpiMerge {
    static constexpr bool PERM = false;
    const bf16_t* Yall; bf16_t* Mg;
    __device__ __forceinline__ void operator()(const acc_t& acc, const pg8::Unit& u, int wr, int wc, int fr, int fq) const {
        const int row0 = u.pm * 256 + wr * 64 + fr, ocol = u.pn * 64 + wc * 16 + 4 * fq;
#pragma unroll
        for (int ai = 0; ai < 2; ++ai)
#pragma unroll
            for (int m = 0; m < 4; ++m) { const int row = row0 + ai * 128 + m * 16; const bf16_t* yr = Yall + (size_t)row * 4096 + ocol; f32x4 s = {0.f, 0.f, 0.f, 0.f};
#pragma unroll
                for (int bj = 0; bj < 2; ++bj)
#pragma unroll
                    for (int n = 0; n < 2; ++n) { const u32x2 w = *(const u32x2*)(yr + (2 * bj + n) * 1024); const f32x4 g = acc[ai][bj][m][n];
                        s[0] += sigmoidf_(g[0]) * bflo(w.x); s[1] += sigmoidf_(g[1]) * bfhi(w.x); s[2] += sigmoidf_(g[2]) * bflo(w.y); s[3] += sigmoidf_(g[3]) * bfhi(w.y); }
                u32x2 o; o.x = cvtpk(s[0], s[1]); o.y = cvtpk(s[2], s[3]); *(u32x2*)(Mg + (size_t)row * D + ocol) = o; }
    }
};
struct EpiResid {
    static constexpr bool PERM = true;
    const float* res_lat_f32;
    bf16_t* rb;
    const float* res_ctx; float* out_ctx; const float* gate;
    __device__ __forceinline__ void operator()(const acc_t& acc, const pg8::Unit& u, int wr, int wc, int fr, int fq) const {
        const int lrow0 = wr * 64 + fr, col0 = u.pn * 256 + wc * 32 + 8 * fq;
        const int v = u.pm < 128 ? (u.pm >> 6) : 2;
        const float* gp = gate + v * 6144;
        f32x4 gv[2][2];
#pragma unroll
        for (int bj = 0; bj < 2; ++bj)
#pragma unroll
            for (int n = 0; n < 2; ++n) gv[bj][n] = *(const f32x4*)(gp + col0 + bj * 128 + n * 4);
        if (u.pm < 128) {
            bf16_t* rbt = rb + (size_t)u.pm * 256 * 2048 + 1024;
            if (res_lat_f32) {
                const float* res = res_lat_f32 + (size_t)u.pm * 256 * D;
#pragma unroll
                for (int ai = 0; ai < 2; ++ai)
#pragma unroll
                    for (int m = 0; m < 4; ++m) { const int lr = lrow0 + ai * 128 + m * 16;
#pragma unroll
                        for (int bj = 0; bj < 2; ++bj) { const int c = col0 + bj * 128;
                            const f32x4 r0 = *(const f32x4*)(res + (size_t)lr * D + c), r1 = *(const f32x4*)(res + (size_t)lr * D + c + 4);
                            const f32x4 o0 = r0 + gv[bj][0] * acc[ai][bj][m][0], o1 = r1 + gv[bj][1] * acc[ai][bj][m][1];
                            u32x4 w2; w2.x = cvtpk(o0[0], o0[1]); w2.y = cvtpk(o0[2], o0[3]); w2.z = cvtpk(o1[0], o1[1]); w2.w = cvtpk(o1[2], o1[3]); *(u32x4*)(rbt + (size_t)lr * 2048 + c) = w2; } }
            } else {
#pragma unroll
                for (int ai = 0; ai < 2; ++ai)
#pragma unroll
                    for (int m = 0; m < 4; ++m) { const int lr = lrow0 + ai * 128 + m * 16;
#pragma unroll
                        for (int bj = 0; bj < 2; ++bj) { const int c = col0 + bj * 128; const u32x4 w = *(const u32x4*)(rbt + (size_t)lr * 2048 + c);
                            const f32x4 r0 = (f32x4){bflo(w.x), bfhi(w.x), bflo(w.y), bfhi(w.y)}, r1 = (f32x4){bflo(w.z), bfhi(w.z), bflo(w.w), bfhi(w.w)};
                            const f32x4 o0 = r0 + gv[bj][0] * acc[ai][bj][m][0], o1 = r1 + gv[bj][1] * acc[ai][bj][m][1];
                            u32x4 w2; w2.x = cvtpk(o0[0], o0[1]); w2.y = cvtpk(o0[2], o0[3]); w2.z = cvtpk(o1[0], o1[1]); w2.w = cvtpk(o1[2], o1[3]); *(u32x4*)(rbt + (size_t)lr * 2048 + c) = w2; } }
            }
        } else {
            const float* res = res_ctx + (size_t)(u.pm - 128) * 256 * D; float* out = out_ctx + (size_t)(u.pm - 128) * 256 * D;
#pragma unroll
            for (int ai = 0; ai < 2; ++ai)
#pragma unroll
                for (int m = 0; m < 4; ++m) { const size_t off = (size_t)(lrow0 + ai * 128 + m * 16) * D + col0;
#pragma unroll
                    for (int bj = 0; bj < 2; ++bj)
#pragma unroll
                        for (int n = 0; n < 2; ++n) { const f32x4 r = *(const f32x4*)(res + off + bj * 128 + n * 4); *(f32x4*)(out + off + bj * 128 + n * 4) = r + gv[bj][n] * acc[ai][bj][m][n]; } }
        }
    }
};
struct EpiSwiGLU {
    static constexpr bool PERM = true;
    bf16_t* Hd;
    __device__ __forceinline__ void operator()(const acc_t& acc, const pg8::Unit& u, int wr, int wc, int fr, int fq) const {
        const int row0 = u.pm * 256 + wr * 64 + fr, hcol = u.pn * 128 + wc * 32 + 8 * fq;
#pragma unroll
        for (int ai = 0; ai < 2; ++ai)
#pragma unroll
            for (int m = 0; m < 4; ++m) { bf16_t* rowp = Hd + (size_t)(row0 + ai * 128 + m * 16) * FF + hcol; f32x4 v[2];
#pragma unroll
                for (int n = 0; n < 2; ++n) { const f32x4 a = acc[ai][0][m][n], b = acc[ai][1][m][n];
#pragma unroll
                    for (int j = 0; j < 4; ++j) v[n][j] = a[j] * sigmoidf_(a[j]) * b[j]; }
                u32x4 w; w.x = cvtpk(v[0][0], v[0][1]); w.y = cvtpk(v[0][2], v[0][3]); w.z = cvtpk(v[1][0], v[1][1]); w.w = cvtpk(v[1][2], v[1][3]); *(u32x4*)rowp = w; }
    }
};

__device__ __forceinline__ s16x4 vtr(LAS const unsigned char* p) { return __builtin_bit_cast(s16x4, __builtin_amdgcn_ds_read_tr16_b64_v4i16((LAS v4i16_t*)p)); }
__device__ __forceinline__ int crow(int r, int hi) { return (r & 3) + 8 * (r >> 2) + 4 * hi; }

template <int MODE>
__device__ __forceinline__ void attn_unit(LAS unsigned char* lds, const bf16_t* __restrict__ u, const bf16_t* __restrict__ qm, bf16_t* __restrict__ y,
                                          const float* __restrict__ rpb, const float* __restrict__ sink,
                                          int qrow0, int kctx_row0, int nlocal, int loc_row0, int aux0, int aux1, int kvh) {
    constexpr int KW = MODE == 0 ? 160 : (MODE == 1 ? 256 : 64);
    constexpr int KSTR = KW * 2 + 16;
    constexpr int NKS = MODE == 0 ? 10 : 4;
    constexpr int NDB = MODE == 0 ? 4 : 2;
    constexpr bool VSEP = MODE != 0;
    constexpr int CPR = KW / 8, NCH = 64 * CPR, NLD = (NCH + 511) / 512;
    constexpr int STAGE = (VSEP ? 2 : 1) * 64 * KSTR;
    const int tid = fresh_tid(), lane = tid & 63, wid = __builtin_amdgcn_readfirstlane(tid >> 6), l32 = lane & 31, hi = lane >> 5;
    int head, qtok, kcolw, kgcol, vgcol, ycol;
    if (MODE == 0) { head = wid & 3; qtok = 32 * (wid >> 2) + l32; kcolw = 0; kgcol = U_CKV; vgcol = U_CKV; ycol = 768 + head * 128; }
    else if (MODE == 1) { head = wid & 3; qtok = 32 * (wid >> 2) + l32; kcolw = head * 64; kgcol = U_NAK; vgcol = U_NAV; ycol = 256 + head * 64; }
    else { head = kvh * 2 + (wid & 1); qtok = 32 * (wid >> 1) + l32; kcolw = 0; kgcol = U_SWK + kvh * 64; vgcol = U_SWV + kvh * 64; ycol = 512 + head * 64; }
    const bf16_t* qp = MODE == 0 ? qm + (size_t)(qrow0 + qtok) * QW + head * 160 : u + (size_t)(qrow0 + qtok) * UW + (MODE == 1 ? U_NAQ : U_SWQ) + head * 64;
    bf16x8 qf[NKS];
#pragma unroll
    for (int ks = 0; ks < NKS; ++ks) qf[ks] = *(const bf16x8*)(qp + 16 * ks + 8 * hi);
    f32x16 o[NDB];
#pragma unroll
    for (int c = 0; c < NDB; ++c)
#pragma unroll
        for (int r = 0; r < 16; ++r) o[c][r] = 0.f;
    float mrun = -1e30f, lrun = 0.f;
    int srow[NLD], sch[NLD];
#pragma unroll
    for (int i = 0; i < NLD; ++i) { const int idx = tid + 512 * i; srow[i] = idx / CPR; sch[i] = idx % CPR; }
    u32x4 kreg[NLD], vreg[NLD];
    const int ntile = 4 + nlocal;
    unsigned dvo[5];
    if (MODE == 1) {
#pragma unroll
        for (int i = 0; i < 5; ++i) { const int sl = (wid + 8 * i) * 64 + lane, row = (sl / 33) & 63, ch = sl % 33; dvo[i] = (unsigned)(row * (UW * 2) + (ch < 32 ? ch : 0) * 16); }
    }
#define ATT_DMA(t, buf) do { const char* tb_ = (const char*)u + (size_t)ATT_TROW(t) * (UW * 2); _Pragma("unroll") for (int i = 0; i < 5; ++i) if (wid + 8 * i < 33) { \
        __builtin_amdgcn_global_load_lds((const unsigned*)(tb_ + kgcol * 2 + dvo[i]), (LAS unsigned*)(lds + (buf) * STAGE + (wid + 8 * i) * 1024), 16, 0, 0); \
        __builtin_amdgcn_global_load_lds((const unsigned*)(tb_ + vgcol * 2 + dvo[i]), (LAS unsigned*)(lds + (buf) * STAGE + 64 * KSTR + (wid + 8 * i) * 1024), 16, 0, 0); } } while (0)
#define ATT_TROW(t) ((t) < 4 ? kctx_row0 + 64 * (t) : loc_row0 + 64 * ((t) - 4))
#define ATT_LOAD(t) do { const int rg_ = ATT_TROW(t); _Pragma("unroll") for (int i = 0; i < NLD; ++i) if (NCH % 512 == 0 || i < NLD - 1 || tid + 512 * i < NCH) { \
        const bf16_t* gp_ = u + (size_t)(rg_ + srow[i]) * UW + sch[i] * 8; kreg[i] = *(const u32x4*)(gp_ + kgcol); if (VSEP) vreg[i] = *(const u32x4*)(gp_ + vgcol); } } while (0)
#define ATT_STORE(buf) do { _Pragma("unroll") for (int i = 0; i < NLD; ++i) if (NCH % 512 == 0 || i < NLD - 1 || tid + 512 * i < NCH) { \
        LAS unsigned char* lp_ = lds + (buf) * STAGE + srow[i] * KSTR + sch[i] * 16; *(LAS u32x4*)lp_ = kreg[i]; if (VSEP) *(LAS u32x4*)(lp_ + 64 * KSTR) = vreg[i]; } } while (0)
    if (MODE == 1) { ATT_DMA(0, 0); asm volatile("s_waitcnt vmcnt(0)" ::: "memory"); } else { ATT_LOAD(0); ATT_STORE(0); }
    __syncthreads();
    const int q4 = (lane & 15) >> 2, p4 = lane & 3, blk = (lane >> 4) & 1;
    for (int t = 0; t < ntile; ++t) {
        const int buf = t & 1;
        if (t + 1 < ntile) { if (MODE == 1) ATT_DMA(t + 1, (t + 1) & 1); else ATT_LOAD(t + 1); }
        float rpv = 0.f;
        if (MODE == 1 && t >= 4) rpv = rpb[(head * 15 + (aux1 + (t - 4) - aux0 + 7)) * 31 + min(lane, 30)];
        LAS const unsigned char* Kb = lds + buf * STAGE;
        LAS const unsigned char* Vb = VSEP ? Kb + 64 * KSTR : Kb;
        f32x16 s0, s1;
#pragma unroll
        for (int r = 0; r < 16; ++r) { s0[r] = 0.f; s1[r] = 0.f; }
        {
            LAS const unsigned char* kp = Kb + l32 * KSTR + (kcolw + 8 * hi) * 2;
            bf16x8 ka0 = *(LAS const bf16x8*)(kp), ka1 = *(LAS const bf16x8*)(kp + 32 * KSTR);
#pragma unroll
            for (int ks = 0; ks < NKS; ++ks) {
                bf16x8 kb0 = ka0, kb1 = ka1;
                if (ks + 1 < NKS) { kb0 = *(LAS const bf16x8*)(kp + (ks + 1) * 32); kb1 = *(LAS const bf16x8*)(kp + (ks + 1) * 32 + 32 * KSTR); }
                s0 = __builtin_amdgcn_mfma_f32_32x32x16_bf16(ka0, qf[ks], s0, 0, 0, 0);
                s1 = __builtin_amdgcn_mfma_f32_32x32x16_bf16(ka1, qf[ks], s1, 0, 0, 0);
                __builtin_amdgcn_sched_barrier(0);
                ka0 = kb0; ka1 = kb1;
            }
        }
        if (MODE == 1 && t >= 4) {
            const int c = qtok, c0 = min(max(c - 8, 0), 48);
            const int rpi = (int)__float_as_uint(rpv);
#pragma unroll
            for (int r = 0; r < 16; ++r) {
                const int kc0 = crow(r, hi), kc1 = kc0 + 32;
                const bool v0 = (kc0 >= c0) && (kc0 < c0 + 16), v1 = (kc1 >= c0) && (kc1 < c0 + 16);
                const float b0 = __uint_as_float((unsigned)__builtin_amdgcn_ds_bpermute(min(max(kc0 - c + 15, 0), 30) << 2, rpi));
                const float b1 = __uint_as_float((unsigned)__builtin_amdgcn_ds_bpermute(min(max(kc1 - c + 15, 0), 30) << 2, rpi));
                s0[r] = v0 ? s0[r] + b0 * LOG2E : -INFINITY; s1[r] = v1 ? s1[r] + b1 * LOG2E : -INFINITY;
            }
        }
        if (MODE == 2 && t >= 4) {
            const int qpos = aux0 + qtok, kb0 = aux1 + 64 * (t - 4);
#pragma unroll
            for (int r = 0; r < 16; ++r) {
                const int d0 = kb0 + crow(r, hi) - qpos, d1 = d0 + 32;
                if (d0 > 128 || d0 < -128) s0[r] = -INFINITY;
                if (d1 > 128 || d1 < -128) s1[r] = -INFINITY;
            }
        }
        float mx = fmaxf(s0[0], s1[0]);
#pragma unroll
        for (int r = 1; r < 16; ++r) mx = fmaxf(mx, fmaxf(s0[r], s1[r]));
        mx = xhalf_max(mx);
        const float mnew = fmaxf(mrun, mx), alpha = fexp2(mrun - mnew);
        mrun = mnew;
        float rs = 0.f;
#pragma unroll
        for (int r = 0; r < 16; ++r) { s0[r] = fexp2(s0[r] - mnew); s1[r] = fexp2(s1[r] - mnew); rs += s0[r] + s1[r]; }
        lrun = lrun * alpha + rs;
#pragma unroll
        for (int c = 0; c < NDB; ++c)
#pragma unroll
            for (int r = 0; r < 16; ++r) o[c][r] *= alpha;
        u32x4 pw[2][2];
#pragma unroll
        for (int s = 0; s < 2; ++s) {
            pw[0][s] = (u32x4){cvtpk(s0[8 * s], s0[8 * s + 1]), cvtpk(s0[8 * s + 2], s0[8 * s + 3]), cvtpk(s0[8 * s + 4], s0[8 * s + 5]), cvtpk(s0[8 * s + 6], s0[8 * s + 7])};
            pw[1][s] = (u32x4){cvtpk(s1[8 * s], s1[8 * s + 1]), cvtpk(s1[8 * s + 2], s1[8 * s + 3]), cvtpk(s1[8 * s + 4], s1[8 * s + 5]), cvtpk(s1[8 * s + 6], s1[8 * s + 7])};
        }
        {
            LAS const unsigned char* vp = Vb + (4 * hi + q4) * KSTR + (kcolw + 16 * blk) * 2 + 8 * p4;
            s16x4 la = vtr(vp), ha = vtr(vp + 8 * KSTR);
#pragma unroll
            for (int it = 0; it < NDB * 4; ++it) {
                const int c = it >> 2, kb = (it >> 1) & 1, s = it & 1;
                s16x4 lb = la, hb = ha;
                if (it + 1 < NDB * 4) { const int c2 = (it + 1) >> 2, kb2 = ((it + 1) >> 1) & 1, s2 = (it + 1) & 1;
                    lb = vtr(vp + (32 * kb2 + 16 * s2) * KSTR + c2 * 64); hb = vtr(vp + (32 * kb2 + 16 * s2 + 8) * KSTR + c2 * 64); }
                const bf16x8 vf = (bf16x8){la[0], la[1], la[2], la[3], ha[0], ha[1], ha[2], ha[3]};
                o[c] = __builtin_amdgcn_mfma_f32_32x32x16_bf16(vf, __builtin_bit_cast(bf16x8, pw[kb][s]), o[c], 0, 0, 0);
                __builtin_amdgcn_sched_barrier(0);
                la = lb; ha = hb;
            }
        }
        if (MODE == 1) asm volatile("s_waitcnt vmcnt(0)" ::: "memory"); else if (t + 1 < ntile) ATT_STORE((t + 1) & 1);
        __syncthreads();
    }
    lrun = xhalf_sum(lrun);
    if (MODE == 2) lrun += fexp2(sink[head] * LOG2E - mrun);
    const float inv = 1.f / lrun;
    bf16_t* yp = y + (size_t)(qrow0 + qtok) * YW + ycol + 4 * hi;
#pragma unroll
    for (int c = 0; c < NDB; ++c)
#pragma unroll
        for (int g = 0; g < 4; ++g) { u32x2 w; w.x = cvtpk(o[c][4 * g] * inv, o[c][4 * g + 1] * inv); w.y = cvtpk(o[c][4 * g + 2] * inv, o[c][4 * g + 3] * inv); *(u32x2*)(yp + 32 * c + 8 * g) = w; }
#undef ATT_TROW
#undef ATT_DMA
#undef ATT_LOAD
#undef ATT_STORE
}


__device__ __forceinline__ void mla_unit(LAS unsigned char* lds, const bf16_t* __restrict__ u, const bf16_t* __restrict__ qm, bf16_t* __restrict__ y,
                                         int qrow0, int kctx_row0, int nlocal, int loc_row0) {
    constexpr int KSTR = 320, NKS = 10, STAGE = 41 * 1024, KB1 = 32 * KSTR + 64, HALFB = 64 * KSTR + 128;
    constexpr float THR = 6.f;
    const int tid = fresh_tid(), lane = tid & 63, wid = __builtin_amdgcn_readfirstlane(tid >> 6), l32 = lane & 31, hi = lane >> 5;
    const int head = wid & 3, qtok = 32 * (wid >> 2) + l32;
    const bf16_t* qp = qm + (size_t)(qrow0 + qtok) * QW + head * 160;
    bf16x8 qf[NKS];
#pragma unroll
    for (int ks = 0; ks < NKS; ++ks) qf[ks] = *(const bf16x8*)(qp + 16 * ks + 8 * hi);
    f32x16 o[4];
#pragma unroll
    for (int c = 0; c < 4; ++c)
#pragma unroll
        for (int r = 0; r < 16; ++r) o[c][r] = 0.f;
    float mref = -1e30f, lrun = 0.f;
    const int nmac = 2 + (nlocal >> 1);
#define MLA_TROW(T) ((T) < 2 ? kctx_row0 + 128 * (T) : loc_row0 + 128 * ((T) - 2))
    unsigned dvo[6];
#pragma unroll
    for (int i = 0; i < 6; ++i) { const int sl = (wid * 6 + i) * 64 + lane, g = sl / 161, rem = sl % 161; const bool ok = sl < 2576 && rem < 160;
        const int row = ok ? 8 * g + rem / 20 : 0, ch = ok ? rem % 20 : 0; dvo[i] = (unsigned)(row * (UW * 2) + ch * 16); }
    const char* kbase = (const char*)(u + U_CKV);
#define MLA_DMA(T, buf) do { const char* tb_ = kbase + (size_t)MLA_TROW(T) * (UW * 2); _Pragma("unroll") for (int i = 0; i < 6; ++i) if (wid * 6 + i < 41) \
        __builtin_amdgcn_global_load_lds((const unsigned*)(tb_ + dvo[i]), (LAS unsigned*)(lds + (buf) * STAGE + (wid * 6 + i) * 1024), 16, 0, 0); } while (0)
    MLA_DMA(0, 0); MLA_DMA(1, 1);
    asm volatile("s_waitcnt vmcnt(0)" ::: "memory");
    __syncthreads();
    const int q4 = (lane & 15) >> 2, p4 = lane & 3, blk = (lane >> 4) & 1;
    const int koff = l32 * KSTR + (l32 >> 3) * 16 + 16 * hi;
    const int voff = (4 * hi + q4) * KSTR + 32 * blk + 8 * p4;
    f32x16 sa0, sa1, sb0, sb1;
    u32x4 pw00, pw01, pw10, pw11;
    float mxn;
#define MLA_QKEXP(SD0, SD1, PA0, PA1, KOFF, DOEXP) do { \
        _Pragma("unroll") for (int r = 0; r < 16; ++r) { SD0[r] = 0.f; SD1[r] = 0.f; } \
        float rs = 0.f; \
        LAS const unsigned char* kp = lds + (KOFF) + koff; \
        bf16x8 ka0 = *(LAS const bf16x8*)(kp), ka1 = *(LAS const bf16x8*)(kp + KB1); \
        _Pragma("unroll") for (int ks = 0; ks < NKS; ++ks) { \
            bf16x8 kb0 = ka0, kb1 = ka1; \
            if (ks + 1 < NKS) { kb0 = *(LAS const bf16x8*)(kp + (ks + 1) * 32); kb1 = *(LAS const bf16x8*)(kp + (ks + 1) * 32 + KB1); } \
            SD0 = __builtin_amdgcn_mfma_f32_32x32x16_bf16(ka0, qf[ks], SD0, 0, 0, 0); \
            SD1 = __builtin_amdgcn_mfma_f32_32x32x16_bf16(ka1, qf[ks], SD1, 0, 0, 0); \
            if (DOEXP) { \
                if (ks < 4) { _Pragma("unroll") for (int j = 0; j < 4; ++j) { const float p = fexp2(PA0[4 * ks + j] - mref); PA0[4 * ks + j] = p; rs += p; } } \
                else if (ks < 8) { _Pragma("unroll") for (int j = 0; j < 4; ++j) { const float p = fexp2(PA1[4 * (ks - 4) + j] - mref); PA1[4 * (ks - 4) + j] = p; rs += p; } } \
                else if (ks == 8) { pw00 = (u32x4){cvtpk(PA0[0], PA0[1]), cvtpk(PA0[2], PA0[3]), cvtpk(PA0[4], PA0[5]), cvtpk(PA0[6], PA0[7])}; \
                                    pw01 = (u32x4){cvtpk(PA0[8], PA0[9]), cvtpk(PA0[10], PA0[11]), cvtpk(PA0[12], PA0[13]), cvtpk(PA0[14], PA0[15])}; } \
                else { pw10 = (u32x4){cvtpk(PA1[0], PA1[1]), cvtpk(PA1[2], PA1[3]), cvtpk(PA1[4], PA1[5]), cvtpk(PA1[6], PA1[7])}; \
                       pw11 = (u32x4){cvtpk(PA1[8], PA1[9]), cvtpk(PA1[10], PA1[11]), cvtpk(PA1[12], PA1[13]), cvtpk(PA1[14], PA1[15])}; } } \
            __builtin_amdgcn_sched_barrier(0); \
            ka0 = kb0; ka1 = kb1; } \
        lrun += rs; } while (0)
#define MLA_PV(VOFF, M0, M1) do { \
        LAS const unsigned char* vp = lds + (VOFF) + voff; \
        s16x4 vl[16], vh[16]; float mxa, mxb; \
        _Pragma("unroll") for (int it = 0; it < 16; ++it) { const int c = it >> 2, kb = (it >> 1) & 1, s_ = it & 1; \
            vl[it] = vtr(vp + (32 * kb + 16 * s_) * KSTR + 16 * (4 * kb + 2 * s_) + c * 64); vh[it] = vtr(vp + (32 * kb + 16 * s_ + 8) * KSTR + 16 * (4 * kb + 2 * s_ + 1) + c * 64); } \
        _Pragma("unroll") for (int it = 0; it < 16; ++it) { const int c = it >> 2, kb = (it >> 1) & 1, s_ = it & 1; \
            const bf16x8 vf = (bf16x8){vl[it][0], vl[it][1], vl[it][2], vl[it][3], vh[it][0], vh[it][1], vh[it][2], vh[it][3]}; \
            const u32x4 pwv = kb == 0 ? (s_ == 0 ? pw00 : pw01) : (s_ == 0 ? pw10 : pw11); \
            o[c] = __builtin_amdgcn_mfma_f32_32x32x16_bf16(vf, __builtin_bit_cast(bf16x8, pwv), o[c], 0, 0, 0); \
            if (it == 0) { mxa = M0[0]; mxb = M1[0]; } else { mxa = fmaxf(mxa, M0[it]); mxb = fmaxf(mxb, M1[it]); } } \
        mxn = xhalf_max(fmaxf(mxa, mxb)); } while (0)
#define MLA_RESCALE() do { if (__any(mxn > mref + THR)) { const float mnew = fmaxf(mref, mxn), alpha = fexp2(mref - mnew); mref = mnew; lrun *= alpha; \
        _Pragma("unroll") for (int c = 0; c < 4; ++c) _Pragma("unroll") for (int r = 0; r < 16; ++r) o[c][r] *= alpha; } __builtin_amdgcn_sched_barrier(0); } while (0)
    MLA_QKEXP(sa0, sa1, sa0, sa1, 0, false);
    { float a_ = fmaxf(sa0[0], sa1[0]);
#pragma unroll
      for (int r = 1; r < 16; ++r) a_ = fmaxf(a_, fmaxf(sa0[r], sa1[r]));
      mxn = xhalf_max(a_); }
    int bcur = 0;
    for (int T = 0; T < nmac; ++T) {
        const int bnxt = bcur == 2 ? 0 : bcur + 1, bnn = bnxt == 2 ? 0 : bnxt + 1;
        if (T + 2 < nmac) MLA_DMA(T + 2, bnn);
        MLA_RESCALE();
        MLA_QKEXP(sb0, sb1, sa0, sa1, bcur * STAGE + HALFB, true);
        MLA_PV(bcur * STAGE, sb0, sb1);
        MLA_RESCALE();
        MLA_QKEXP(sa0, sa1, sb0, sb1, bnxt * STAGE, true);
        MLA_PV(bcur * STAGE + HALFB, sa0, sa1);
        asm volatile("s_waitcnt vmcnt(0)" ::: "memory");
        __syncthreads();
        bcur = bnxt;
    }
    lrun = xhalf_sum(lrun);
    const float inv = 1.f / lrun;
    bf16_t* yp = y + (size_t)(qrow0 + qtok) * YW + 768 + head * 128 + 4 * hi;
#pragma unroll
    for (int c = 0; c < 4; ++c)
#pragma unroll
        for (int g = 0; g < 4; ++g) { u32x2 w; w.x = cvtpk(o[c][4 * g] * inv, o[c][4 * g + 1] * inv); w.y = cvtpk(o[c][4 * g + 2] * inv, o[c][4 * g + 3] * inv); *(u32x2*)(yp + 32 * c + 8 * g) = w; }
#undef MLA_TROW
#undef MLA_DMA
#undef MLA_QKEXP
#undef MLA_PV
#undef MLA_RESCALE
}

#define XB_TMO      128
#define XB_XCNT(j)  (256  + 64 * (j))
#define XB_XSUB(j)  (1280 + 64 * (j))
#define XB_XGEN(j)  (2304 + 64 * (j))
#define XB_TOP      3328
#define XB_TOPGEN   3392
#define XCD_BAR_WORDS 3456
#define XB_SPIN_CAP (1u << 18)
__device__ __forceinline__ unsigned xb_ld(unsigned* p)              { return __hip_atomic_load(p, __ATOMIC_RELAXED, __HIP_MEMORY_SCOPE_AGENT); }
__device__ __forceinline__ unsigned xb_add(unsigned* p, unsigned v) { return __hip_atomic_fetch_add(p, v, __ATOMIC_RELAXED, __HIP_MEMORY_SCOPE_AGENT); }
__device__ __forceinline__ unsigned xb_xcc_id() { return (unsigned)__builtin_amdgcn_s_getreg((3 << 11) | 20) & 0xFu; }
#define XB_SPIN(cond, bar) do { unsigned _sp = 0; while (cond) { __builtin_amdgcn_s_sleep(1); \
    if ((++_sp & 255u) == 0u) { if (xb_ld(&(bar)[XB_TMO])) break; if (_sp > XB_SPIN_CAP) { atomicAdd(&(bar)[XB_TMO], 1u); break; } } } } while (0)
struct XcdBarrier { unsigned* bar; unsigned x; volatile LAS unsigned* st; };
__device__ __forceinline__ XcdBarrier xcd_barrier_post(unsigned* bar, volatile LAS unsigned* st) {
    XcdBarrier b; b.bar = bar; b.x = xb_xcc_id(); b.st = st;
    if (threadIdx.x == 0) (void)xb_add(&bar[XB_XCNT(b.x)], 1u);
    return b;
}
__device__ __forceinline__ void xcd_barrier_complete(unsigned* bar, unsigned x, unsigned& nloc, unsigned& nx) {
    const unsigned G = gridDim.x * gridDim.y * gridDim.z;
    unsigned sum, cnt, mine, sp = 0u;
    for (;;) {
        sum = 0u; cnt = 0u; mine = 0u;
#pragma unroll
        for (unsigned j = 0; j < 16; ++j) { const unsigned c = xb_ld(&bar[XB_XCNT(j)]); sum += c; cnt += (c > 0u) ? 1u : 0u; mine = (j == x) ? c : mine; }
        if (sum == G) break;
        __builtin_amdgcn_s_sleep(1);
        if ((++sp & 255u) == 0u) { if (xb_ld(&bar[XB_TMO])) break; if (sp > XB_SPIN_CAP) { atomicAdd(&bar[XB_TMO], 1u); break; } }
    }
    nloc = mine > 0u ? mine : 1u; nx = cnt > 0u ? cnt : 1u;
}
__device__ __forceinline__ void xcd_barrier(const XcdBarrier& b) {
    asm volatile("s_waitcnt vmcnt(0)" ::: "memory");
    __syncthreads();
    if (threadIdx.x == 0) {
        unsigned* bar = b.bar; asm volatile("" : "+s"(bar)); unsigned bxcc = b.x; asm volatile("" : "+s"(bxcc));
        __builtin_amdgcn_s_waitcnt(0);
        unsigned nloc = b.st[0], nx = b.st[1];
        if (nloc == 0u) { xcd_barrier_complete(bar, bxcc, nloc, nx); b.st[0] = nloc; b.st[1] = nx; }
        const unsigned old = xb_add(&bar[XB_XSUB(bxcc)], 1u);
        const unsigned gen = old / nloc;
        if (old + 1u == (gen + 1u) * nloc) {
            __builtin_amdgcn_fence(__ATOMIC_RELEASE, "agent");
            asm volatile("s_waitcnt vmcnt(0)" ::: "memory");
            const unsigned og = xb_add(&bar[XB_TOP], 1u);
            const unsigned tg = og / nx;
            if (og + 1u == (tg + 1u) * nx) xb_add(&bar[XB_TOPGEN], 1u);
            else XB_SPIN(xb_ld(&bar[XB_TOPGEN]) == tg, bar);
            __builtin_amdgcn_fence(__ATOMIC_ACQUIRE, "agent");
            xb_add(&bar[XB_XGEN(bxcc)], 1u);
            asm volatile("s_waitcnt vmcnt(0)" ::: "memory");
        } else {
            XB_SPIN(xb_ld(&bar[XB_XGEN(bxcc)]) == gen, bar);
            __builtin_amdgcn_fence(__ATOMIC_ACQUIRE, "agent");
            asm volatile("s_waitcnt vmcnt(0)" ::: "memory");
        }
    }
    __syncthreads();
}

struct Args { const float* in[24]; float* out; unsigned char* ws; };
typedef __attribute__((address_space(4))) const Args CArgs;
__device__ __forceinline__ int fresh_sgpr(int v) { asm volatile("" : "+s"(v)); return v; }
__device__ __forceinline__ CArgs* fresh_args() { CArgs* p = (CArgs*)__builtin_amdgcn_kernarg_segment_ptr(); asm volatile("" : "+s"(p)); return p; }
enum { I_X = 0, I_C, I_CTX, I_CCTX, I_ADAW, I_ADAB, I_N1G, I_N2G, I_WIN, I_POOLW, I_POOLS, I_RPB, I_SINK, I_QNORM, I_KVNORM, I_WUQ, I_WUK, I_WUV, I_WBR, I_WOUT, I_W1, I_W3, I_W2, I_FNG };

__device__ __forceinline__ int rowmap(int mode, int n) {
    if (mode == 0) return n;
    if (mode == 1) { const int i = n >> 10, col = n & 1023, pn = col >> 6, cc = col & 63, wc = cc >> 4, fq = (cc >> 2) & 3, j = cc & 3; return 256 * pn + 128 * (i >> 1) + 32 * wc + 16 * (i & 1) + 4 * fq + j; }
    const int r = 256 * (n >> 7) + (n & 127); return mode == 2 ? r : r + 128;
}
__device__ __forceinline__ void tr_item(const float* __restrict__ W, int ldw, bf16_t* __restrict__ WT, int ldt, int nblk, int mode, LAS float* scr, int item, int lane, bool qscale = false) {
    const int kb = item / nblk, nb = item % nblk, k0 = 64 * kb, n0 = 32 * nb;
    float tv[32];
#pragma unroll
    for (int i = 0; i < 32; ++i) tv[i] = W[(size_t)(k0 + 2 * i + (lane >> 5)) * ldw + n0 + (lane & 31)];
#pragma unroll
    for (int i = 0; i < 32; ++i) scr[(2 * i + (lane >> 5)) * 33 + (lane & 31)] = tv[i];
    asm volatile("s_waitcnt lgkmcnt(0)" ::: "memory");
    const int c = lane & 7;
#pragma unroll
    for (int j = 0; j < 4; ++j) { const int n = (lane >> 3) + 8 * j; const LAS float* s = scr + (8 * c) * 33 + n;
        const float qs = (qscale && n0 + n >= U_NAQ && n0 + n < U_CQ) ? QSC64 : 1.f;
        u32x4 o; o.x = cvtpk(s[0 * 33] * qs, s[1 * 33] * qs); o.y = cvtpk(s[2 * 33] * qs, s[3 * 33] * qs); o.z = cvtpk(s[4 * 33] * qs, s[5 * 33] * qs); o.w = cvtpk(s[6 * 33] * qs, s[7 * 33] * qs);
        *(u32x4*)(WT + (size_t)rowmap(mode, n0 + n) * ldt + k0 + 8 * c) = o; }
    asm volatile("s_waitcnt lgkmcnt(0)" ::: "memory");
}

__global__ void __launch_bounds__(NTHREADS) mk_fwd(Args args) {
    extern __shared__ __attribute__((aligned(16))) unsigned char lds_raw[];
    LAS unsigned char* lds = (LAS unsigned char*)lds_raw;
    cg::grid_group grid = cg::this_grid();
    const int wid = __builtin_amdgcn_readfirstlane(threadIdx.x >> 6);
    const int bx = blockIdx.x;
    unsigned* barw = (unsigned*)args.ws;
    volatile LAS unsigned* bst = (volatile LAS unsigned*)(lds + LDS_BYTES - 16);
    if (threadIdx.x == 0) { bst[0] = 0u; bst[1] = 0u; }
    __syncthreads();
    if (gridDim.x == 0x7fffffffu) grid.sync();
    XcdBarrier xbar = xcd_barrier_post(barw, bst);
#define PH_BEGIN { const int tid = fresh_tid(); const int lane = tid & 63; (void)tid; (void)lane; CArgs* ap = fresh_args(); const int bx = fresh_sgpr((int)blockIdx.x); const int G = fresh_sgpr((int)gridDim.x); const int gw = bx * 8 + wid, NGW = G * 8; (void)gw; (void)NGW; unsigned char* ws = ap->ws; float* out = ap->out; \
    float* mod = (float*)(ws + WS_MOD); float* xc = (float*)(ws + WS_XC); bf16_t* Hb = (bf16_t*)(ws + WS_H); bf16_t* Yb = (bf16_t*)(ws + WS_Y); bf16_t* Ub = (bf16_t*)(ws + WS_R4); \
    bf16_t* Qm = (bf16_t*)(ws + WS_QM); bf16_t* Yall = (bf16_t*)(ws + WS_R4); bf16_t* Hid = (bf16_t*)(ws + WS_R4); bf16_t* Mg = (bf16_t*)(ws + WS_Y); \
    (void)mod; (void)xc; (void)Hb; (void)Yb; (void)Ub; (void)Qm; (void)Yall; (void)Hid; (void)Mg; (void)out;
#define PH_LAYER unsigned char* wl = ws + WS_W + (size_t)l * WL; const float* modl = mod + (size_t)l * 3 * 6144; const float* xres = l == 0 ? ap->in[I_X] : out; const float* cres = l == 0 ? ap->in[I_CTX] : xc; \
    const int Mq = l == 0 ? MT : NLAT; (void)wl; (void)modl; (void)xres; (void)cres; (void)Mq;
#define PH_END   xcd_barrier(xbar); }
#define PH_END0  xcd_barrier(xbar); }
#define PH_ENDL  }

    PH_BEGIN
    {
        LAS float* scr = (LAS float*)(lds + wid * 16384);
        constexpr int T_U = 976, T_G = 2048, T_B = 128, T_O = 512, T_1 = 1408, T_2 = 1408;
        constexpr int LTOT = T_U + T_G + 2 * T_B + T_O + 2 * T_1 + T_2;
        for (int it = gw; it < DEPTH * LTOT; it += NGW) {
            const int l = it / LTOT; int r = it % LTOT;
            unsigned char* wl = ws + WS_W + (size_t)l * WL;
            const float* win = ap->in[I_WIN] + (size_t)l * D * INC;
            if (r < T_U) { tr_item(win, INC, (bf16_t*)(wl + W_U), D, 61, 0, scr, r, lane, true); continue; } r -= T_U;
            if (r < T_G) { tr_item(win + U_END, INC, (bf16_t*)(wl + W_G), D, 128, 1, scr, r, lane); continue; } r -= T_G;
            if (r < T_B) { tr_item(ap->in[I_WBR] + ((size_t)l * 4 + 1) * 256 * D, D, (bf16_t*)(wl + W_B) + (size_t)1 * 1024 * 512, 512, 32, 0, scr, r, lane); continue; } r -= T_B;
            if (r < T_B) { tr_item(ap->in[I_WBR] + ((size_t)l * 4 + 2) * 256 * D, D, (bf16_t*)(wl + W_B) + (size_t)2 * 1024 * 512, 512, 32, 0, scr, r, lane); continue; } r -= T_B;
            if (r < T_O) { tr_item(ap->in[I_WOUT] + (size_t)l * D * D, D, (bf16_t*)(wl + W_O), D, 32, 0, scr, r, lane); continue; } r -= T_O;
            if (r < T_1) { tr_item(ap->in[I_W1] + (size_t)l * D * FF, FF, (bf16_t*)(wl + W_13), D, 88, 2, scr, r, lane); continue; } r -= T_1;
            if (r < T_1) { tr_item(ap->in[I_W3] + (size_t)l * D * FF, FF, (bf16_t*)(wl + W_13), D, 88, 3, scr, r, lane); continue; } r -= T_1;
            tr_item(ap->in[I_W2] + (size_t)l * FF * D, D, (bf16_t*)(wl + W_2), FF, 32, 0, scr, r, lane);
        }
        constexpr int F_Q = 640 * 256, F_3 = 512 * 256, F_0 = 256 * 256, FTOT = F_Q + F_3 + F_0;
        for (int it = bx * NTHREADS + tid; it < DEPTH * FTOT; it += G * NTHREADS) {
            const int l = it / FTOT; int r = it % FTOT;
            unsigned char* wl = ws + WS_W + (size_t)l * WL;
            if (r < F_Q) {
                const int k = r / 640, n = r % 640, h = n / 160, c = n % 160;
                const float* uq = ap->in[I_WUQ] + (size_t)l * 256 * 384 + (size_t)k * 384 + h * 96;
                float s;
                if (c < 128) { const float* uk = ap->in[I_WUK] + (size_t)l * 128 * 256 + (size_t)c * 256 + h * 64; f32x4 a4 = {0.f, 0.f, 0.f, 0.f};
#pragma unroll
                    for (int d = 0; d < 64; d += 4) a4 += *(const f32x4*)(uq + d) * *(const f32x4*)(uk + d);
                    s = (a4[0] + a4[1]) + (a4[2] + a4[3]); }
                else s = uq[64 + (c - 128)];
                ((bf16_t*)(wl + W_QF))[(size_t)n * 256 + k] = f2bf(s * QSCMLA);
            } else if (r < F_Q + F_3) {
                r -= F_Q; const int k = r / 256, n = (r % 256) * 4, h = k / 128, c = k % 128;
                const float* uv = ap->in[I_WUV] + (size_t)l * 128 * 256 + (size_t)c * 256 + h * 64;
                const float* wb = ap->in[I_WBR] + ((size_t)l * 4 + 3) * 256 * D + (size_t)(h * 64) * D + n;
                f32x4 a4 = {0.f, 0.f, 0.f, 0.f};
#pragma unroll 16
                for (int d = 0; d < 64; ++d) a4 += *(const f32x4*)(wb + (size_t)d * D) * uv[d];
                bf16_t* dst = (bf16_t*)(wl + W_B) + (size_t)3 * 1024 * 512 + (size_t)n * 512 + k;
                dst[0] = f2bf(a4[0]); dst[512] = f2bf(a4[1]); dst[1024] = f2bf(a4[2]); dst[1536] = f2bf(a4[3]);
            } else {
                r -= F_Q + F_3; const int k = r / 256, n = (r % 256) * 4, g = k / 64, c = k % 64;
                const float* pw = ap->in[I_POOLW] + (size_t)l * 4 * 64 * 64 + (size_t)g * 4096 + c * 64;
                const float* ps = ap->in[I_POOLS] + (size_t)l * 256 + g * 64;
                const float* wb = ap->in[I_WBR] + ((size_t)l * 4 + 0) * 256 * D + (size_t)(g * 64) * D + n;
                f32x4 a4 = {0.f, 0.f, 0.f, 0.f};
#pragma unroll 16
                for (int d = 0; d < 64; ++d) a4 += *(const f32x4*)(wb + (size_t)d * D) * (pw[d] * ps[d]);
                bf16_t* dst = (bf16_t*)(wl + W_B) + (size_t)n * 512 + k;
                dst[0] = f2bf(a4[0]); dst[512] = f2bf(a4[1]); dst[1024] = f2bf(a4[2]); dst[1536] = f2bf(a4[3]);
            }
        }
        __syncthreads();
        LAS float* sc = (LAS float*)lds;
        LAS float* red = sc + 3072;
        for (int i = tid; i < 3072; i += NTHREADS) { const int v = i >> 10, k = i & 1023; const float cv = v < 2 ? ap->in[I_C][v * D + k] : ap->in[I_CCTX][k]; sc[i] = cv / (1.f + expf(-cv)); }
        __syncthreads();
        for (int it = bx; it < DEPTH * 96; it += G) {
            const int l = it / 96, cgp = it % 96, col = cgp * 64 + lane;
            const float* aw = ap->in[I_ADAW] + (size_t)l * D * 6144 + col;
            float a0 = 0.f, a1 = 0.f, a2 = 0.f;
#pragma unroll 1
            for (int k0 = wid * 128; k0 < wid * 128 + 128; k0 += 32) { float wv[32];
#pragma unroll
                for (int j = 0; j < 32; ++j) wv[j] = aw[(size_t)(k0 + j) * 6144];
#pragma unroll
                for (int j = 0; j < 32; ++j) { a0 += sc[k0 + j] * wv[j]; a1 += sc[1024 + k0 + j] * wv[j]; a2 += sc[2048 + k0 + j] * wv[j]; } }
            red[(wid * 3 + 0) * 64 + lane] = a0; red[(wid * 3 + 1) * 64 + lane] = a1; red[(wid * 3 + 2) * 64 + lane] = a2;
            __syncthreads();
            if (tid < 192) { const int v = tid >> 6, ln = tid & 63; float s = 0.f;
#pragma unroll
                for (int w = 0; w < 8; ++w) s += red[(w * 3 + v) * 64 + ln];
                const int colo = cgp * 64 + ln; mod[(l * 3 + v) * 6144 + colo] = s + ap->in[I_ADAB][l * 6144 + colo]; }
            __syncthreads();
        }
    }
    PH_END0

    for (int l = 0; l < DEPTH; ++l) {

#define NORM_PHASE(XL, XC, GAMMA, SHC, SCC, LB) \
        for (int r0 = gw * 4; r0 < MT; r0 += NGW * 4) { \
            const float* src = r0 < NLAT ? (XL) + (size_t)r0 * D : (XC) + (size_t)(r0 - NLAT) * D; \
            const int v = r0 < NLAT ? r0 / SEQ : 2; const float* mv = modl + v * 6144; \
            f32x4 xv[4][4]; float ss[4]; \
            if ((LB) && r0 < NLAT) { const bf16_t* sb_ = (const bf16_t*)out + (size_t)r0 * 2048 + 1024; \
                _Pragma("unroll") for (int rr = 0; rr < 4; ++rr) _Pragma("unroll") for (int j = 0; j < 4; ++j) { const u32x2 w_ = *(const u32x2*)(sb_ + rr * 2048 + lane * 4 + 256 * j); xv[rr][j] = (f32x4){bflo(w_.x), bfhi(w_.x), bflo(w_.y), bfhi(w_.y)}; } } \
            else { _Pragma("unroll") for (int rr = 0; rr < 4; ++rr) _Pragma("unroll") for (int j = 0; j < 4; ++j) xv[rr][j] = *(const f32x4*)(src + rr * D + lane * 4 + 256 * j); } \
            _Pragma("unroll") for (int rr = 0; rr < 4; ++rr) { float a_ = 0.f; _Pragma("unroll") for (int j = 0; j < 4; ++j) a_ += xv[rr][j][0] * xv[rr][j][0] + xv[rr][j][1] * xv[rr][j][1] + xv[rr][j][2] * xv[rr][j][2] + xv[rr][j][3] * xv[rr][j][3]; ss[rr] = a_; } \
            _Pragma("unroll") for (int o_ = 1; o_ < 64; o_ <<= 1) _Pragma("unroll") for (int rr = 0; rr < 4; ++rr) ss[rr] += __uint_as_float((unsigned)__builtin_amdgcn_ds_bpermute((lane ^ o_) << 2, (int)__float_as_uint(ss[rr]))); \
            _Pragma("unroll") for (int rr = 0; rr < 4; ++rr) ss[rr] = rsqrtf(ss[rr] * (1.f / D) + EPSV); \
            _Pragma("unroll") for (int j = 0; j < 4; ++j) { const int c0 = lane * 4 + 256 * j; const f32x4 g = *(const f32x4*)((GAMMA) + c0), sh = *(const f32x4*)(mv + (SHC) * D + c0), sc = *(const f32x4*)(mv + (SCC) * D + c0); \
                const f32x4 gs = g * (sc + 1.f); \
                _Pragma("unroll") for (int rr = 0; rr < 4; ++rr) { const f32x4 yv = xv[rr][j] * ss[rr] * gs + sh; u32x2 w; w.x = cvtpk(yv[0], yv[1]); w.y = cvtpk(yv[2], yv[3]); *(u32x2*)(Hb + (size_t)(r0 + rr) * D + c0) = w; } } \
        }
        PH_BEGIN PH_LAYER
        NORM_PHASE(ap->in[I_X], cres, ap->in[I_N1G] + l * D, 0, 1, l != 0)
        PH_END

        PH_BEGIN PH_LAYER
        { pg8::SchedPlain S; S.so.init(MT, UW, G, bx); S.A = (const char*)Hb; S.B = (const char*)(wl + W_U); S.a_t = (size_t)256 * D * 2; S.b_t = (size_t)256 * D * 2; S.nt = D / 64;
          EpiStore E{Ub, UW}; pg8::gemm_phase(lds, D * 2, D * 2, S, E); }
        PH_END

        PH_BEGIN PH_LAYER
        {
            const float* qng = ap->in[I_QNORM] + l * 256; const float* kvg = ap->in[I_KVNORM] + l * 128;
            const f32x4 gq = *(const f32x4*)(qng + lane * 4); const float gk0 = kvg[lane * 2], gk1 = kvg[lane * 2 + 1];
            const int si = 2 * (lane & 15);
            const float sf0 = exp2f(-(float)(si & 15) * 0.8304820237218406f), sf1 = exp2f(-(float)((si + 1) & 15) * 0.8304820237218406f);
            const int ki = 2 * (lane & 7);
            const float kf0 = exp2f(-(float)(ki & 7) * 1.6609640474436813f), kf1 = exp2f(-(float)((ki + 1) & 7) * 1.6609640474436813f);
            const int pg = lane >> 4, pw_ = 2 << pg;
#define P2B_DECL(S) bf16_t* ur##S; int tloc##S, nseq##S, base##S; bool lat##S; u32x2 cq##S, ps##S, nb##S[16]; unsigned ckv##S, q1##S, q2##S, k1##S = 0, k2##S = 0, r1##S = 0, r2##S = 0;
#define P2B_LOAD(S, ROW) do { const int row_ = (ROW); ur##S = Ub + (size_t)row_ * UW; lat##S = row_ < NLAT; \
                if (lat##S) { tloc##S = row_ & (SEQ - 1); nseq##S = SEQ; } else { tloc##S = (row_ - NLAT) & (CTXL - 1); nseq##S = CTXL; } base##S = row_ - tloc##S; \
                cq##S = *(const u32x2*)(ur##S + U_CQ + lane * 4); ckv##S = *(const unsigned*)(ur##S + U_CKV + lane * 2); ps##S = *(const u32x2*)(ur##S + U_POOL + lane * 4); \
                q1##S = *(const unsigned*)(ur##S + U_SWQ + (lane >> 4) * 64 + si); q2##S = *(const unsigned*)(ur##S + U_SWQ + (lane >> 4) * 64 + 32 + si); \
                if (lat##S) { if (lane < 32) { k1##S = *(const unsigned*)(ur##S + U_SWK + (lane >> 4) * 64 + si); k2##S = *(const unsigned*)(ur##S + U_SWK + (lane >> 4) * 64 + 32 + si); } \
                              if (lane < 8) { r1##S = *(const unsigned*)(ur##S + U_KR + ki); r2##S = *(const unsigned*)(ur##S + U_KR + 16 + ki); } } \
                _Pragma("unroll") for (int i = 0; i < 16; ++i) { const int t_ = min(max(tloc##S - 8 + i, 0), nseq##S - 1); nb##S[i] = *(const u32x2*)(Ub + (size_t)(base##S + t_) * UW + U_POOL + lane * 4); } } while (0)
#define P2B_PROC(S, ROW) do { const int row_ = (ROW); const float prow = (float)(tloc##S >> 6), pcol = (float)(tloc##S & 63); \
                { float a = bflo(cq##S.x), b = bfhi(cq##S.x), c = bflo(cq##S.y), d = bfhi(cq##S.y); float sq = a * a + b * b + c * c + d * d; float a2 = bflo(ckv##S), b2 = bfhi(ckv##S); float sk = a2 * a2 + b2 * b2; \
                  _Pragma("unroll") for (int o_ = 1; o_ < 64; o_ <<= 1) { sq += __uint_as_float((unsigned)__builtin_amdgcn_ds_bpermute((lane ^ o_) << 2, (int)__float_as_uint(sq))); sk += __uint_as_float((unsigned)__builtin_amdgcn_ds_bpermute((lane ^ o_) << 2, (int)__float_as_uint(sk))); } \
                  const float rq = rsqrtf(sq * (1.f / 256.f) + EPSV), rk = rsqrtf(sk * (1.f / 128.f) + EPSV); u32x2 w; w.x = cvtpk(a * rq * gq[0], b * rq * gq[1]); w.y = cvtpk(c * rq * gq[2], d * rq * gq[3]); \
                  *(u32x2*)(ur##S + U_CQ + lane * 4) = w; *(unsigned*)(ur##S + U_CKV + lane * 2) = cvtpk(a2 * rk * gk0, b2 * rk * gk1); } \
                if (lat##S) { const float ps_ = si < 16 ? prow : pcol; const float a0 = ps_ * sf0, a1 = ps_ * sf1; const float c0 = __cosf(a0), s0 = __sinf(a0), c1 = __cosf(a1), s1 = __sinf(a1); \
                  { const float x1a = bflo(q1##S), x1b = bfhi(q1##S), x2a = bflo(q2##S), x2b = bfhi(q2##S); \
                    *(unsigned*)(ur##S + U_SWQ + (lane >> 4) * 64 + si) = cvtpk(x1a * c0 - x2a * s0, x1b * c1 - x2b * s1); *(unsigned*)(ur##S + U_SWQ + (lane >> 4) * 64 + 32 + si) = cvtpk(x2a * c0 + x1a * s0, x2b * c1 + x1b * s1); } \
                  if (lane < 32) { const float x1a = bflo(k1##S), x1b = bfhi(k1##S), x2a = bflo(k2##S), x2b = bfhi(k2##S); \
                    *(unsigned*)(ur##S + U_SWK + (lane >> 4) * 64 + si) = cvtpk(x1a * c0 - x2a * s0, x1b * c1 - x2b * s1); *(unsigned*)(ur##S + U_SWK + (lane >> 4) * 64 + 32 + si) = cvtpk(x2a * c0 + x1a * s0, x2b * c1 + x1b * s1); } \
                  if (lane < 8) { const float pk_ = ki < 8 ? prow : pcol; const float b0 = pk_ * kf0, b1 = pk_ * kf1; const float d0 = __cosf(b0), e0 = __sinf(b0), d1 = __cosf(b1), e1 = __sinf(b1); \
                    const float x1a = bflo(r1##S), x1b = bfhi(r1##S), x2a = bflo(r2##S), x2b = bfhi(r2##S); \
                    *(unsigned*)(ur##S + U_KR + ki) = cvtpk(x1a * d0 - x2a * e0, x1b * d1 - x2b * e1); *(unsigned*)(ur##S + U_KR + 16 + ki) = cvtpk(x2a * d0 + x1a * e0, x2b * d1 + x1b * e1); } } \
                { const int plo = max(tloc##S - (pw_ >> 1), 0), phi = min(tloc##S - (pw_ >> 1) + pw_, nseq##S); f32x4 s_ = {0.f, 0.f, 0.f, 0.f}; \
                  _Pragma("unroll") for (int i = 0; i < 16; ++i) { const int t_ = tloc##S - 8 + i; const float wt = (t_ >= plo && t_ < phi) ? 1.f : 0.f; \
                      s_[0] += wt * bflo(nb##S[i].x); s_[1] += wt * bfhi(nb##S[i].x); s_[2] += wt * bflo(nb##S[i].y); s_[3] += wt * bfhi(nb##S[i].y); } \
                  const float ic = 1.f / (float)(phi - plo); u32x2 o_; o_.x = cvtpk(s_[0] * ic - bflo(ps##S.x), s_[1] * ic - bfhi(ps##S.x)); o_.y = cvtpk(s_[2] * ic - bflo(ps##S.y), s_[3] * ic - bfhi(ps##S.y)); \
                  *(u32x2*)(Yb + (size_t)row_ * YW + lane * 4) = o_; } } while (0)
            P2B_DECL(A) P2B_DECL(B)
            for (int row = gw * 2; row < MT; row += NGW * 2) {
                P2B_LOAD(A, row); P2B_LOAD(B, row + 1);
                P2B_PROC(A, row); P2B_PROC(B, row + 1);
            }
#undef P2B_DECL
#undef P2B_LOAD
#undef P2B_PROC
        }
        PH_END

        PH_BEGIN PH_LAYER
        { pg8::SchedPlain S; S.so.init(Mq, QW, G, bx); S.A = (const char*)(Ub + U_CQ); S.B = (const char*)(wl + W_QF); S.a_t = (size_t)256 * UW * 2; S.b_t = (size_t)256 * 256 * 2; S.nt = 4;
          EpiQRope E{Qm}; pg8::gemm_phase(lds, UW * 2, 256 * 2, S, E); }
        PH_END

        PH_BEGIN PH_LAYER
        {
            const float* rpb = ap->in[I_RPB] + (size_t)l * 4 * 15 * 31; const float* snk = ap->in[I_SINK] + l * 4;
            for (int i = bx; i < 512; i += G) { const int b = i >> 8, tb = i & 255;
                mla_unit(lds, Ub, Qm, Yb, b * SEQ + tb * 64, NLAT + b * CTXL, 256, b * SEQ); }
            for (int i = bx; i < 512; i += G) { const int b = i >> 8, r = i & 255, r0 = min(max(r - 4, 0), 248);
                attn_unit<1>(lds, Ub, Qm, Yb, rpb, snk, b * SEQ + r * 64, NLAT + b * CTXL, 8, b * SEQ + r0 * 64, r, r0, 0); }
            for (int i = bx; i < 512; i += G) { const int b = i >> 8, rem = i & 255, kvh = rem >> 7, n = rem & 127;
                const int jlo = n == 0 ? 2 : 0, jhi = n == 127 ? 4 : 6, kp0 = (n - 1) * 128 + 64 * jlo;
                attn_unit<2>(lds, Ub, Qm, Yb, rpb, snk, b * SEQ + n * 128, NLAT + b * CTXL, jhi - jlo, b * SEQ + kp0, n * 128, kp0, kvh); }
            if (l == 0) {
                for (int i = bx; i < 24; i += G) { const int kind = i >> 3, j = i & 7, b = j >> 2;
                    if (kind == 0) mla_unit(lds, Ub, Qm, Yb, NLAT + b * CTXL + 64 * (j & 3), NLAT + b * CTXL, 0, 0);
                    else if (kind == 1) attn_unit<1>(lds, Ub, Qm, Yb, rpb, snk, NLAT + b * CTXL + 64 * (j & 3), NLAT + b * CTXL, 0, 0, 0, 0, 0);
                    else attn_unit<2>(lds, Ub, Qm, Yb, rpb, snk, NLAT + b * CTXL + 128 * (j & 1), NLAT + b * CTXL, 0, 0, 0, 0, (j >> 1) & 1); }
            }
        }
        PH_END

        PH_BEGIN PH_LAYER
        { pg8::SchedBranch S; S.so.init(Mq, 4096, G, bx); S.A = (const char*)Yb; S.B = (const char*)(wl + W_B); S.a_t = (size_t)256 * YW * 2;
          EpiStore E{Yall, 4096}; pg8::gemm_phase(lds, YW * 2, 512 * 2, S, E); }
        PH_END

        PH_BEGIN PH_LAYER
        { pg8::SchedPlain S; S.so.init(Mq, 4096, G, bx); S.A = (const char*)Hb; S.B = (const char*)(wl + W_G); S.a_t = (size_t)256 * D * 2; S.b_t = (size_t)256 * D * 2; S.nt = D / 64;
          EpiMerge E{Yall, Mg}; pg8::gemm_phase(lds, D * 2, D * 2, S, E); }
        PH_END

        PH_BEGIN PH_LAYER
        { pg8::SchedPlain S; S.so.init(Mq, D, G, bx); S.A = (const char*)Mg; S.B = (const char*)(wl + W_O); S.a_t = (size_t)256 * D * 2; S.b_t = (size_t)256 * D * 2; S.nt = D / 64;
          EpiResid E{l == 0 ? ap->in[I_X] : nullptr, (bf16_t*)out, cres, xc, modl + 2 * D}; pg8::gemm_phase(lds, D * 2, D * 2, S, E); }
        PH_END

        PH_BEGIN PH_LAYER
        NORM_PHASE(out, xc, ap->in[I_N2G] + l * D, 3, 4, true)
        PH_END

        PH_BEGIN PH_LAYER
        { pg8::SchedPlain S; S.so.init(Mq, 2 * FF, G, bx); S.A = (const char*)Hb; S.B = (const char*)(wl + W_13); S.a_t = (size_t)256 * D * 2; S.b_t = (size_t)256 * D * 2; S.nt = D / 64;
          EpiSwiGLU E{Hid}; pg8::gemm_phase(lds, D * 2, D * 2, S, E); }
        PH_END

        PH_BEGIN PH_LAYER
        { pg8::SchedPlain S; S.so.init(Mq, D, G, bx); S.A = (const char*)Hid; S.B = (const char*)(wl + W_2); S.a_t = (size_t)256 * FF * 2; S.b_t = (size_t)256 * FF * 2; S.nt = FF / 64;
          EpiResid E{nullptr, (bf16_t*)out, xc, xc, modl + 5 * D}; pg8::gemm_phase(lds, FF * 2, FF * 2, S, E); }
        PH_END
    }

    PH_BEGIN
    {
        const float* fg = ap->in[I_FNG];
        for (int r0 = gw * 4; r0 < NLAT; r0 += NGW * 4) {
            float* src = out + (size_t)r0 * D; f32x4 xv[4][4]; float ss[4];
            const bf16_t* sb_ = (const bf16_t*)out + (size_t)r0 * 2048 + 1024;
#pragma unroll
            for (int rr = 0; rr < 4; ++rr)
#pragma unroll
                for (int j = 0; j < 4; ++j) { const u32x2 w_ = *(const u32x2*)(sb_ + rr * 2048 + lane * 4 + 256 * j); xv[rr][j] = (f32x4){bflo(w_.x), bfhi(w_.x), bflo(w_.y), bfhi(w_.y)}; }
            asm volatile("s_waitcnt vmcnt(0)" ::: "memory");
#pragma unroll
            for (int rr = 0; rr < 4; ++rr) { float a_ = 0.f;
#pragma unroll
                for (int j = 0; j < 4; ++j) a_ += xv[rr][j][0] * xv[rr][j][0] + xv[rr][j][1] * xv[rr][j][1] + xv[rr][j][2] * xv[rr][j][2] + xv[rr][j][3] * xv[rr][j][3];
                ss[rr] = a_; }
#pragma unroll
            for (int o_ = 1; o_ < 64; o_ <<= 1)
#pragma unroll
                for (int rr = 0; rr < 4; ++rr) ss[rr] += __uint_as_float((unsigned)__builtin_amdgcn_ds_bpermute((lane ^ o_) << 2, (int)__float_as_uint(ss[rr])));
#pragma unroll
            for (int rr = 0; rr < 4; ++rr) ss[rr] = rsqrtf(ss[rr] * (1.f / D) + EPSV);
#pragma unroll
            for (int j = 0; j < 4; ++j) { const f32x4 g = *(const f32x4*)(fg + lane * 4 + 256 * j);
#pragma unroll
                for (int rr = 0; rr < 4; ++rr) *(f32x4*)(src + rr * D + lane * 4 + 256 * j) = xv[rr][j] * ss[rr] * g; }
        }
    }
    PH_ENDL
}

extern "C" void kernel_launch(void* const* d_in, const int* in_sizes, int n_in, void* d_out, int out_size, void* d_ws, size_t ws_size, hipStream_t stream) {
    static int grid = 0;
    if (grid == 0) {
        if (n_in != 24 || out_size != NLAT * D || ws_size < WS_END) { fprintf(stderr, "kernel_launch: unexpected shapes (n_in %d out %d ws %zu)\n", n_in, out_size, ws_size); grid = -1; return; }
        int dev = 0, cus = 0, per_cu = 0;
        hipGetDevice(&dev);
        hipDeviceGetAttribute(&cus, hipDeviceAttributeMultiprocessorCount, dev);
        hipFuncSetAttribute((const void*)mk_fwd, hipFuncAttributeMaxDynamicSharedMemorySize, LDS_BYTES);
        hipOccupancyMaxActiveBlocksPerMultiprocessor(&per_cu, (const void*)mk_fwd, NTHREADS, LDS_BYTES);
        if (per_cu < 1) { fprintf(stderr, "kernel_launch: occupancy query returned %d\n", per_cu); per_cu = 1; }
        (void)hipGetLastError();
        grid = cus * per_cu;
    }
    if (grid < 0) return;
    Args a{};
    for (int i = 0; i < 24; ++i) a.in[i] = (const float*)d_in[i];
    a.out = (float*)d_out; a.ws = (unsigned char*)d_ws;
    if (hipMemsetAsync(d_ws, 0, XCD_BAR_WORDS * 4, stream) != hipSuccess) { fprintf(stderr, "memset of barrier words failed\n"); return; }
    void* kargs[] = {&a};
    hipError_t e = hipLaunchCooperativeKernel((const void*)mk_fwd, dim3(grid), dim3(NTHREADS), kargs, LDS_BYTES, stream);
    if (e != hipSuccess) fprintf(stderr, "cooperative launch failed: %s (grid %d)\n", hipGetErrorString(e), grid);
}
```
